# Optimizing an MI355X kernel written in HIP

```python
import math
import jax, jax.numpy as jnp
from jax import lax
import numpy as np


D_MODEL = 1024
BATCH = 4
SEQ = 4096
DEPTH = 1

D_MIX = D_MODEL
D_LRU = D_MIX // 2
D_ATTN = D_MIX - D_LRU
N_LRU_BLOCKS = 8
LRU_BLOCK = D_LRU // N_LRU_BLOCKS
CONV_WIDTH = 4
LRU_C = 8.0
N_HEADS = 8
HEAD_DIM = D_ATTN // N_HEADS
MOBA_BLOCK = 256
MOBA_TOPK = 3
Q_CHUNK = 32
REL_BUCKETS = 32
REL_MAX_DIST = 128
N_GROUPS = 4
EXPERTS_PER_GROUP = 8
N_EXPERTS = N_GROUPS * EXPERTS_PER_GROUP
EXPERT_TOPK = 2
D_EXPERT = 256
MOE_ROWS = 128
LN_EPS = 1e-5
DEEPNORM_ALPHA = (2.0 * DEPTH) ** 0.25
DEEPNORM_BETA = (8.0 * DEPTH) ** -0.25
N_MOD = 6
D_IN_PROJ = 2 * D_LRU + 3 * D_ATTN

kernel_name = 'hymba_rglru_moba_hmoe_deepnorm_layer'


def _normalize(x):
    xf = x.astype(jnp.float32)
    mu = jnp.mean(xf, axis=-1, keepdims=True)
    var = jnp.mean(jnp.square(xf - mu), axis=-1, keepdims=True)
    return (xf - mu) * lax.rsqrt(var + LN_EPS)


def layernorm(x, g, b):
    return (_normalize(x) * g + b).astype(x.dtype)


def rmsnorm(x, g):
    xf = x.astype(jnp.float32)
    y = xf * lax.rsqrt(jnp.mean(jnp.square(xf), axis=-1, keepdims=True) + LN_EPS)
    return (y * g).astype(x.dtype)


def modulate(x, shift, scale):
    return (_normalize(x) * (1.0 + scale) + shift).astype(x.dtype)


def causal_depthwise_conv(x, w, b):
    s = x.shape[1]
    xp = jnp.pad(x, ((0, 0), (CONV_WIDTH - 1, 0), (0, 0)))
    return sum(w[k] * xp[:, k:k + s] for k in range(CONV_WIDTH)) + b


def rg_lru(xc, w_a, b_a, w_x, b_x, lam):
    bsz, s, _ = xc.shape
    xb = xc.reshape(bsz, s, N_LRU_BLOCKS, LRU_BLOCK)
    r = jax.nn.sigmoid(jnp.einsum('bsni,nij->bsnj', xb, w_a) + b_a).reshape(bsz, s, D_LRU)
    i = jax.nn.sigmoid(jnp.einsum('bsni,nij->bsnj', xb, w_x) + b_x).reshape(bsz, s, D_LRU)
    log_a = -LRU_C * r.astype(jnp.float32) * jax.nn.softplus(-lam.astype(jnp.float32))
    a = jnp.exp(log_a)
    mult = jnp.sqrt(-jnp.expm1(2.0 * log_a))
    u = mult * (i * xc).astype(jnp.float32)

    def combine(left, right):
        a1, b1 = left
        a2, b2 = right
        return a1 * a2, a2 * b1 + b2

    _, h = lax.associative_scan(combine, (a, u), axis=1)
    return h.astype(xc.dtype)


def t5_bucket(rel):
    n = jnp.maximum(rel, 0)
    max_exact = REL_BUCKETS // 2
    large = max_exact + (jnp.log(jnp.maximum(n, 1).astype(jnp.float32) / max_exact)
                         / math.log(REL_MAX_DIST / max_exact)
                         * (REL_BUCKETS - max_exact)).astype(jnp.int32)
    large = jnp.minimum(large, REL_BUCKETS - 1)
    return jnp.where(n < max_exact, n, large)


def moba_attention(q, k, v, rel_bias):
    bsz, s, h, dh = q.shape
    nb = -(-s // MOBA_BLOCK)
    sp = nb * MOBA_BLOCK
    pad = ((0, 0), (0, sp - s), (0, 0), (0, 0))
    qp = jnp.pad(q, pad).transpose(0, 2, 1, 3)
    kp = jnp.pad(k, pad).transpose(0, 2, 1, 3)
    vp = jnp.pad(v, pad).transpose(0, 2, 1, 3)
    scale = HEAD_DIM ** -0.5
    k_blocks = kp.reshape(bsz, h, nb, MOBA_BLOCK, dh)
    v_blocks = vp.reshape(bsz, h, nb, MOBA_BLOCK, dh)
    k_mean = jnp.mean(k_blocks, axis=3)

    own_all = jnp.arange(sp) // MOBA_BLOCK
    past = jnp.arange(nb)[None, :] < own_all[:, None]
    gate = jnp.einsum('bhqd,bhnd->bhqn', qp, k_mean).astype(jnp.float32)
    gate = jnp.where(past, gate, -jnp.inf)
    if nb < MOBA_TOPK:
        gate = jnp.pad(gate, ((0, 0), (0, 0), (0, 0), (0, MOBA_TOPK - nb)), constant_values=-jnp.inf)
    _, sel = lax.top_k(gate, MOBA_TOPK)

    table_h = rel_bias.T
    b_idx = jnp.arange(bsz)
    h_idx = jnp.arange(h)
    kv_offsets = jnp.arange(MOBA_BLOCK)

    def chunk(ci):
        start = ci * Q_CHUNK
        qc = lax.dynamic_slice_in_dim(qp, start, Q_CHUNK, axis=2)
        selc = lax.dynamic_slice_in_dim(sel, start, Q_CHUNK, axis=2)
        qpos = start + jnp.arange(Q_CHUNK)
        own = start // MOBA_BLOCK
        valid = selc < own
        selg = jnp.minimum(selc, nb - 1)
        kg = k_blocks[b_idx[:, None, None, None], h_idx[None, :, None, None], selg]
        vg = v_blocks[b_idx[:, None, None, None], h_idx[None, :, None, None], selg]
        kpos_p = selg[..., None] * MOBA_BLOCK + kv_offsets
        s_p = jnp.einsum('bhqd,bhqnkd->bhqnk', qc, kg).astype(jnp.float32) * scale
        s_p = s_p + table_h[h_idx[None, :, None, None, None], t5_bucket(qpos[:, None, None] - kpos_p)]
        s_p = jnp.where(valid[..., None], s_p, -jnp.inf)
        ko = lax.dynamic_slice_in_dim(kp, own * MOBA_BLOCK, MOBA_BLOCK, axis=2)
        vo = lax.dynamic_slice_in_dim(vp, own * MOBA_BLOCK, MOBA_BLOCK, axis=2)
        rel_o = qpos[:, None] - (own * MOBA_BLOCK + kv_offsets)[None, :]
        s_o = jnp.einsum('bhqd,bhkd->bhqk', qc, ko).astype(jnp.float32) * scale
        s_o = s_o + table_h[:, t5_bucket(rel_o)]
        s_o = jnp.where(rel_o >= 0, s_o, -jnp.inf)
        logits = jnp.concatenate([s_p.reshape(bsz, h, Q_CHUNK, MOBA_TOPK * MOBA_BLOCK), s_o], axis=-1)
        p = jax.nn.softmax(logits, axis=-1)
        p_p = p[..., :MOBA_TOPK * MOBA_BLOCK].reshape(bsz, h, Q_CHUNK, MOBA_TOPK, MOBA_BLOCK).astype(v.dtype)
        p_o = p[..., MOBA_TOPK * MOBA_BLOCK:].astype(v.dtype)
        return (jnp.einsum('bhqnk,bhqnkd->bhqd', p_p, vg)
                + jnp.einsum('bhqk,bhkd->bhqd', p_o, vo))

    outs = lax.map(chunk, jnp.arange(sp // Q_CHUNK))
    out = outs.transpose(1, 2, 0, 3, 4).reshape(bsz, h, sp, dh)[:, :, :s]
    return out.transpose(0, 2, 1, 3).reshape(bsz, s, h * dh)


def hybrid_mixer(u, w_in, conv_w, conv_b, w_gate_a, b_gate_a, w_gate_x, b_gate_x,
                 lru_lambda, rel_bias, norm_lru_g, norm_attn_g, w_out):
    bsz, s, _ = u.shape
    proj = u @ w_in
    x_lru, y_lru, q, k, v = jnp.split(
        proj, [D_LRU, 2 * D_LRU, 2 * D_LRU + D_ATTN, 2 * D_LRU + 2 * D_ATTN], axis=-1)
    h = rg_lru(causal_depthwise_conv(x_lru, conv_w, conv_b),
               w_gate_a, b_gate_a, w_gate_x, b_gate_x, lru_lambda)
    lru_out = h * jax.nn.gelu(y_lru)
    attn_out = moba_attention(q.reshape(bsz, s, N_HEADS, HEAD_DIM),
                              k.reshape(bsz, s, N_HEADS, HEAD_DIM),
                              v.reshape(bsz, s, N_HEADS, HEAD_DIM), rel_bias)
    merged = jnp.concatenate([rmsnorm(lru_out, norm_lru_g), rmsnorm(attn_out, norm_attn_g)], axis=-1)
    return merged @ w_out


def hierarchical_moe(u, w_rg, b_rg, w_re, b_re, w1, w3, w2):
    bsz, s, d = u.shape
    nc = s // MOE_ROWS
    xt = u.reshape(bsz, nc, MOE_ROWS, d).transpose(1, 0, 2, 3).reshape(nc, bsz * MOE_ROWS, d)

    def body(xc):
        g_prob = jax.nn.softmax((xc @ w_rg + b_rg).astype(jnp.float32), axis=-1)
        g_top, g_idx = lax.top_k(g_prob, 1)
        e_logits = (xc @ w_re + b_re).astype(jnp.float32).reshape(-1, N_GROUPS, EXPERTS_PER_GROUP)
        e_in = jnp.take_along_axis(e_logits, g_idx[:, :, None], axis=1)[:, 0]
        e_top, e_loc = lax.top_k(jax.nn.softmax(e_in, axis=-1), EXPERT_TOPK)
        e_top = e_top / jnp.sum(e_top, axis=-1, keepdims=True)
        weights = g_top * e_top
        e_glob = g_idx * EXPERTS_PER_GROUP + e_loc
        gate = jnp.sum(jax.nn.one_hot(e_glob, N_EXPERTS, dtype=jnp.float32) * weights[..., None], axis=1)
        hdn = jax.nn.silu(jnp.einsum('td,edf->tef', xc, w1)) * jnp.einsum('td,edf->tef', xc, w3)
        return jnp.einsum('tef,efd->td', hdn * gate[:, :, None].astype(hdn.dtype), w2)

    ys = lax.map(body, xt)
    return ys.reshape(nc, bsz, MOE_ROWS, d).transpose(1, 0, 2, 3).reshape(bsz, s, d)


def setup_inputs(seed: int = 0) -> dict:
    key = jax.random.key(seed)
    ks = jax.random.split(key, 28)
    f32 = jnp.float32
    L = DEPTH

    def nrm(k, shape, scale):
        return jax.random.normal(k, shape, f32) * scale

    a_c = jax.random.uniform(ks[11], (L, D_LRU), f32, 0.9, 0.999)
    a_base = a_c ** (1.0 / LRU_C)
    return {
        'x': nrm(ks[0], (BATCH, SEQ, D_MODEL), 1.0),
        'c': nrm(ks[1], (BATCH, D_MODEL), 1.0),
        'w_ada': nrm(ks[2], (L, D_MODEL, N_MOD * D_MODEL), 0.5 * D_MODEL ** -0.5),
        'b_ada': nrm(ks[3], (L, N_MOD * D_MODEL), 0.02),
        'w_in': nrm(ks[4], (L, D_MODEL, D_IN_PROJ), D_MODEL ** -0.5),
        'conv_w': nrm(ks[5], (L, CONV_WIDTH, D_LRU), CONV_WIDTH ** -0.5),
        'conv_b': nrm(ks[6], (L, D_LRU), 0.02),
        'w_gate_a': nrm(ks[7], (L, N_LRU_BLOCKS, LRU_BLOCK, LRU_BLOCK), LRU_BLOCK ** -0.5),
        'b_gate_a': nrm(ks[8], (L, N_LRU_BLOCKS, LRU_BLOCK), 0.02),
        'w_gate_x': nrm(ks[9], (L, N_LRU_BLOCKS, LRU_BLOCK, LRU_BLOCK), LRU_BLOCK ** -0.5),
        'b_gate_x': nrm(ks[10], (L, N_LRU_BLOCKS, LRU_BLOCK), 0.02),
        'lru_lambda': jnp.log(a_base) - jnp.log1p(-a_base),
        'rel_bias': nrm(ks[12], (REL_BUCKETS, N_HEADS), 0.5),
        'norm_lru_g': 1.0 + nrm(ks[13], (L, D_LRU), 0.05),
        'norm_attn_g': 1.0 + nrm(ks[14], (L, D_ATTN), 0.05),
        'w_out': nrm(ks[15], (L, D_MIX, D_MODEL), DEEPNORM_BETA * D_MIX ** -0.5),
        'ln1_g': 1.0 + nrm(ks[16], (L, D_MODEL), 0.05),
        'ln1_b': nrm(ks[17], (L, D_MODEL), 0.02),
        'w_router_group': nrm(ks[18], (L, D_MODEL, N_GROUPS), D_MODEL ** -0.5),
        'b_router_group': nrm(ks[19], (L, N_GROUPS), 0.01),
        'w_router_expert': nrm(ks[20], (L, D_MODEL, N_EXPERTS), D_MODEL ** -0.5),
        'b_router_expert': nrm(ks[21], (L, N_EXPERTS), 0.01),
        'w1': nrm(ks[22], (L, N_EXPERTS, D_MODEL, D_EXPERT), D_MODEL ** -0.5),
        'w3': nrm(ks[23], (L, N_EXPERTS, D_MODEL, D_EXPERT), D_MODEL ** -0.5),
        'w2': nrm(ks[24], (L, N_EXPERTS, D_EXPERT, D_MODEL), DEEPNORM_BETA * D_EXPERT ** -0.5),
        'ln2_g': 1.0 + nrm(ks[25], (L, D_MODEL), 0.05),
        'ln2_b': nrm(ks[26], (L, D_MODEL), 0.02),
    }


def reference(x, c, w_ada, b_ada, w_in, conv_w, conv_b, w_gate_a, b_gate_a, w_gate_x, b_gate_x,
              lru_lambda, rel_bias, norm_lru_g, norm_attn_g, w_out, ln1_g, ln1_b,
              w_router_group, b_router_group, w_router_expert, b_router_expert,
              w1, w3, w2, ln2_g, ln2_b):
    bsz, _, d = x.shape
    silu_c = jax.nn.silu(c)
    for l in range(DEPTH):
        mod = (silu_c @ w_ada[l] + b_ada[l]).reshape(bsz, N_MOD, d)
        sh1, sc1, g1, sh2, sc2, g2 = [mod[:, j, None, :] for j in range(N_MOD)]
        u = modulate(x, sh1, sc1)
        mix = hybrid_mixer(u, w_in[l], conv_w[l], conv_b[l], w_gate_a[l], b_gate_a[l],
                           w_gate_x[l], b_gate_x[l], lru_lambda[l], rel_bias,
                           norm_lru_g[l], norm_attn_g[l], w_out[l])
        x = layernorm(DEEPNORM_ALPHA * x + g1 * mix, ln1_g[l], ln1_b[l])
        u2 = modulate(x, sh2, sc2)
        ffn = hierarchical_moe(u2, w_router_group[l], b_router_group[l], w_router_expert[l],
                               b_router_expert[l], w1[l], w3[l], w2[l])
        x = layernorm(DEEPNORM_ALPHA * x + g2 * ffn, ln2_g[l], ln2_b[l])
    return x
```

```cpp
#include <hip/hip_runtime.h>
#include <cstdint>
#include <cstdio>

constexpr int D = 1024, NB = 4, S = 4096, M = NB * S;
constexpr int DL = 512, DA = 512, NH = 8, HD = 64, BLK = 256, NBLK = S / BLK;
constexpr int NPROJ = 2560, NMOD = 6, PL = 1024  , PA = 1536  ;
constexpr int NG = 4, EPG = 8, NE = 32, DE = 256;
constexpr float LN_EPS = 1e-5f;
constexpr float ALPHA = 1.189207115002721f;

__device__ __constant__ unsigned char T5_BUCKET[128] = {
    0, 1, 2, 3, 4, 5, 6, 7, 8, 9, 10, 11, 12, 13, 14, 15, 16, 16, 16, 17, 17, 18, 18, 18, 19, 19, 19, 20, 20, 20, 20, 21, 21, 21, 21, 22, 22, 22, 22, 22,
    23, 23, 23, 23, 23, 23, 24, 24, 24, 24, 24, 24, 25, 25, 25, 25, 25, 25, 25, 26, 26, 26, 26, 26, 26, 26, 26, 27, 27, 27, 27, 27, 27, 27, 27, 27, 27,
    28, 28, 28, 28, 28, 28, 28, 28, 28, 28, 29, 29, 29, 29, 29, 29, 29, 29, 29, 29, 29, 29, 30, 30, 30, 30, 30, 30, 30, 30, 30, 30, 30, 30, 30, 30,
    31, 31, 31, 31, 31, 31, 31, 31, 31, 31, 31, 31, 31, 31, 31};

__device__ __forceinline__ float wave_sum(float v) {
#pragma unroll
    for (int o = 1; o < 64; o <<= 1) v += __shfl_xor(v, o);
    return v;
}
__device__ __forceinline__ float wave_max(float v) {
#pragma unroll
    for (int o = 1; o < 64; o <<= 1) v = fmaxf(v, __shfl_xor(v, o));
    return v;
}
__device__ __forceinline__ float sigmoidf_(float x) { return 1.f / (1.f + expf(-x)); }
__device__ __forceinline__ float siluf_(float x) { return x * sigmoidf_(x); }
__device__ __forceinline__ float gelu_tanh(float x) { return 0.5f * x * (1.f + tanhf(0.7978845608028654f * (x + 0.044715f * x * x * x))); }

__global__ void __launch_bounds__(256) k_mod(const float* c, const float* w_ada, const float* b_ada, float* mod) {
    __shared__ float sc[NB][D];
    for (int i = threadIdx.x; i < NB * D; i += 256) sc[i / D][i % D] = siluf_(c[i]);
    __syncthreads();
    const int j = blockIdx.x * 256 + threadIdx.x;
    float a0 = 0.f, a1 = 0.f, a2 = 0.f, a3 = 0.f;
    for (int k = 0; k < D; ++k) { const float w = w_ada[(size_t)k * (NMOD * D) + j]; a0 += sc[0][k] * w; a1 += sc[1][k] * w; a2 += sc[2][k] * w; a3 += sc[3][k] * w; }
    const float bb = b_ada[j];
    mod[0 * NMOD * D + j] = a0 + bb; mod[1 * NMOD * D + j] = a1 + bb; mod[2 * NMOD * D + j] = a2 + bb; mod[3 * NMOD * D + j] = a3 + bb;
}

__global__ void __launch_bounds__(256) k_modulate(const float* x, const float* mod, int shift_idx, float* u) {
    const int row = blockIdx.x * 4 + (threadIdx.x >> 6), lane = threadIdx.x & 63, b = row / S;
    const float* xr = x + (size_t)row * D; float v[16]; float s = 0.f;
#pragma unroll
    for (int i = 0; i < 16; ++i) { v[i] = xr[lane + 64 * i]; s += v[i]; }
    const float mean = wave_sum(s) * (1.f / D); float q = 0.f;
#pragma unroll
    for (int i = 0; i < 16; ++i) { v[i] -= mean; q += v[i] * v[i]; }
    const float rstd = rsqrtf(wave_sum(q) * (1.f / D) + LN_EPS);
    const float* sh = mod + (size_t)b * NMOD * D + shift_idx * D; const float* scl = sh + D;
#pragma unroll
    for (int i = 0; i < 16; ++i) { const int cidx = lane + 64 * i; u[(size_t)row * D + cidx] = v[i] * rstd * (1.f + scl[cidx]) + sh[cidx]; }
}

__global__ void __launch_bounds__(256) k_sgemm(const float* A, const float* B, float* C, int Kk, int ldb, int ldc) {
    __shared__ float As[16][64 + 4], Bs[16][64 + 4];
    const int tx = threadIdx.x & 15, ty = threadIdx.x >> 4, m0 = blockIdx.y * 64, n0 = blockIdx.x * 64;
    float acc[4][4] = {};
    for (int k0 = 0; k0 < Kk; k0 += 16) {
        { const int r = threadIdx.x >> 2, kq = (threadIdx.x & 3) * 4; const float4 a = *(const float4*)(A + (size_t)(m0 + r) * Kk + k0 + kq);
          As[kq + 0][r] = a.x; As[kq + 1][r] = a.y; As[kq + 2][r] = a.z; As[kq + 3][r] = a.w; }
        { const int kr = threadIdx.x >> 4, nq = (threadIdx.x & 15) * 4; const float4 b = *(const float4*)(B + (size_t)(k0 + kr) * ldb + n0 + nq);
          Bs[kr][nq + 0] = b.x; Bs[kr][nq + 1] = b.y; Bs[kr][nq + 2] = b.z; Bs[kr][nq + 3] = b.w; }
        __syncthreads();
#pragma unroll
        for (int k = 0; k < 16; ++k) { float a[4], b[4];
#pragma unroll
            for (int i = 0; i < 4; ++i) { a[i] = As[k][ty * 4 + i]; b[i] = Bs[k][tx * 4 + i]; }
#pragma unroll
            for (int i = 0; i < 4; ++i)
#pragma unroll
                for (int j = 0; j < 4; ++j) acc[i][j] += a[i] * b[j]; }
        __syncthreads();
    }
#pragma unroll
    for (int i = 0; i < 4; ++i) *(float4*)(C + (size_t)(m0 + ty * 4 + i) * ldc + n0 + tx * 4) = make_float4(acc[i][0], acc[i][1], acc[i][2], acc[i][3]);
}

__global__ void __launch_bounds__(512) k_lru_elem(const float* proj, const float* conv_w, const float* conv_b, const float* w_a, const float* b_a, const float* w_x, const float* b_x,
                                                  const float* lam, float* Aout, float* Uout) {
    __shared__ float xc[DL];
    const int row = blockIdx.x, s = row % S, ch = threadIdx.x;
    float v = conv_b[ch];
#pragma unroll
    for (int k = 0; k < 4; ++k) { const int ss = s - 3 + k; if (ss >= 0) v += conv_w[k * DL + ch] * proj[(size_t)(row - 3 + k) * PL + ch]; }
    xc[ch] = v; __syncthreads();
    const int n = ch >> 6, j = ch & 63; float ra = b_a[ch], rx = b_x[ch];
    for (int i = 0; i < 64; ++i) { const float xv = xc[n * 64 + i]; ra += xv * w_a[(n * 64 + i) * 64 + j]; rx += xv * w_x[(n * 64 + i) * 64 + j]; }
    const float r = sigmoidf_(ra), ig = sigmoidf_(rx);
    const float sp = log1pf(expf(-lam[ch]));
    const float log_a = -8.0f * r * sp, a = expf(log_a), mult = sqrtf(-expm1f(2.f * log_a));
    Aout[(size_t)row * DL + ch] = a; Uout[(size_t)row * DL + ch] = mult * (ig * v);
}
__global__ void __launch_bounds__(64) k_lru_scan(const float* Ain, const float* Uin, const float* proj, float* lru_out) {
    const int g = blockIdx.x * 64 + threadIdx.x, b = g / DL, ch = g % DL; float h = 0.f;
    for (int s = 0; s < S; s += 8) { float a[8], u[8], y[8];
#pragma unroll
        for (int i = 0; i < 8; ++i) { const size_t row = (size_t)b * S + s + i; a[i] = Ain[row * DL + ch]; u[i] = Uin[row * DL + ch]; y[i] = proj[row * PL + DL + ch]; }
#pragma unroll
        for (int i = 0; i < 8; ++i) { h = a[i] * h + u[i]; lru_out[((size_t)b * S + s + i) * DL + ch] = h * gelu_tanh(y[i]); } }
}
__global__ void __launch_bounds__(256) k_kmean(const float* proj, float* km) {
    const int g = blockIdx.x * 256 + threadIdx.x, col = g % DA, bb = g / DA;
    float s = 0.f; for (int r = 0; r < BLK; ++r) s += proj[((size_t)bb * BLK + r) * PA + 512 + col];
    km[g] = s * (1.f / BLK);
}
__global__ void __launch_bounds__(256) k_attn(const float* proj, const float* km, const float* rel_bias, float* attn_out) {
    __shared__ float sq[4][64], sg[4][16], sp_[4][1024];
    const int w = threadIdx.x >> 6, lane = threadIdx.x & 63, gw = blockIdx.x * 4 + w, row = gw / NH, h = gw % NH, b = row / S, s = row % S, own = s / BLK;
    const float* qp = proj + (size_t)row * PA + h * 64;
    sq[w][lane] = qp[lane];
    __syncthreads();
    if (lane < 16) { float g = -INFINITY; if (lane < own) { g = 0.f; const float* kmp = km + ((size_t)(b * NBLK + lane)) * DA + h * 64; for (int d = 0; d < 64; ++d) g += sq[w][d] * kmp[d]; } sg[w][lane] = g; }
    __syncthreads();
    int blk[4]; bool bval[4]; { unsigned used = 0u;
#pragma unroll
        for (int t = 0; t < 3; ++t) { int best = -1; float bv = 0.f;
#pragma unroll
            for (int i = 0; i < 16; ++i) { const float gv = sg[w][i]; if (!((used >> i) & 1u) && (best < 0 || gv > bv)) { best = i; bv = gv; } }
            used |= 1u << best; blk[t] = best; bval[t] = best < own; } }
    blk[3] = own; bval[3] = true;
    float sc[16]; float mx = -INFINITY;
#pragma unroll
    for (int bi = 0; bi < 4; ++bi) {
#pragma unroll
        for (int t = 0; t < 4; ++t) { float v = -INFINITY;
            if (bval[bi]) { const int kpos = blk[bi] * BLK + t * 64 + lane, rel = s - kpos;
                if (rel >= 0) { const float* kp = proj + ((size_t)b * S + kpos) * PA + 512 + h * 64; float d = 0.f; for (int e = 0; e < 64; ++e) d += sq[w][e] * kp[e];
                    const int bucket = rel < 128 ? (int)T5_BUCKET[rel] : 31; v = d * 0.125f + rel_bias[bucket * NH + h]; } }
            sc[bi * 4 + t] = v; mx = fmaxf(mx, v); } }
    mx = wave_max(mx); float sum = 0.f;
#pragma unroll
    for (int i = 0; i < 16; ++i) { sc[i] = expf(sc[i] - mx); sum += sc[i]; sp_[w][i * 64 + lane] = sc[i]; }
    sum = wave_sum(sum);
    __syncthreads();
    float o = 0.f;
#pragma unroll
    for (int bi = 0; bi < 4; ++bi) if (bval[bi]) { const float* vp = proj + ((size_t)b * S + blk[bi] * BLK) * PA + 1024 + h * 64 + lane;
        for (int kk = 0; kk < BLK; ++kk) o += sp_[w][bi * 256 + kk] * vp[(size_t)kk * PA]; }
    attn_out[(size_t)row * DA + h * 64 + lane] = o / sum;
}
__global__ void __launch_bounds__(256) k_merge(const float* lru_out, const float* attn_out, const float* g_l, const float* g_a, float* merged) {
    const int row = blockIdx.x * 4 + (threadIdx.x >> 6), lane = threadIdx.x & 63;
    float a[8], c[8]; float sa = 0.f, sc2 = 0.f;
#pragma unroll
    for (int i = 0; i < 8; ++i) { a[i] = lru_out[(size_t)row * DL + lane + 64 * i]; c[i] = attn_out[(size_t)row * DA + lane + 64 * i]; sa += a[i] * a[i]; sc2 += c[i] * c[i]; }
    const float ra = rsqrtf(wave_sum(sa) * (1.f / DL) + LN_EPS), rc = rsqrtf(wave_sum(sc2) * (1.f / DA) + LN_EPS);
#pragma unroll
    for (int i = 0; i < 8; ++i) { const int ci = lane + 64 * i; merged[(size_t)row * D + ci] = a[i] * ra * g_l[ci]; merged[(size_t)row * D + DL + ci] = c[i] * rc * g_a[ci]; }
}
__global__ void __launch_bounds__(256) k_post1(const float* x, const float* mix, const float* mod, const float* ln_g, const float* ln_b, const float* w_rg, const float* b_rg, const float* w_re, const float* b_re,
                                               float* x1, float* u2, int* r_idx, float* r_w) {
    const int row = blockIdx.x * 4 + (threadIdx.x >> 6), lane = threadIdx.x & 63, b = row / S;
    const float* md = mod + (size_t)b * NMOD * D; float v[16]; float s = 0.f;
#pragma unroll
    for (int i = 0; i < 16; ++i) { const int ci = lane + 64 * i; v[i] = ALPHA * x[(size_t)row * D + ci] + md[2 * D + ci] * mix[(size_t)row * D + ci]; s += v[i]; }
    float mean = wave_sum(s) * (1.f / D), q = 0.f;
#pragma unroll
    for (int i = 0; i < 16; ++i) { v[i] -= mean; q += v[i] * v[i]; }
    float rstd = rsqrtf(wave_sum(q) * (1.f / D) + LN_EPS); s = 0.f;
#pragma unroll
    for (int i = 0; i < 16; ++i) { const int ci = lane + 64 * i; v[i] = v[i] * rstd * ln_g[ci] + ln_b[ci]; x1[(size_t)row * D + ci] = v[i]; s += v[i]; }
    mean = wave_sum(s) * (1.f / D); q = 0.f;
#pragma unroll
    for (int i = 0; i < 16; ++i) { v[i] -= mean; q += v[i] * v[i]; }
    rstd = rsqrtf(wave_sum(q) * (1.f / D) + LN_EPS);
#pragma unroll
    for (int i = 0; i < 16; ++i) { const int ci = lane + 64 * i; v[i] = v[i] * rstd * (1.f + md[4 * D + ci]) + md[3 * D + ci]; u2[(size_t)row * D + ci] = v[i]; }
    float lg[NG], le[NE];
#pragma unroll
    for (int g = 0; g < NG; ++g) { float p = 0.f;
#pragma unroll
        for (int i = 0; i < 16; ++i) p += v[i] * w_rg[(size_t)(lane + 64 * i) * NG + g];
        lg[g] = wave_sum(p) + b_rg[g]; }
#pragma unroll
    for (int e = 0; e < NE; ++e) { float p = 0.f;
#pragma unroll
        for (int i = 0; i < 16; ++i) p += v[i] * w_re[(size_t)(lane + 64 * i) * NE + e];
        le[e] = wave_sum(p) + b_re[e]; }
    if (lane == 0) {
        int gi = 0; float gmax = lg[0];
#pragma unroll
        for (int g = 1; g < NG; ++g) if (lg[g] > gmax) { gi = g; gmax = lg[g]; }
        float gs = 0.f;
#pragma unroll
        for (int g = 0; g < NG; ++g) gs += expf(lg[g] - gmax);
        const float gtop = 1.f / gs;
        float ev[EPG];
#pragma unroll
        for (int e = 0; e < EPG; ++e) { float t = 0.f;
#pragma unroll
            for (int g = 0; g < NG; ++g) if (g == gi) t = le[g * EPG + e];
            ev[e] = t; }
        int e0 = 0; float v0 = ev[0];
#pragma unroll
        for (int e = 1; e < EPG; ++e) if (ev[e] > v0) { e0 = e; v0 = ev[e]; }
        int e1 = -1; float v1 = 0.f;
#pragma unroll
        for (int e = 0; e < EPG; ++e) if (e != e0 && (e1 < 0 || ev[e] > v1)) { e1 = e; v1 = ev[e]; }
        const float p1 = expf(v1 - v0), w0 = 1.f / (1.f + p1), w1 = p1 / (1.f + p1);
        r_idx[row * 2 + 0] = gi * EPG + e0; r_idx[row * 2 + 1] = gi * EPG + e1; r_w[row * 2 + 0] = gtop * w0; r_w[row * 2 + 1] = gtop * w1;
    }
}
__global__ void __launch_bounds__(256) k_moe(const float* u2, const int* r_idx, const float* r_w, const float* w1, const float* w3, const float* w2, float* ffn) {
    __shared__ float xs[D], hs[DE];
    const int row = blockIdx.x, t = threadIdx.x;
    for (int i = t; i < D; i += 256) xs[i] = u2[(size_t)row * D + i];
    __syncthreads();
    float y[4] = {0.f, 0.f, 0.f, 0.f};
    for (int sl = 0; sl < 2; ++sl) { const int e = r_idx[row * 2 + sl]; const float wt = r_w[row * 2 + sl];
        const float* p1 = w1 + (size_t)e * D * DE + t; const float* p3 = w3 + (size_t)e * D * DE + t; float h1 = 0.f, h3 = 0.f;
        for (int k = 0; k < D; ++k) { h1 += xs[k] * p1[(size_t)k * DE]; h3 += xs[k] * p3[(size_t)k * DE]; }
        hs[t] = siluf_(h1) * h3 * wt; __syncthreads();
        const float* p2 = w2 + (size_t)e * DE * D + t;
        for (int j = 0; j < DE; ++j) { const float hv = hs[j];
#pragma unroll
            for (int i = 0; i < 4; ++i) y[i] += hv * p2[(size_t)j * D + 256 * i]; }
        __syncthreads(); }
#pragma unroll
    for (int i = 0; i < 4; ++i) ffn[(size_t)row * D + t + 256 * i] = y[i];
}
__global__ void __launch_bounds__(256) k_final(const float* x1, const float* ffn, const float* mod, const float* ln_g, const float* ln_b, float* out) {
    const int row = blockIdx.x * 4 + (threadIdx.x >> 6), lane = threadIdx.x & 63, b = row / S;
    const float* md = mod + (size_t)b * NMOD * D; float v[16]; float s = 0.f;
#pragma unroll
    for (int i = 0; i < 16; ++i) { const int ci = lane + 64 * i; v[i] = ALPHA * x1[(size_t)row * D + ci] + md[5 * D + ci] * ffn[(size_t)row * D + ci]; s += v[i]; }
    const float mean = wave_sum(s) * (1.f / D); float q = 0.f;
#pragma unroll
    for (int i = 0; i < 16; ++i) { v[i] -= mean; q += v[i] * v[i]; }
    const float rstd = rsqrtf(wave_sum(q) * (1.f / D) + LN_EPS);
#pragma unroll
    for (int i = 0; i < 16; ++i) { const int ci = lane + 64 * i; out[(size_t)row * D + ci] = v[i] * rstd * ln_g[ci] + ln_b[ci]; }
}

extern "C" void kernel_launch(void* const* d_in, const int* in_sizes, int n_in, void* d_out, int out_size, void* d_ws, size_t ws_size, hipStream_t stream) {
    const float* x = (const float*)d_in[0]; const float* c = (const float*)d_in[1]; const float* w_ada = (const float*)d_in[2]; const float* b_ada = (const float*)d_in[3];
    const float* w_in = (const float*)d_in[4]; const float* conv_w = (const float*)d_in[5]; const float* conv_b = (const float*)d_in[6];
    const float* w_ga = (const float*)d_in[7]; const float* b_ga = (const float*)d_in[8]; const float* w_gx = (const float*)d_in[9]; const float* b_gx = (const float*)d_in[10];
    const float* lam = (const float*)d_in[11]; const float* rel_bias = (const float*)d_in[12]; const float* g_l = (const float*)d_in[13]; const float* g_a = (const float*)d_in[14];
    const float* w_out = (const float*)d_in[15]; const float* ln1_g = (const float*)d_in[16]; const float* ln1_b = (const float*)d_in[17];
    const float* w_rg = (const float*)d_in[18]; const float* b_rg = (const float*)d_in[19]; const float* w_re = (const float*)d_in[20]; const float* b_re = (const float*)d_in[21];
    const float* w1 = (const float*)d_in[22]; const float* w3 = (const float*)d_in[23]; const float* w2 = (const float*)d_in[24]; const float* ln2_g = (const float*)d_in[25]; const float* ln2_b = (const float*)d_in[26];
    float* out = (float*)d_out;
    char* ws = (char*)d_ws; const size_t MiB = 1u << 20;
    if (ws_size < 226 * MiB) { fprintf(stderr, "workspace too small: have %zu\n", ws_size); return; }
    float* mod = (float*)ws;
    float* KM = (float*)(ws + 128 * 1024);
    int* RI = (int*)(ws + 256 * 1024);
    float* RW = (float*)(ws + 384 * 1024);
    float* U = (float*)(ws + 1 * MiB);
    float* PROJL = (float*)(ws + 65 * MiB);
    float* LU = (float*)(ws + 129 * MiB);
    float* PROJA = (float*)(ws + 65 * MiB);
    float* MIX = (float*)(ws + 65 * MiB);
    float* LA = (float*)(ws + 161 * MiB);
    float* AO = (float*)(ws + 193 * MiB);
    float* X1 = (float*)(ws + 161 * MiB);

    k_mod<<<NMOD * D / 256, 256, 0, stream>>>(c, w_ada, b_ada, mod);
    k_modulate<<<M / 4, 256, 0, stream>>>(x, mod, 0, U);
    k_sgemm<<<dim3(PL / 64, M / 64), 256, 0, stream>>>(U, w_in, PROJL, D, NPROJ, PL);
    k_lru_elem<<<M, 512, 0, stream>>>(PROJL, conv_w, conv_b, w_ga, b_ga, w_gx, b_gx, lam, LA, LU);
    k_lru_scan<<<NB * DL / 64, 64, 0, stream>>>(LA, LU, PROJL, LA);
    k_sgemm<<<dim3(PA / 64, M / 64), 256, 0, stream>>>(U, w_in + 1024, PROJA, D, NPROJ, PA);
    k_kmean<<<NB * NBLK * DA / 256, 256, 0, stream>>>(PROJA, KM);
    k_attn<<<M * NH / 4, 256, 0, stream>>>(PROJA, KM, rel_bias, AO);
    k_merge<<<M / 4, 256, 0, stream>>>(LA, AO, g_l, g_a, U);
    k_sgemm<<<dim3(D / 64, M / 64), 256, 0, stream>>>(U, w_out, MIX, D, D, D);
    k_post1<<<M / 4, 256, 0, stream>>>(x, MIX, mod, ln1_g, ln1_b, w_rg, b_rg, w_re, b_re, X1, U, RI, RW);
    k_moe<<<M, 256, 0, stream>>>(U, RI, RW, w1, w3, w2, MIX);
    k_final<<<M / 4, 256, 0, stream>>>(X1, MIX, mod, ln2_g, ln2_b, out);
}
```

```cpp
#include <hip/hip_runtime.h>
#include <cstdio>
#include <cstdint>

namespace pg8 {
#define PG8_LAS __attribute__((address_space(3)))
typedef unsigned short bf16_t;
typedef short bf16x8 __attribute__((ext_vector_type(8)));
typedef float f32x4 __attribute__((ext_vector_type(4)));
typedef unsigned u32x4 __attribute__((ext_vector_type(4)));
constexpr int BM = 256, BK = 64, HALF = 128, HTB = HALF * BK * 2  , STAGE_BYTES = 8 * HTB, NXCD = 8, WGM = 8;

__host__ __device__ __forceinline__ int lds_byte(int r, int c) { const int st = (r >> 4) * 2 + (c >> 5), rr = r & 15, cc = c & 31, ob = rr * 64 + cc * 2; return st * 1024 + (ob ^ (((ob >> 9) & 1) << 5)); }
__host__ __device__ __forceinline__ void stage_rc(int b, int& R, int& C) { const int st = b / 1024, sb = b % 1024, swz = sb ^ (((sb >> 9) & 1) << 5); R = (st >> 1) * 16 + swz / 64; C = (st & 1) * 32 + (swz % 64) / 2; }
__host__ __device__ __forceinline__ int perm32(int rho) { const int n = rho >> 4, i = rho & 15; return 8 * (i >> 2) + 4 * n + (i & 3); }

struct Unit { int pm, pn; };
struct Gemm { const bf16_t* A; const bf16_t* Bt; int M, N, K; };

struct StaticOrder {
    int nM, nN, nwg, G, c;
    __host__ __device__ void init(int M, int N, int G_, int c_) { nM = M / BM; nN = N / BM; nwg = nM * nN; G = G_; c = c_; }
    __host__ __device__ bool next(int i, Unit& u) const {
        const long L = (long)i * G + c; if (L >= nwg) return false;
        int wgid = (int)L; { const int q = nwg / NXCD, r = nwg % NXCD, xcd = wgid % NXCD, off = wgid / NXCD; wgid = (xcd < r ? xcd * (q + 1) : r * (q + 1) + (xcd - r) * q) + off; }
        const int nig = WGM * nN, gid = wgid / nig, fm = gid * WGM, gsz = (nM - fm) < WGM ? (nM - fm) : WGM;
        u.pm = fm + ((wgid % nig) % gsz); u.pn = (wgid % nig) / gsz; return true;
    }
    __device__ __forceinline__ void a_ready(const Unit&) const {}
    __device__ __forceinline__ void done(const Unit&) const {}
};

__device__ __forceinline__ unsigned cvt_pk_bf16(float lo, float hi) { unsigned r; asm volatile("v_cvt_pk_bf16_f32 %0, %1, %2" : "=v"(r) : "v"(lo), "v"(hi)); return r; }
typedef float f32x2 __attribute__((ext_vector_type(2)));
__device__ __forceinline__ f32x2 gelu_pk(f32x2 v) {
    const f32x2 av = __builtin_elementwise_abs(v), d = av * 0.2316418882f + 1.0f;
    f32x2 t; t.x = __builtin_amdgcn_rcpf(d.x); t.y = __builtin_amdgcn_rcpf(d.y);
    f32x2 q = t * 0.5307027145f + (-0.7265760135f); q = q * t + 0.7107068705f; q = q * t + (-0.142248368f); q = q * t + 0.127414796f; q = q * t;
    const f32x2 s = (v * v) * (-0.72134752044f);
    f32x2 e; e.x = __builtin_amdgcn_exp2f(s.x); e.y = __builtin_amdgcn_exp2f(s.y);
    const f32x2 m = v * (q * e), r = v - m;
    f32x2 o; o.x = v.x < 0.f ? m.x : r.x; o.y = v.y < 0.f ? m.y : r.y; return o;
}

template <int ACT  > struct EpiBf16 {
    static constexpr bool PERM = true, AFTER_DRAIN = false; static_assert(ACT == 0 || ACT == 1, "EpiBf16: ACT is 0 (none) or 1 (gelu_pk)");
    bf16_t* O; int ldc; const float* bias; int split_cols; size_t split_stride; float scale0;
    __device__ __forceinline__ void operator()(const f32x4 (&acc)[2][2][4][2], const Unit& u, int wr, int wc, int fr, int fq) const {
        const int row0 = u.pm * BM + wr * 64 + fr; int colt = u.pn * BM; bf16_t* base = O;
        float sc = 1.f; if (split_cols) { const int t = colt / split_cols; base += (size_t)t * split_stride; colt -= t * split_cols; if (t == 0) sc = scale0; }
        const int col0 = colt + wc * 32 + 8 * fq, bcol0 = u.pn * BM + wc * 32 + 8 * fq;
        f32x4 bv[2][2];
#pragma unroll
        for (int bj = 0; bj < 2; ++bj)
#pragma unroll
            for (int n = 0; n < 2; ++n) bv[bj][n] = bias ? *(const f32x4*)(bias + bcol0 + bj * HALF + 4 * n) : (f32x4){0.f, 0.f, 0.f, 0.f};
#pragma unroll
        for (int ai = 0; ai < 2; ++ai)
#pragma unroll
            for (int m = 0; m < 4; ++m) { bf16_t* rowp = base + (size_t)(row0 + ai * HALF + m * 16) * ldc + col0;
#pragma unroll
                for (int bj = 0; bj < 2; ++bj) { f32x4 v0 = acc[ai][bj][m][0] + bv[bj][0], v1 = acc[ai][bj][m][1] + bv[bj][1];
                    if (ACT == 1) { f32x2 a = gelu_pk((f32x2){v0[0], v0[1]}), b = gelu_pk((f32x2){v0[2], v0[3]}), c = gelu_pk((f32x2){v1[0], v1[1]}), d = gelu_pk((f32x2){v1[2], v1[3]});
                        v0 = (f32x4){a.x, a.y, b.x, b.y}; v1 = (f32x4){c.x, c.y, d.x, d.y}; }
                    v0 = v0 * sc; v1 = v1 * sc; u32x4 w; w.x = cvt_pk_bf16(v0[0], v0[1]); w.y = cvt_pk_bf16(v0[2], v0[3]); w.z = cvt_pk_bf16(v1[0], v1[1]); w.w = cvt_pk_bf16(v1[2], v1[3]);
                    *(u32x4*)(rowp + bj * HALF) = w; } }
    }
};

struct PanelStats {
    unsigned* xbuf;
    unsigned* cnt;
    unsigned* tmo;
    int ntn; float eps;
    unsigned code;
    __device__ __forceinline__ bool run(const f32x4 (&v)[2][2][4][2], const Unit& u, int wr, int wc, int fr, int fq, PG8_LAS unsigned char* lds, int wid, int lane) const {
        typedef float f32x2v __attribute__((ext_vector_type(2)));
        PG8_LAS f32x2v* P = (PG8_LAS f32x2v*)lds;
        PG8_LAS f32x2v* S = (PG8_LAS f32x2v*)(lds + 8192);
        PG8_LAS unsigned* flag = (PG8_LAS unsigned*)(lds + 8192 + 2048);
#pragma unroll
        for (int ai = 0; ai < 2; ++ai)
#pragma unroll
            for (int m = 0; m < 4; ++m) {
                float s = 0.f;
#pragma unroll
                for (int bj = 0; bj < 2; ++bj)
#pragma unroll
                    for (int n = 0; n < 2; ++n) { const f32x4 x = v[ai][bj][m][n]; s += (x[0] + x[1]) + (x[2] + x[3]); }
                s += __shfl_xor(s, 16); s += __shfl_xor(s, 32);
                const float mw = s * (1.0f / 64.0f); float q = 0.f;
#pragma unroll
                for (int bj = 0; bj < 2; ++bj)
#pragma unroll
                    for (int n = 0; n < 2; ++n) { const f32x4 d = v[ai][bj][m][n] - mw; q += (d[0] * d[0] + d[1] * d[1]) + (d[2] * d[2] + d[3] * d[3]); }
                q += __shfl_xor(q, 16); q += __shfl_xor(q, 32);
                if (fq == 0) P[(ai * HALF + wr * 64 + m * 16 + fr) * 4 + wc] = (f32x2v){mw, q};
            }
        asm volatile("s_waitcnt lgkmcnt(0)" ::: "memory"); __builtin_amdgcn_s_barrier(); asm volatile("" ::: "memory");
#if defined(BROKEN_EXCHANGE_NO_WAIT)
#warning BROKEN CONTROL BUILD: the row-statistics exchange does not wait; results are wrong by design
        if (blockIdx.x >= 64) { const long long t0_ = clock64(); while (clock64() - t0_ < 60000) __builtin_amdgcn_s_sleep(8); }
#endif
        const int row = wid * 32 + (lane & 31);
        if (lane < 32) {
            const f32x2v a = P[row * 4 + 0], b = P[row * 4 + 1], c = P[row * 4 + 2], d = P[row * 4 + 3];
            const float mt = (a.x + b.x + c.x + d.x) * 0.25f;
            const float da = a.x - mt, db = b.x - mt, dc = c.x - mt, dd = d.x - mt;
            const float m2 = (a.y + b.y) + (c.y + d.y) + 64.0f * ((da * da + db * db) + (dc * dc + dd * dd));
            unsigned long long* slot = (unsigned long long*)xbuf + ((size_t)(u.pm * BM + row) * 4 + u.pn);
            __hip_atomic_store(slot, ((unsigned long long)__float_as_uint(m2) << 32) | __float_as_uint(mt), __ATOMIC_RELAXED, __HIP_MEMORY_SCOPE_AGENT);
        }
        asm volatile("s_waitcnt vmcnt(0)" ::: "memory");
        if (lane == 0) __hip_atomic_fetch_add(cnt + 64 * u.pm, 1u, __ATOMIC_RELAXED, __HIP_MEMORY_SCOPE_AGENT);
        if (wid == 0) {
            bool dead = false; const unsigned long long t0 = __builtin_amdgcn_s_memrealtime(); const unsigned want = 8u * (unsigned)ntn;
            for (;;) {
#if defined(BROKEN_EXCHANGE_NO_WAIT)
                break;
#endif
                if ((unsigned)__builtin_amdgcn_readfirstlane(__hip_atomic_load(cnt + 64 * u.pm, __ATOMIC_RELAXED, __HIP_MEMORY_SCOPE_AGENT)) >= want) break;
                if (__builtin_amdgcn_s_memrealtime() - t0 > 2000000ull) {
                    if (lane == 0) { unsigned expect = 0u; __hip_atomic_compare_exchange_strong(tmo + 1, &expect, code | (unsigned)(u.pm & 0xff), __ATOMIC_RELAXED, __ATOMIC_RELAXED, __HIP_MEMORY_SCOPE_AGENT);
                                     __hip_atomic_store(tmo, 1u, __ATOMIC_RELAXED, __HIP_MEMORY_SCOPE_AGENT); }
                    dead = true; break; }
                __builtin_amdgcn_s_sleep(2);
            }
            __builtin_amdgcn_fence(__ATOMIC_ACQUIRE, "agent");
            if (lane == 0) flag[0] = dead ? 1u : 0u;
        }
        asm volatile("s_waitcnt vmcnt(0) lgkmcnt(0)" ::: "memory"); __builtin_amdgcn_s_barrier(); asm volatile("" ::: "memory");
        const bool bad = flag[0] != 0u;
        if (lane < 32) {
            const unsigned long long* slot = (const unsigned long long*)xbuf + (size_t)(u.pm * BM + row) * 4; float mt[4], m2[4]; float ms = 0.f;
#pragma unroll
            for (int t = 0; t < 4; ++t) { if (t < ntn) { const unsigned long long w = __hip_atomic_load(slot + t, __ATOMIC_RELAXED, __HIP_MEMORY_SCOPE_AGENT); mt[t] = __uint_as_float((unsigned)w); m2[t] = __uint_as_float((unsigned)(w >> 32)); } else { mt[t] = 0.f; m2[t] = 0.f; } ms += mt[t]; }
            const float mean = ms / (float)ntn; float q = 0.f;
#pragma unroll
            for (int t = 0; t < 4; ++t) if (t < ntn) { const float dm = mt[t] - mean; q += m2[t] + 256.0f * dm * dm; }
            S[row] = (f32x2v){mean, 1.0f / sqrtf(q / (256.0f * (float)ntn) + eps)};
        }
        asm volatile("s_waitcnt lgkmcnt(0)" ::: "memory"); __builtin_amdgcn_s_barrier(); asm volatile("" ::: "memory");
        return bad;
    }
};
struct EpiLnRes {
    static constexpr bool PERM = false, AFTER_DRAIN = true;
    const float* base; float* out; int ldc; const float* bias; PanelStats st; unsigned poison;
    __device__ __forceinline__ void fused(f32x4 (&acc)[2][2][4][2], const Unit& u, int wr, int wc, int fr, int fq, PG8_LAS unsigned char* lds, int wid, int lane) const {
        typedef float f32x2v __attribute__((ext_vector_type(2)));
        const PG8_LAS f32x2v* S = (const PG8_LAS f32x2v*)(lds + 8192);
        const int col0 = u.pn * BM + wc * 32 + 4 * fq;
#pragma unroll
        for (int bj = 0; bj < 2; ++bj)
#pragma unroll
            for (int n = 0; n < 2; ++n) { const f32x4 bv = bias ? *(const f32x4*)(bias + col0 + bj * HALF + n * 16) : (f32x4){0.f, 0.f, 0.f, 0.f};
#pragma unroll
                for (int ai = 0; ai < 2; ++ai)
#pragma unroll
                    for (int m = 0; m < 4; ++m) acc[ai][bj][m][n] += bv; }
        f32x4 pre[4][2][2];
#pragma unroll
        for (int m = 0; m < 4; ++m) { const size_t off = (size_t)(u.pm * BM + wr * 64 + m * 16 + fr) * ldc + col0;
#pragma unroll
            for (int bj = 0; bj < 2; ++bj)
#pragma unroll
                for (int n = 0; n < 2; ++n) pre[m][bj][n] = *(const f32x4*)(base + off + bj * HALF + n * 16); }
        const bool bad = st.run(acc, u, wr, wc, fr, fq, lds, wid, lane) || poison != 0u;
        const float qnan = __builtin_nanf("");
#pragma unroll
        for (int ai = 0; ai < 2; ++ai)
#pragma unroll
            for (int m = 0; m < 4; ++m) { const int r = ai * HALF + wr * 64 + m * 16 + fr; const f32x2v sr = S[r]; const size_t off = (size_t)(u.pm * BM + r) * ldc + col0;
#pragma unroll
                for (int bj = 0; bj < 2; ++bj)
#pragma unroll
                    for (int n = 0; n < 2; ++n) { const f32x4 bs = ai == 0 ? pre[m][bj][n] : *(const f32x4*)(base + off + bj * HALF + n * 16); f32x4 o = bs + (acc[ai][bj][m][n] - sr.x) * sr.y;
                        if (bad) o = (f32x4){qnan, qnan, qnan, qnan}; *(f32x4*)(out + off + bj * HALF + n * 16) = o; }
                if (m & 1) asm volatile("" ::: "memory"); }
    }
};
struct EpiLnResLn {
    static constexpr bool PERM = false, AFTER_DRAIN = true;
    const float* base; float* out; bf16_t* xn; int ldc; const float* bias; PanelStats st1, st2; unsigned poison;
    __device__ __forceinline__ void fused(f32x4 (&acc)[2][2][4][2], const Unit& u, int wr, int wc, int fr, int fq, PG8_LAS unsigned char* lds, int wid, int lane) const {
        typedef float f32x2v __attribute__((ext_vector_type(2))); typedef unsigned u32x2v __attribute__((ext_vector_type(2)));
        const PG8_LAS f32x2v* S = (const PG8_LAS f32x2v*)(lds + 8192);
        const int col0 = u.pn * BM + wc * 32 + 4 * fq;
#pragma unroll
        for (int bj = 0; bj < 2; ++bj)
#pragma unroll
            for (int n = 0; n < 2; ++n) { const f32x4 bv = bias ? *(const f32x4*)(bias + col0 + bj * HALF + n * 16) : (f32x4){0.f, 0.f, 0.f, 0.f};
#pragma unroll
                for (int ai = 0; ai < 2; ++ai)
#pragma unroll
                    for (int m = 0; m < 4; ++m) acc[ai][bj][m][n] += bv; }
        bool bad = st1.run(acc, u, wr, wc, fr, fq, lds, wid, lane) || poison != 0u;
        const float qnan = __builtin_nanf("");
#pragma unroll
        for (int ai = 0; ai < 2; ++ai)
#pragma unroll
            for (int m = 0; m < 4; ++m) { const int r = ai * HALF + wr * 64 + m * 16 + fr; const f32x2v sr = S[r]; const size_t off = (size_t)(u.pm * BM + r) * ldc + col0;
#pragma unroll
                for (int bj = 0; bj < 2; ++bj)
#pragma unroll
                    for (int n = 0; n < 2; ++n) { const f32x4 bs = *(const f32x4*)(base + off + bj * HALF + n * 16); acc[ai][bj][m][n] = bs + (acc[ai][bj][m][n] - sr.x) * sr.y; }
                asm volatile("" : "+v"(acc[ai][0][m][0]), "+v"(acc[ai][0][m][1]), "+v"(acc[ai][1][m][0]), "+v"(acc[ai][1][m][1]));
                if (m & 1) asm volatile("" ::: "memory"); }
        const bool bad1 = bad;
        bad = st2.run(acc, u, wr, wc, fr, fq, lds, wid, lane) || bad;
#pragma unroll
        for (int ai = 0; ai < 2; ++ai)
#pragma unroll
            for (int m = 0; m < 4; ++m) { const int r = ai * HALF + wr * 64 + m * 16 + fr; const f32x2v sr = S[r]; const size_t off = (size_t)(u.pm * BM + r) * ldc + col0;
#pragma unroll
                for (int bj = 0; bj < 2; ++bj)
#pragma unroll
                    for (int n = 0; n < 2; ++n) { const f32x4 x1 = acc[ai][bj][m][n]; *(f32x4*)(out + off + bj * HALF + n * 16) = bad1 ? (f32x4){qnan, qnan, qnan, qnan} : x1;
                        const f32x4 o = (x1 - sr.x) * sr.y; u32x2v w; w.x = cvt_pk_bf16(o[0], o[1]); w.y = cvt_pk_bf16(o[2], o[3]);
                        if (bad) { w.x = 0x7fc07fc0u; w.y = 0x7fc07fc0u; } *(u32x2v*)(xn + off + bj * HALF + n * 16) = w; }
                asm volatile("" ::: "memory"); }
    }
};

template <class Epi, class Sched, bool ALIGN_EPI = false, bool SP2 = false>
__device__ __forceinline__ void gemm_phase(PG8_LAS unsigned char* lds, const Gemm g, const Sched& S, const Epi& E) {
    const int tid = threadIdx.x, wid = __builtin_amdgcn_readfirstlane(tid >> 6), lane = tid & 63, wr = wid >> 2, wc = wid & 3, fr = lane & 15, fq = lane >> 4;
    const int K = g.K, nt = K / BK;
    unsigned voffA[2], voffB[2];
#pragma unroll
    for (int i = 0; i < 2; ++i) { int R, C; stage_rc(tid * 16 + i * 8192, R, C); const int Rb = Epi::PERM ? ((R & ~31) + perm32(R & 31)) : R;
        voffA[i] = (unsigned)(R * K + C) * 2u; voffB[i] = (unsigned)(Rb * K + C) * 2u; }
    const size_t kstep = (size_t)(BK * 2);
    const size_t hstep = (size_t)HALF * K * 2;
    const size_t tstep = 2 * hstep;
    const unsigned ldsw = (unsigned)wid * 1024u;
    const int aoff = lds_byte(wr * 64 + fr, fq * 8), boff = lds_byte(wc * 32 + fr, fq * 8);
#define PG8_SA(b, h) (((b) * 2 + (h)) * HTB)
#define PG8_SB(b, h) ((4 + (b) * 2 + (h)) * HTB)
#define PG8_STAGE(bufoff, gbase, voff) do { _Pragma("unroll") for (int _i = 0; _i < 2; ++_i) \
        __builtin_amdgcn_global_load_lds((const unsigned*)((const char*)(gbase) + (voff)[_i]), (PG8_LAS unsigned*)(lds + (bufoff) + ldsw + _i * 8192), 16, 0, 0); } while (0)
#define PG8_LDA(dst, b, h) do { _Pragma("unroll") for (int m = 0; m < 4; ++m) _Pragma("unroll") for (int k = 0; k < 2; ++k) dst[m][k] = *(const PG8_LAS bf16x8*)(lds + PG8_SA(b, h) + aoff + m * 2048 + k * 1024); } while (0)
#define PG8_LDB(dst, b, h) do { _Pragma("unroll") for (int n = 0; n < 2; ++n) _Pragma("unroll") for (int k = 0; k < 2; ++k) dst[n][k] = *(const PG8_LAS bf16x8*)(lds + PG8_SB(b, h) + boff + n * 2048 + k * 1024); } while (0)
#define PG8_MMA(ai, bj, At, Bt) do { __builtin_amdgcn_s_setprio(1); _Pragma("unroll") for (int m = 0; m < 4; ++m) _Pragma("unroll") for (int n = 0; n < 2; ++n) _Pragma("unroll") for (int k = 0; k < 2; ++k) \
        acc[ai][bj][m][n] = __builtin_amdgcn_mfma_f32_16x16x32_bf16(Bt[n][k], At[m][k], acc[ai][bj][m][n], 0, 0, 0); __builtin_amdgcn_s_setprio(0); } while (0)
#define PG8_WAIT_V(n) asm volatile("s_waitcnt vmcnt(" #n ")" ::: "memory")
#define PG8_WAIT_L(n) asm volatile("s_waitcnt lgkmcnt(" #n ")" ::: "memory")
#define PG8_BAR __builtin_amdgcn_s_barrier()
#define PG8_SCHED __builtin_amdgcn_sched_barrier(0)
    Unit cur, nxt; int ui = 0;
    if (!S.next(0, cur)) return;
    f32x4 acc[2][2][4][2];
#pragma unroll
    for (int a = 0; a < 2; ++a)
#pragma unroll
        for (int b = 0; b < 2; ++b)
#pragma unroll
            for (int m = 0; m < 4; ++m)
#pragma unroll
                for (int n = 0; n < 2; ++n) acc[a][b][m][n] = (f32x4){0.f, 0.f, 0.f, 0.f};
    bf16x8 At[4][2], B0[2][2], B1[2][2];
    const char* cA = (const char*)g.A + (size_t)cur.pm * tstep; const char* cB = (const char*)g.Bt + (size_t)cur.pn * tstep;
    S.a_ready(cur);
    if constexpr (SP2) {
        PG8_STAGE(PG8_SB(0, 0), cB, voffB); PG8_STAGE(PG8_SB(0, 1), cB + hstep, voffB); PG8_STAGE(PG8_SA(0, 0), cA, voffA); PG8_STAGE(PG8_SA(0, 1), cA + hstep, voffA);
        if (wr == 1) PG8_BAR;
        PG8_WAIT_V(2); PG8_BAR;
        PG8_STAGE(PG8_SB(1, 0), cB + kstep, voffB); PG8_STAGE(PG8_SA(1, 0), cA + kstep, voffA); PG8_STAGE(PG8_SB(1, 1), cB + hstep + kstep, voffB);
        PG8_WAIT_V(6); PG8_BAR;
    } else {
        PG8_STAGE(PG8_SB(0, 0), cB, voffB); PG8_STAGE(PG8_SA(0, 0), cA, voffA); PG8_STAGE(PG8_SB(0, 1), cB + hstep, voffB); PG8_STAGE(PG8_SA(0, 1), cA + hstep, voffA);
        if (wr == 1) PG8_BAR;
        PG8_WAIT_V(4); PG8_BAR;
        PG8_STAGE(PG8_SB(1, 0), cB + kstep, voffB); PG8_STAGE(PG8_SA(1, 0), cA + kstep, voffA); PG8_STAGE(PG8_SB(1, 1), cB + hstep + kstep, voffB);
        PG8_WAIT_V(6); PG8_BAR;
    }
    for (;;) {
        const bool has_next = S.next(ui + 1, nxt);
        const char* nA = has_next ? (const char*)g.A + (size_t)nxt.pm * tstep : cA; const char* nB = has_next ? (const char*)g.Bt + (size_t)nxt.pn * tstep : cB;
        for (int t = 0; t < nt; t += 2) {
            const bool last = (t == nt - 2);
            const char* a1 = cA + (size_t)(t + 1) * kstep;
            const char* a2 = last ? nA : cA + (size_t)(t + 2) * kstep; const char* b2 = last ? nB : cB + (size_t)(t + 2) * kstep;
            const char* a3 = a2 + kstep; const char* b3 = b2 + kstep;
            if (last && has_next) S.a_ready(nxt);
            if constexpr (SP2) {
            PG8_LDB(B0, 0, 0); PG8_LDB(B1, 0, 1); PG8_SCHED; PG8_LDA(At, 0, 0); PG8_STAGE(PG8_SA(1, 1), a1 + hstep, voffA);
            PG8_WAIT_V(8); PG8_WAIT_L(0); PG8_BAR; PG8_MMA(0, 0, At, B0); PG8_MMA(0, 1, At, B1); PG8_BAR; PG8_SCHED;
            PG8_LDA(At, 0, 1); PG8_STAGE(PG8_SB(0, 0), b2, voffB); PG8_STAGE(PG8_SB(0, 1), b2 + hstep, voffB); PG8_STAGE(PG8_SA(0, 0), a2, voffA);
            PG8_WAIT_V(8); PG8_WAIT_L(0); PG8_BAR; PG8_MMA(1, 0, At, B0); PG8_MMA(1, 1, At, B1); PG8_BAR; PG8_SCHED;
            PG8_LDB(B0, 1, 0); PG8_LDB(B1, 1, 1); PG8_SCHED; PG8_LDA(At, 1, 0); PG8_STAGE(PG8_SA(0, 1), a2 + hstep, voffA);
            PG8_WAIT_V(8); PG8_WAIT_L(0); PG8_BAR; PG8_MMA(0, 0, At, B0); PG8_MMA(0, 1, At, B1); PG8_BAR; PG8_SCHED;
            PG8_LDA(At, 1, 1); PG8_STAGE(PG8_SB(1, 0), b3, voffB); PG8_STAGE(PG8_SB(1, 1), b3 + hstep, voffB); PG8_STAGE(PG8_SA(1, 0), a3, voffA);
            PG8_WAIT_V(8); PG8_WAIT_L(0); PG8_BAR; PG8_MMA(1, 0, At, B0); PG8_MMA(1, 1, At, B1); PG8_BAR; PG8_SCHED;
            } else {
            PG8_LDB(B0, 0, 0); PG8_SCHED; PG8_LDA(At, 0, 0); PG8_STAGE(PG8_SA(1, 1), a1 + hstep, voffA);
            PG8_WAIT_L(8); PG8_BAR; PG8_WAIT_L(0); PG8_MMA(0, 0, At, B0); PG8_BAR; PG8_SCHED;
            PG8_LDB(B1, 0, 1); PG8_STAGE(PG8_SB(0, 0), b2, voffB);
            PG8_BAR; PG8_WAIT_L(0); PG8_MMA(0, 1, At, B1); PG8_BAR;
            PG8_LDA(At, 0, 1); PG8_STAGE(PG8_SA(0, 0), a2, voffA);
            PG8_BAR; PG8_WAIT_L(0); PG8_MMA(1, 0, At, B0); PG8_BAR; PG8_SCHED;
            PG8_STAGE(PG8_SB(0, 1), b2 + hstep, voffB);
            PG8_WAIT_V(6); PG8_BAR; PG8_MMA(1, 1, At, B1); PG8_BAR;
            PG8_LDB(B0, 1, 0); PG8_SCHED; PG8_LDA(At, 1, 0); PG8_STAGE(PG8_SA(0, 1), a2 + hstep, voffA);
            PG8_WAIT_L(8); PG8_BAR; PG8_WAIT_L(0); PG8_MMA(0, 0, At, B0); PG8_BAR; PG8_SCHED;
            PG8_LDB(B1, 1, 1); PG8_STAGE(PG8_SB(1, 0), b3, voffB);
            PG8_BAR; PG8_WAIT_L(0); PG8_MMA(0, 1, At, B1); PG8_BAR;
            PG8_LDA(At, 1, 1); PG8_STAGE(PG8_SA(1, 0), a3, voffA);
            PG8_BAR; PG8_WAIT_L(0); PG8_MMA(1, 0, At, B0); PG8_BAR; PG8_SCHED;
            PG8_STAGE(PG8_SB(1, 1), b3 + hstep, voffB);
            PG8_WAIT_V(6); PG8_BAR; PG8_MMA(1, 1, At, B1); PG8_BAR;
            }
        }
        if constexpr (ALIGN_EPI) { if (wr == 0) PG8_BAR; }
        if constexpr (!Epi::AFTER_DRAIN) { E(acc, cur, wr, wc, fr, fq); S.done(cur); }
        if (!has_next) break;
#pragma unroll
        for (int a = 0; a < 2; ++a)
#pragma unroll
            for (int b = 0; b < 2; ++b)
#pragma unroll
                for (int m = 0; m < 4; ++m)
#pragma unroll
                    for (int n = 0; n < 2; ++n) acc[a][b][m][n] = (f32x4){0.f, 0.f, 0.f, 0.f};
        cur = nxt; cA = nA; cB = nB; ++ui;
        if constexpr (ALIGN_EPI) { if (wr == 1) PG8_BAR; }
    }
    PG8_WAIT_V(0);
    if constexpr (!ALIGN_EPI) { if (wr == 0) PG8_BAR; }
    PG8_BAR;
    if constexpr (Epi::AFTER_DRAIN) { E.fused(acc, cur, wr, wc, fr, fq, lds, wid, lane); S.done(cur); }
#undef PG8_SA
#undef PG8_SB
#undef PG8_STAGE
#undef PG8_LDA
#undef PG8_LDB
#undef PG8_MMA
#undef PG8_WAIT_V
#undef PG8_WAIT_L
#undef PG8_BAR
#undef PG8_SCHED
}
}

#ifndef PG8_SP2
#define PG8_SP2 true
#endif
#ifndef PG8_ALIGN
#define PG8_ALIGN true
#endif

namespace pg8 {
struct EpiProj {
    static constexpr bool PERM = true, AFTER_DRAIN = false;
    bf16_t* O; size_t stride; float* kmsum; float qscale;
    __device__ __forceinline__ void operator()(const f32x4 (&acc)[2][2][4][2], const Unit& u, int wr, int wc, int fr, int fq) const {
        const int t = u.pn >> 1, colt = (u.pn & 1) * BM;
        const int row0 = u.pm * BM + wr * 64 + fr, col0 = colt + wc * 32 + 8 * fq;
        bf16_t* base = O + (size_t)t * stride; const float sc = (t == 2) ? qscale : 1.f;
#pragma unroll
        for (int ai = 0; ai < 2; ++ai)
#pragma unroll
            for (int m = 0; m < 4; ++m) { bf16_t* rowp = base + (size_t)(row0 + ai * HALF + m * 16) * 512 + col0;
#pragma unroll
                for (int bj = 0; bj < 2; ++bj) { const f32x4 v0 = acc[ai][bj][m][0] * sc, v1 = acc[ai][bj][m][1] * sc;
                    u32x4 w; w.x = cvt_pk_bf16(v0[0], v0[1]); w.y = cvt_pk_bf16(v0[2], v0[3]); w.z = cvt_pk_bf16(v1[0], v1[1]); w.w = cvt_pk_bf16(v1[2], v1[3]);
                    *(u32x4*)(rowp + bj * HALF) = w; } }
        if (t == 3) {
#pragma unroll
            for (int bj = 0; bj < 2; ++bj)
#pragma unroll
                for (int n = 0; n < 2; ++n) { f32x4 s = (f32x4){0.f, 0.f, 0.f, 0.f};
#pragma unroll
                    for (int ai = 0; ai < 2; ++ai)
#pragma unroll
                        for (int m = 0; m < 4; ++m) s += acc[ai][bj][m][n];
#pragma unroll
                    for (int o = 1; o < 16; o <<= 1) { s[0] += __shfl_xor(s[0], o); s[1] += __shfl_xor(s[1], o); s[2] += __shfl_xor(s[2], o); s[3] += __shfl_xor(s[3], o); }
                    if (fr == 0) { float* kp = kmsum + (size_t)u.pm * 512 + col0 + bj * HALF + 4 * n;
                        atomicAdd(kp + 0, s[0]); atomicAdd(kp + 1, s[1]); atomicAdd(kp + 2, s[2]); atomicAdd(kp + 3, s[3]); } }
        }
    }
};
struct EpiF32 {
    static constexpr bool PERM = false, AFTER_DRAIN = false;
    float* C; int ldc;
    __device__ __forceinline__ void operator()(const f32x4 (&acc)[2][2][4][2], const Unit& u, int wr, int wc, int fr, int fq) const {
        const int row0 = u.pm * BM + wr * 64 + fr, col0 = u.pn * BM + wc * 32 + 4 * fq;
#pragma unroll
        for (int ai = 0; ai < 2; ++ai)
#pragma unroll
            for (int m = 0; m < 4; ++m) { float* rowp = C + (size_t)(row0 + ai * HALF + m * 16) * ldc + col0;
#pragma unroll
                for (int bj = 0; bj < 2; ++bj)
#pragma unroll
                    for (int n = 0; n < 2; ++n) *(f32x4*)(rowp + bj * HALF + n * 16) = acc[ai][bj][m][n]; }
    }
};
}

namespace pg8 {
constexpr unsigned TOK_NONE = 0xffffffffu;
template <class Epi, class Sched, bool GATHER, bool ALIGN_EPI = true>
__device__ __forceinline__ void gemm_phase_g(PG8_LAS unsigned char* lds, const Gemm g, const Sched& S, const Epi& E, const PG8_LAS unsigned* toktab) {
    const int tid = threadIdx.x, wid = __builtin_amdgcn_readfirstlane(tid >> 6), lane = tid & 63, wr = wid >> 2, wc = wid & 3, fr = lane & 15, fq = lane >> 4;
    const int K = g.K, nt = K / BK;
    unsigned voffB[2]; int RA[2]; unsigned CA2[2];
#pragma unroll
    for (int i = 0; i < 2; ++i) { int R, C; stage_rc(tid * 16 + i * 8192, R, C); const int Rb = Epi::PERM ? ((R & ~31) + perm32(R & 31)) : R;
        RA[i] = R; CA2[i] = (unsigned)C * 2u; voffB[i] = (unsigned)(Rb * K + C) * 2u; }
    const size_t kstep = (size_t)(BK * 2), hstep = (size_t)HALF * K * 2, tstep = 2 * hstep;
    const unsigned ldsw = (unsigned)wid * 1024u;
    const int aoff = lds_byte(wr * 64 + fr, fq * 8), boff = lds_byte(wc * 32 + fr, fq * 8);
#define PG8_SA(b, h) (((b) * 2 + (h)) * HTB)
#define PG8_SB(b, h) ((4 + (b) * 2 + (h)) * HTB)
#define PG8_STAGE(bufoff, gbase, voff) do { _Pragma("unroll") for (int _i = 0; _i < 2; ++_i) \
        __builtin_amdgcn_global_load_lds((const unsigned*)((const char*)(gbase) + (voff)[_i]), (PG8_LAS unsigned*)(lds + (bufoff) + ldsw + _i * 8192), 16, 0, 0); } while (0)
#define PG8_LDA(dst, b, h) do { _Pragma("unroll") for (int m = 0; m < 4; ++m) _Pragma("unroll") for (int k = 0; k < 2; ++k) dst[m][k] = *(const PG8_LAS bf16x8*)(lds + PG8_SA(b, h) + aoff + m * 2048 + k * 1024); } while (0)
#define PG8_LDB(dst, b, h) do { _Pragma("unroll") for (int n = 0; n < 2; ++n) _Pragma("unroll") for (int k = 0; k < 2; ++k) dst[n][k] = *(const PG8_LAS bf16x8*)(lds + PG8_SB(b, h) + boff + n * 2048 + k * 1024); } while (0)
#define PG8_MMA(ai, bj, At, Bt) do { __builtin_amdgcn_s_setprio(1); _Pragma("unroll") for (int m = 0; m < 4; ++m) _Pragma("unroll") for (int n = 0; n < 2; ++n) _Pragma("unroll") for (int k = 0; k < 2; ++k) \
        acc[ai][bj][m][n] = __builtin_amdgcn_mfma_f32_16x16x32_bf16(Bt[n][k], At[m][k], acc[ai][bj][m][n], 0, 0, 0); __builtin_amdgcn_s_setprio(0); } while (0)
#define PG8_WAIT_V(n) asm volatile("s_waitcnt vmcnt(" #n ")" ::: "memory")
#define PG8_WAIT_L(n) asm volatile("s_waitcnt lgkmcnt(" #n ")" ::: "memory")
#define PG8_BAR __builtin_amdgcn_s_barrier()
#define PG8_SCHED __builtin_amdgcn_sched_barrier(0)
#define PG8_MKOFF(VO, UI, U) do { _Pragma("unroll") for (int _h = 0; _h < 2; ++_h) _Pragma("unroll") for (int _i = 0; _i < 2; ++_i) { \
        unsigned _row; if (GATHER) { const unsigned _t = toktab[(UI) * 256 + _h * HALF + RA[_i]]; _row = (_t == TOK_NONE) ? 0u : (_t >> 1); } else _row = (unsigned)((U).pm * BM + _h * HALF + RA[_i]); \
        VO[_h][_i] = _row * (unsigned)(K * 2) + CA2[_i]; } } while (0)
    Unit cur, nxt; int ui = 0;
    if (!S.next(0, cur)) return;
    f32x4 acc[2][2][4][2];
#pragma unroll
    for (int a = 0; a < 2; ++a)
#pragma unroll
        for (int b = 0; b < 2; ++b)
#pragma unroll
            for (int m = 0; m < 4; ++m)
#pragma unroll
                for (int n = 0; n < 2; ++n) acc[a][b][m][n] = (f32x4){0.f, 0.f, 0.f, 0.f};
    bf16x8 At[4][2], B0[2][2], B1[2][2];
    const char* Ab = (const char*)g.A; const char* cB = (const char*)g.Bt + (size_t)cur.pn * tstep;
    unsigned vc[2][2], vn[2][2];
    PG8_MKOFF(vc, 0, cur);
    PG8_STAGE(PG8_SB(0, 0), cB, voffB); PG8_STAGE(PG8_SB(0, 1), cB + hstep, voffB); PG8_STAGE(PG8_SA(0, 0), Ab, vc[0]); PG8_STAGE(PG8_SA(0, 1), Ab, vc[1]);
    if (wr == 1) PG8_BAR;
    PG8_WAIT_V(2); PG8_BAR;
    PG8_STAGE(PG8_SB(1, 0), cB + kstep, voffB); PG8_STAGE(PG8_SA(1, 0), Ab + kstep, vc[0]); PG8_STAGE(PG8_SB(1, 1), cB + hstep + kstep, voffB);
    PG8_WAIT_V(6); PG8_BAR;
    for (;;) {
        const bool has_next = S.next(ui + 1, nxt);
        const char* nB = has_next ? (const char*)g.Bt + (size_t)nxt.pn * tstep : cB;
        if (has_next) { PG8_MKOFF(vn, ui + 1, nxt); } else { vn[0][0] = vc[0][0]; vn[0][1] = vc[0][1]; vn[1][0] = vc[1][0]; vn[1][1] = vc[1][1]; }
#pragma unroll 1
        for (int t = 0; t < nt; t += 2) {
            const bool last = (t == nt - 2);
            const char* a1 = Ab + (size_t)(t + 1) * kstep;
            const char* a2 = last ? Ab : Ab + (size_t)(t + 2) * kstep; const char* b2 = last ? nB : cB + (size_t)(t + 2) * kstep;
            const char* a3 = a2 + kstep; const char* b3 = b2 + kstep;
            unsigned v2[2][2];
#pragma unroll
            for (int h = 0; h < 2; ++h)
#pragma unroll
                for (int i = 0; i < 2; ++i) v2[h][i] = last ? vn[h][i] : vc[h][i];
            PG8_LDB(B0, 0, 0); PG8_LDB(B1, 0, 1); PG8_SCHED; PG8_LDA(At, 0, 0); PG8_STAGE(PG8_SA(1, 1), a1, vc[1]);
            PG8_WAIT_V(8); PG8_WAIT_L(0); PG8_BAR; PG8_MMA(0, 0, At, B0); PG8_MMA(0, 1, At, B1); PG8_BAR; PG8_SCHED;
            PG8_LDA(At, 0, 1); PG8_STAGE(PG8_SB(0, 0), b2, voffB); PG8_STAGE(PG8_SB(0, 1), b2 + hstep, voffB); PG8_STAGE(PG8_SA(0, 0), a2, v2[0]);
            PG8_WAIT_V(8); PG8_WAIT_L(0); PG8_BAR; PG8_MMA(1, 0, At, B0); PG8_MMA(1, 1, At, B1); PG8_BAR; PG8_SCHED;
            PG8_LDB(B0, 1, 0); PG8_LDB(B1, 1, 1); PG8_SCHED; PG8_LDA(At, 1, 0); PG8_STAGE(PG8_SA(0, 1), a2, v2[1]);
            PG8_WAIT_V(8); PG8_WAIT_L(0); PG8_BAR; PG8_MMA(0, 0, At, B0); PG8_MMA(0, 1, At, B1); PG8_BAR; PG8_SCHED;
            PG8_LDA(At, 1, 1); PG8_STAGE(PG8_SB(1, 0), b3, voffB); PG8_STAGE(PG8_SB(1, 1), b3 + hstep, voffB); PG8_STAGE(PG8_SA(1, 0), a3, v2[0]);
            PG8_WAIT_V(8); PG8_WAIT_L(0); PG8_BAR; PG8_MMA(1, 0, At, B0); PG8_MMA(1, 1, At, B1); PG8_BAR; PG8_SCHED;
        }
        if constexpr (ALIGN_EPI) { if (wr == 0) PG8_BAR; }
        E(acc, cur, ui, wr, wc, fr, fq);
        if (!has_next) break;
#pragma unroll
        for (int a = 0; a < 2; ++a)
#pragma unroll
            for (int b = 0; b < 2; ++b)
#pragma unroll
                for (int m = 0; m < 4; ++m)
#pragma unroll
                    for (int n = 0; n < 2; ++n) acc[a][b][m][n] = (f32x4){0.f, 0.f, 0.f, 0.f};
        cur = nxt; cB = nB; ++ui;
#pragma unroll
        for (int h = 0; h < 2; ++h)
#pragma unroll
            for (int i = 0; i < 2; ++i) vc[h][i] = vn[h][i];
        if constexpr (ALIGN_EPI) { if (wr == 1) PG8_BAR; }
    }
    PG8_WAIT_V(0);
    if constexpr (!ALIGN_EPI) { if (wr == 0) PG8_BAR; }
    PG8_BAR;
#undef PG8_SA
#undef PG8_SB
#undef PG8_STAGE
#undef PG8_LDA
#undef PG8_LDB
#undef PG8_MMA
#undef PG8_WAIT_V
#undef PG8_WAIT_L
#undef PG8_BAR
#undef PG8_SCHED
#undef PG8_MKOFF
}
struct MoeOrder {
    const PG8_LAS unsigned* toff; int nct, G, c;
    __device__ __forceinline__ bool next(int i, Unit& u) const {
        const int L = i * G + c; const int total = (int)toff[32] * nct; if (L >= total) return false;
        const int rt = L / nct, ct = L % nct; int e = 0; while ((int)toff[e + 1] <= rt) ++e;
        u.pm = rt; u.pn = e * nct + ct; return true;
    }
};
struct EpiMoeUp {
    static constexpr bool PERM = true, AFTER_DRAIN = false;
    bf16_t* H; const float* RW; const PG8_LAS unsigned* toktab;
    __device__ __forceinline__ void operator()(const f32x4 (&acc)[2][2][4][2], const Unit& u, int ui, int wr, int wc, int fr, int fq) const {
        const int col0 = (u.pn & 1) * HALF + wc * 32 + 8 * fq;
#pragma unroll
        for (int ai = 0; ai < 2; ++ai)
#pragma unroll
            for (int m = 0; m < 4; ++m) { const int r = ai * HALF + wr * 64 + m * 16 + fr; const unsigned tk = toktab[ui * 256 + r]; const float w = (tk != TOK_NONE) ? RW[tk] : 0.f;
                float h[8];
#pragma unroll
                for (int n = 0; n < 2; ++n)
#pragma unroll
                    for (int j = 0; j < 4; ++j) { const float a = acc[ai][0][m][n][j], b = acc[ai][1][m][n][j]; h[4 * n + j] = a / (1.f + __expf(-a)) * b * w; }
                u32x4 o; o.x = cvt_pk_bf16(h[0], h[1]); o.y = cvt_pk_bf16(h[2], h[3]); o.z = cvt_pk_bf16(h[4], h[5]); o.w = cvt_pk_bf16(h[6], h[7]);
                *(u32x4*)(H + (size_t)(u.pm * BM + r) * 256 + col0) = o; }
    }
};
struct EpiMoeDown {
    static constexpr bool PERM = true, AFTER_DRAIN = false;
    bf16_t* YS; bf16_t* dump; const PG8_LAS unsigned* toktab;
    __device__ __forceinline__ void operator()(const f32x4 (&acc)[2][2][4][2], const Unit& u, int ui, int wr, int wc, int fr, int fq) const {
        const int col0 = (u.pn & 3) * BM + wc * 32 + 8 * fq;
#pragma unroll
        for (int ai = 0; ai < 2; ++ai)
#pragma unroll
            for (int m = 0; m < 4; ++m) { const int r = ai * HALF + wr * 64 + m * 16 + fr; const unsigned tk = toktab[ui * 256 + r];
                bf16_t* rowp = ((tk != TOK_NONE) ? YS + (size_t)tk * 1024 : dump) + col0;
#pragma unroll
                for (int bj = 0; bj < 2; ++bj) { const f32x4 v0 = acc[ai][bj][m][0], v1 = acc[ai][bj][m][1];
                    u32x4 o; o.x = cvt_pk_bf16(v0[0], v0[1]); o.y = cvt_pk_bf16(v0[2], v0[3]); o.z = cvt_pk_bf16(v1[0], v1[1]); o.w = cvt_pk_bf16(v1[2], v1[3]);
                    *(u32x4*)(rowp + bj * HALF) = o; }
                asm volatile("" ::: "memory"); }
    }
};
}

#include <hip/hip_bf16.h>
#include <cmath>
namespace attn_body {
using bf16=__hip_bfloat16;
using bf16x8=__attribute__((ext_vector_type(8)))short;
using s16x4=__attribute__((ext_vector_type(4)))short;
using f32x16=__attribute__((ext_vector_type(16)))float;
using u32x4=__attribute__((ext_vector_type(4)))unsigned;
constexpr int BATCH=4,NHEAD=8,SEQ=4096,D=64,DM=NHEAD*D;
constexpr int NW=8,QBLK=32,QB=QBLK*NW,KVBLK=64,NQB=SEQ/QB;
constexpr int ATTN_PITCH=DM, ATTN_UNIT_ROWS=QB;
__device__ __forceinline__ int crow(int r,int hi){return (r&3)+8*(r>>2)+4*hi;}
#define SBAR() __builtin_amdgcn_sched_barrier(0)
__device__ __forceinline__ void maskbias(f32x16&p0,f32x16&p1,int relbase,int hi,const __attribute__((address_space(3))) float*RT){
  const __attribute__((address_space(3))) float*p=RT+(511-relbase+4*hi);
  #pragma unroll
  for(int r=0;r<16;++r){ p0[r]+=p[(r&3)+8*(r>>2)]; p1[r]+=p[32+(r&3)+8*(r>>2)]; if((r&3)==3)__builtin_amdgcn_sched_barrier(0); }
}

constexpr int NSLOT=3, SLOTB=8192;
constexpr int LDS_K=0, LDS_V=NSLOT*SLOTB, LDS_WS=2*NSLOT*SLOTB, LDS_OST=LDS_WS+NW*64*4, LDS_KM=LDS_OST+NW*4096, LDS_BT=LDS_KM+4096, LDS_BYTES=LDS_BT+3072;
constexpr float C2=0.125f*1.4426950408889634f;
__device__ __forceinline__ void glds16(const void*gsrc,unsigned lds_dst){unsigned keep;
  asm volatile("s_mov_b32 %0, m0\n\ts_mov_b32 m0, %2\n\ts_nop 0\n\tglobal_load_lds_dwordx4 %1, off\n\ts_mov_b32 m0, %0":"=&s"(keep):"v"(gsrc),"s"(lds_dst):"memory");}
__device__ __forceinline__ float max3f(float a,float b,float c){float r;asm("v_max3_f32 %0, %1, %2, %3":"=v"(r):"v"(a),"v"(b),"v"(c));return r;}
__device__ __forceinline__ float max2f(float a,float b){float r;asm("v_max_f32_e32 %0, %1, %2":"=v"(r):"v"(a),"v"(b));return r;}
__device__ __forceinline__ float fadd_s(float a,float b){float r;asm("v_add_f32_e32 %0, %1, %2":"=v"(r):"v"(a),"v"(b));return r;}
__device__ __forceinline__ float fsub_s(float a,float b){float r;asm("v_sub_f32_e32 %0, %1, %2":"=v"(r):"v"(a),"v"(b));return r;}
typedef float f32x4_t __attribute__((ext_vector_type(4))); typedef float f32x2_t __attribute__((ext_vector_type(2))); typedef __bf16 bf16x2_t __attribute__((ext_vector_type(2)));
__device__ __forceinline__ unsigned cvtpk_s(float lo,float hi){f32x2_t v={lo,hi};bf16x2_t b=__builtin_convertvector(v,bf16x2_t);return __builtin_bit_cast(unsigned,b);}
#define WAIT_BAR(N) asm volatile("s_waitcnt vmcnt(" #N ") lgkmcnt(0)\n\ts_barrier":::"memory")

__device__ __forceinline__ void qkt(f32x16&p0,f32x16&p1,const char*Kslot,const bf16x8*qr,int r32,int hi){
  const char*kb=Kslot+hi*1024+r32*16;
  #pragma unroll
  for(int d0=0;d0<4;++d0){
    const bf16x8 b0=*reinterpret_cast<const bf16x8*>(kb+d0*2048);
    const bf16x8 b1=*reinterpret_cast<const bf16x8*>(kb+d0*2048+512);
    if(d0==0){p0=__builtin_amdgcn_mfma_f32_32x32x16_bf16(b0,qr[0],f32x16{},0,0,0);p1=__builtin_amdgcn_mfma_f32_32x32x16_bf16(b1,qr[0],f32x16{},0,0,0);}
    else{p0=__builtin_amdgcn_mfma_f32_32x32x16_bf16(b0,qr[d0],p0,0,0,0);p1=__builtin_amdgcn_mfma_f32_32x32x16_bf16(b1,qr[d0],p1,0,0,0);}}
}
typedef __attribute__((address_space(3))) const char* lds_cptr;
typedef short v4i16_t __attribute__((ext_vector_type(4)));
__device__ __forceinline__ void kload8(bf16x8*kf,lds_cptr kp){
  kf[0]=*(const __attribute__((address_space(3))) bf16x8*)(kp);      kf[1]=*(const __attribute__((address_space(3))) bf16x8*)(kp+512);
  kf[2]=*(const __attribute__((address_space(3))) bf16x8*)(kp+2048); kf[3]=*(const __attribute__((address_space(3))) bf16x8*)(kp+2560);
  kf[4]=*(const __attribute__((address_space(3))) bf16x8*)(kp+4096); kf[5]=*(const __attribute__((address_space(3))) bf16x8*)(kp+4608);
  kf[6]=*(const __attribute__((address_space(3))) bf16x8*)(kp+6144); kf[7]=*(const __attribute__((address_space(3))) bf16x8*)(kp+6656);
}
__device__ __forceinline__ void kload2(bf16x8*kf,lds_cptr kp,int j){ kf[2*j]=*(const __attribute__((address_space(3))) bf16x8*)(kp+j*2048); kf[2*j+1]=*(const __attribute__((address_space(3))) bf16x8*)(kp+j*2048+512); }
__device__ __forceinline__ s16x4 vtr(lds_cptr p){ return __builtin_bit_cast(s16x4,__builtin_amdgcn_ds_read_tr16_b64_v4i16((__attribute__((address_space(3))) v4i16_t*)p)); }
__device__ __forceinline__ float rowmax(const f32x16&p0,const f32x16&p1){
  float a=max3f(p0[0],p0[1],p1[0]),b=max3f(p0[2],p0[3],p1[1]);a=max3f(a,p1[2],p1[3]);
  #pragma unroll
  for(int r=4;r<16;r+=4){a=max3f(a,p0[r],p0[r+1]);b=max3f(b,p0[r+2],p0[r+3]);a=max3f(a,p1[r],p1[r+1]);b=max3f(b,p1[r+2],p1[r+3]);}
  const float m=max2f(a,b);
  auto rr=__builtin_amdgcn_permlane32_swap(__float_as_uint(m),__float_as_uint(m),false,false);
  return max2f(__uint_as_float(rr[0]),__uint_as_float(rr[1]));
}
__device__ __forceinline__ void pv(f32x16*o,int vb,bf16x8 pa0,bf16x8 pa1,bf16x8 pa2,bf16x8 pa3){
  #pragma unroll
  for(int d0=0;d0<2;++d0){s16x4 lo[4],hi[4];
    #pragma unroll
    for(int ks=0;ks<4;++ks){
      asm volatile("ds_read_b64_tr_b16 %0,%1 offset:%c2":"=&v"(lo[ks]):"v"(vb),"i"(d0*4096+ks*1024):"memory");
      asm volatile("ds_read_b64_tr_b16 %0,%1 offset:%c2":"=&v"(hi[ks]):"v"(vb),"i"(d0*4096+ks*1024+512):"memory");}
    asm volatile("s_waitcnt lgkmcnt(0)":::"memory");SBAR();
    #define PK(k) (bf16x8){lo[k][0],lo[k][1],lo[k][2],lo[k][3],hi[k][0],hi[k][1],hi[k][2],hi[k][3]}
    o[d0]=__builtin_amdgcn_mfma_f32_32x32x16_bf16(pa0,PK(0),o[d0],0,0,0);
    o[d0]=__builtin_amdgcn_mfma_f32_32x32x16_bf16(pa1,PK(1),o[d0],0,0,0);
    o[d0]=__builtin_amdgcn_mfma_f32_32x32x16_bf16(pa2,PK(2),o[d0],0,0,0);
    o[d0]=__builtin_amdgcn_mfma_f32_32x32x16_bf16(pa3,PK(3),o[d0],0,0,0);
    #undef PK
  }
}

#ifndef ATTN_STORE16
#define ATTN_STORE16(p,v) (*(u32x4*)(p)=(v))
#endif
template<int THRL> __device__ __forceinline__ void attn_unit(int b,int h,int qb,const bf16*Q,const bf16*__restrict__ K,const bf16*__restrict__ V,bf16*O,const float*kmsum,const float*rel_bias,const unsigned char*t5b,char*shm){
  const int tid=threadIdx.x,lane=tid&63,r32=lane&31,hi=lane>>5; const int wid=__builtin_amdgcn_readfirstlane(tid>>6);
  const long rowbase=(long)b*SEQ; const int q0=qb*QB;
  const bf16*Qw=Q+(rowbase+q0+wid*QBLK)*DM+h*D;
  const bf16*Kh=K+rowbase*DM+h*D,*Vh=V+rowbase*DM+h*D;
  typedef __attribute__((address_space(3))) char* lds_wptr; const lds_wptr shm3=(lds_wptr)shm;
  const unsigned lds0=(unsigned)(uintptr_t)shm;
  float*wsf=(float*)(shm+LDS_WS)+wid*64;
  const bf16*ksrc=Kh+(long)lane*DM+wid*8;
  const bf16*vsrc=Vh+(long)(16*(wid&3)+(lane>>2))*DM+(wid>>2)*32+(lane&3)*8;
  const unsigned kdst=lds0+LDS_K+wid*1024, vdst=lds0+LDS_V+wid*1024;
  #define TMAP(t) (((t)<4)?(4*qb+(t)):((t)-4))
  #define DMA_K(t,slot) glds16(ksrc+(long)TMAP(t)*KVBLK*DM,(unsigned)__builtin_amdgcn_readfirstlane(kdst+(slot)))
  #define DMA_V(t,slot) glds16(vsrc+(long)TMAP(t)*KVBLK*DM,(unsigned)__builtin_amdgcn_readfirstlane(vdst+(slot)))
  const int vb0=(int)(lds0+LDS_V)+((lane>>4)&1)*32+(lane&3)*8+(4*hi+((lane&15)>>2))*64;
  const char*Kbase=shm+LDS_K; bf16x8 kf[8];
  const lds_cptr kp0=shm3+LDS_K+hi*1024+r32*16; const lds_cptr vp0=shm3+LDS_V+((lane>>4)&1)*32+(lane&3)*8+(4*hi+((lane&15)>>2))*64;
  const int NT=(q0+QB)/KVBLK;
  {
    if(tid<256){ const int jb_=tid>>4,d4_=(tid&15)*4; *(__attribute__((address_space(3))) f32x4_t*)(shm3+LDS_KM+tid*16)=*(const f32x4_t*)(kmsum+((long)(b*(SEQ/QB)+jb_)*DM+h*D+d4_)); }
    for(int k_=tid;k_<767;k_+=NW*64){ const int rel_=511-k_; float v_=0.f; if(rel_<0)v_=-INFINITY; else if(rel_<113)v_=(rel_bias[(int)t5b[rel_]*NHEAD+h]-rel_bias[31*NHEAD+h])*1.4426950408889634f;
      ((__attribute__((address_space(3))) float*)(shm3+LDS_BT))[k_]=v_; } }
  DMA_K(0,0);DMA_V(0,0);DMA_K(1,SLOTB);
  bf16x8 qr[4];
  #pragma unroll
  for(int d0=0;d0<4;++d0)qr[d0]=*reinterpret_cast<const bf16x8*>(&Qw[(long)r32*DM+d0*16+hi*8]);
  float mhat=0.f,l_reg=0.f;f32x16 o[2];o[0]=f32x16{};o[1]=f32x16{};
  const int qrel=wid*QBLK+r32;
  #define CMASK(P0,P1,t) do{ const int t_=(t); if(t_<4){ if(32*wid-64*t_-63<113) maskbias(P0,P1,qrel-64*t_,hi,BT); } \
    else if(((t_-4)>>2)==qb-1){ const int ko_=256-64*((t_-4)&3); if(32*wid+ko_-63<113) maskbias(P0,P1,qrel+ko_,hi,BT); } }while(0)
  bool resc=false;
  #define START(P0,P1) do{ const float rm=rowmax(P0,P1); resc=false; \
    { const float dl=rm; mhat=fadd_s(mhat,dl); \
      _Pragma("unroll") for(int r=0;r<16;++r){P0[r]=fsub_s(P0[r],dl);P1[r]=fsub_s(P1[r],dl);} \
      } \
    _Pragma("unroll") for(int r=0;r<16;++r)P0[r]=__builtin_amdgcn_exp2f(P0[r]); }while(0)
  #define RESC() do{ if(resc){ asm volatile("s_waitcnt lgkmcnt(0)":::"memory"); \
      _Pragma("unroll") for(int d_=0;d_<2;++d_) _Pragma("unroll") for(int r=0;r<16;++r)o[d_][r]*=wsf[crow(r,hi)]; } }while(0)
  f32x16 pA0,pA1,pB0,pB1;
  int sl_prev=0,sl_cur=0,sl_next=SLOTB;
  #define ROT() do{sl_prev=sl_cur;sl_cur=sl_next;sl_next=(sl_next==(NSLOT-1)*SLOTB)?0:sl_next+SLOTB;}while(0)
  DMA_K(2,2*SLOTB);
  WAIT_BAR(3);
  unsigned selmask;
  { const __attribute__((address_space(3))) float*KM=(const __attribute__((address_space(3))) float*)(shm3+LDS_KM);
    float v0=-INFINITY,v1=-INFINITY,v2=-INFINITY;int i0=0,i1=0,i2=0;
    #define QF(d0,j) __builtin_bit_cast(float,(unsigned)(unsigned short)qr[d0][j]<<16)
    #pragma unroll 1
    for(int jb=0;jb<qb;++jb){ float g=0.f;
      #pragma unroll
      for(int d0=0;d0<4;++d0){ const f32x4_t ka=*(const __attribute__((address_space(3))) f32x4_t*)(KM+jb*64+16*d0+8*hi), kb2=*(const __attribute__((address_space(3))) f32x4_t*)(KM+jb*64+16*d0+8*hi+4);
        g+=QF(d0,0)*ka[0]+QF(d0,1)*ka[1]+QF(d0,2)*ka[2]+QF(d0,3)*ka[3]+QF(d0,4)*kb2[0]+QF(d0,5)*kb2[1]+QF(d0,6)*kb2[2]+QF(d0,7)*kb2[3]; }
    #undef QF
      g+=__shfl_xor(g,32);
      if(g>v0){v2=v1;i2=i1;v1=v0;i1=i0;v0=g;i0=jb;} else if(g>v1){v2=v1;i2=i1;v1=g;i1=jb;} else if(g>v2){v2=g;i2=jb;} }
    selmask=(qb>=3)?((1u<<i0)|(1u<<i1)|(1u<<i2)):((1u<<qb)-1u); }
  const __attribute__((address_space(3))) float*BT=(const __attribute__((address_space(3))) float*)(shm3+LDS_BT);
  qkt(pA0,pA1,Kbase,qr,r32,hi);asm volatile("s_nop 15\n\ts_nop 7":"+v"(pA0),"+v"(pA1));CMASK(pA0,pA1,0);
  START(pA0,pA1);
  _Pragma("unroll") for(int r=0;r<16;++r)pA1[r]=__builtin_amdgcn_exp2f(pA1[r]);
  WAIT_BAR(0);
  DMA_K(3,0);DMA_V(1,SLOTB);
  ROT();
  kload8(kf,kp0+sl_cur);
  WAIT_BAR(2);
  s16x4 vlo[8],vhi[8]; u32x4 pw0,pw1,pw2,pw3;
  #define PKW(P,B) cvtpk_s(P[B],P[B+1])
  #define PAF(k) __builtin_bit_cast(bf16x8,pw##k)
  #define VFR(i) (bf16x8){vlo[i][0],vlo[i][1],vlo[i][2],vlo[i][3],vhi[i][0],vhi[i][1],vhi[i][2],vhi[i][3]}
  #define PIN(x) asm volatile("":"+v"(x))
  #define MX3(a,b,c) __builtin_fmaxf(__builtin_fmaxf((a),(b)),(c))
  #define GAPA(MF,A0,A1,A2,A3,W0,W1,PW) do{ MF; sacc+=A0; sacc+=A1; sacc+=A2; sacc+=A3; PIN(sacc); W0; W1; PIN(PW); SBAR(); }while(0)
  #define EX(v) __builtin_amdgcn_exp2f(v)
  #define GAPB(MF,X,B) do{ MF; X[B]=EX(X[B]); X[B+1]=EX(X[B+1]); X[B+2]=EX(X[B+2]); X[B+3]=EX(X[B+3]); PIN(X); SBAR(); }while(0)
  #define VRD(i) do{ vlo[i]=vtr(vp_+(((i)>>2)*4096+((i)&3)*1024)); vhi[i]=vtr(vp_+(((i)>>2)*4096+((i)&3)*1024+512)); }while(0)
  #define KRD(G,j) do{ if(G){ kload2(kf,kp0+sl_next,j); SBAR(); } }while(0)
  #define STEP(C0,C1,P0,P1,t,GK,GV,GL) do{ SBAR(); \
    const lds_cptr vp_=vp0+sl_prev; \
    VRD(0); SBAR(); float sacc=(P0[0]+P0[1]); \
    GAPA(C0=__builtin_amdgcn_mfma_f32_32x32x16_bf16(kf[0],qr[0],f32x16{},0,0,0), P0[2],P0[3],P0[4],P0[5],     pw0[0]=PKW(P0,0), pw0[1]=PKW(P0,2), pw0); \
    VRD(4); SBAR(); GAPA(C1=__builtin_amdgcn_mfma_f32_32x32x16_bf16(kf[1],qr[0],f32x16{},0,0,0), P0[6],P0[7],P0[8],P0[9],     pw0[2]=PKW(P0,4), pw0[3]=PKW(P0,6), pw0); \
    VRD(1); SBAR(); GAPA(C0=__builtin_amdgcn_mfma_f32_32x32x16_bf16(kf[2],qr[1],C0,0,0,0),   P0[10],P0[11],P0[12],P0[13], pw1[0]=PKW(P0,8), pw1[1]=PKW(P0,10), pw1); \
    VRD(5); SBAR(); GAPA(C1=__builtin_amdgcn_mfma_f32_32x32x16_bf16(kf[3],qr[1],C1,0,0,0),   P0[14],P0[15],P1[0],P1[1],   pw1[2]=PKW(P0,12),pw1[3]=PKW(P0,14), pw1); \
    VRD(2); SBAR(); GAPA(C0=__builtin_amdgcn_mfma_f32_32x32x16_bf16(kf[4],qr[2],C0,0,0,0),   P1[2],P1[3],P1[4],P1[5],     pw2[0]=PKW(P1,0), pw2[1]=PKW(P1,2), pw2); \
    VRD(6); SBAR(); GAPA(C1=__builtin_amdgcn_mfma_f32_32x32x16_bf16(kf[5],qr[2],C1,0,0,0),   P1[6],P1[7],P1[8],P1[9],     pw2[2]=PKW(P1,4), pw2[3]=PKW(P1,6), pw2); \
    VRD(3); SBAR(); GAPA(C0=__builtin_amdgcn_mfma_f32_32x32x16_bf16(kf[6],qr[3],C0,0,0,0),   P1[10],P1[11],P1[12],P1[13], pw3[0]=PKW(P1,8), pw3[1]=PKW(P1,10), pw3); \
    VRD(7); SBAR(); GAPA(C1=__builtin_amdgcn_mfma_f32_32x32x16_bf16(kf[7],qr[3],C1,0,0,0),   P1[14],P1[15],0.f,0.f,       pw3[2]=PKW(P1,12),pw3[3]=PKW(P1,14), pw3); \
    l_reg+=sacc; \
    if(GK){DMA_K((t)+3,sl_cur);} if(GV){DMA_V((t)+1,sl_next);} \
    { const int tq_=(t); const bool sel_=(tq_<4)||((selmask>>((tq_-4)>>2))&1u); const float nm_=sel_?-mhat:-INFINITY; \
      _Pragma("unroll") for(int r=0;r<16;++r){C0[r]+=nm_;C1[r]+=nm_;} } \
    CMASK(C0,C1,t); \
    { float a=MX3(C0[0],C0[1],C1[0]),b=MX3(C0[2],C0[3],C1[1]); a=MX3(a,C1[2],C1[3]); \
      _Pragma("unroll") for(int r=4;r<16;r+=4){a=MX3(a,C0[r],C0[r+1]);b=MX3(b,C0[r+2],C0[r+3]);a=MX3(a,C1[r],C1[r+1]);b=MX3(b,C1[r+2],C1[r+3]);} \
      float rm=__builtin_fmaxf(a,b); { auto rr=__builtin_amdgcn_permlane32_swap(__float_as_uint(rm),__float_as_uint(rm),false,false); rm=__builtin_fmaxf(__uint_as_float(rr[0]),__uint_as_float(rr[1])); } \
      resc=false; \
      if(__builtin_expect(__any(rm>(float)THRL),0)){ const float dl=__builtin_fmaxf(rm,0.f); mhat+=dl; \
        _Pragma("unroll") for(int r=0;r<16;++r){C0[r]-=dl;C1[r]-=dl;} \
        const float f=__builtin_amdgcn_exp2f(-dl); l_reg*=f; if(hi==0)wsf[r32]=f; resc=true; } \
      } \
    SBAR(); \
    GAPB(o[0]=__builtin_amdgcn_mfma_f32_32x32x16_bf16(PAF(0),VFR(0),o[0],0,0,0), C0,0); \
    GAPB(o[1]=__builtin_amdgcn_mfma_f32_32x32x16_bf16(PAF(0),VFR(4),o[1],0,0,0), C0,4); \
    KRD(GL,0); GAPB(o[0]=__builtin_amdgcn_mfma_f32_32x32x16_bf16(PAF(1),VFR(1),o[0],0,0,0), C0,8); \
    KRD(GL,1); GAPB(o[1]=__builtin_amdgcn_mfma_f32_32x32x16_bf16(PAF(1),VFR(5),o[1],0,0,0), C0,12); \
    KRD(GL,2); GAPB(o[0]=__builtin_amdgcn_mfma_f32_32x32x16_bf16(PAF(2),VFR(2),o[0],0,0,0), C1,0); \
    KRD(GL,3); GAPB(o[1]=__builtin_amdgcn_mfma_f32_32x32x16_bf16(PAF(2),VFR(6),o[1],0,0,0), C1,4); \
    GAPB(o[0]=__builtin_amdgcn_mfma_f32_32x32x16_bf16(PAF(3),VFR(3),o[0],0,0,0), C1,8); \
    GAPB(o[1]=__builtin_amdgcn_mfma_f32_32x32x16_bf16(PAF(3),VFR(7),o[1],0,0,0), C1,12); \
    }while(0)
  int t=1;
  for(;t+5<NT;t+=2){
    STEP(pB0,pB1,pA0,pA1,t,true,true,true);     WAIT_BAR(2); RESC(); ROT();
    STEP(pA0,pA1,pB0,pB1,t+1,true,true,true);   WAIT_BAR(2); RESC(); ROT();
  }
  #define ENDW(tt) do{ if((tt)+3<NT){WAIT_BAR(2);} else if((tt)+2<NT){WAIT_BAR(1);} else {WAIT_BAR(0);} }while(0)
  for(;t+1<NT;t+=2){
    STEP(pB0,pB1,pA0,pA1,t,(t+3<NT),(t+1<NT),(t+1<NT));       ENDW(t);   RESC(); ROT();
    STEP(pA0,pA1,pB0,pB1,t+1,(t+4<NT),(t+2<NT),(t+2<NT));     ENDW(t+1); RESC(); ROT();
  }
  STEP(pB0,pB1,pA0,pA1,NT-1,false,false,false); RESC();
  { float sacc=pB0[0]+pB0[1]; _Pragma("unroll") for(int r=2;r<16;++r)sacc+=pB0[r]; _Pragma("unroll") for(int r=0;r<16;++r)sacc+=pB1[r]; l_reg+=sacc;
    pw0=(u32x4){PKW(pB0,0),PKW(pB0,2),PKW(pB0,4),PKW(pB0,6)};pw1=(u32x4){PKW(pB0,8),PKW(pB0,10),PKW(pB0,12),PKW(pB0,14)};pw2=(u32x4){PKW(pB1,0),PKW(pB1,2),PKW(pB1,4),PKW(pB1,6)};pw3=(u32x4){PKW(pB1,8),PKW(pB1,10),PKW(pB1,12),PKW(pB1,14)};
    SBAR(); pv(o,vb0+sl_cur,PAF(0),PAF(1),PAF(2),PAF(3)); }
  #undef PKW
  #undef PAF
  #undef VFR
  #undef PIN
  #undef MX3
  #undef GAPA
  #undef GAPB
  #undef EX
  #undef VRD
  #undef KRD
  #undef STEP
  #undef ENDW
  {auto rr=__builtin_amdgcn_permlane32_swap(__float_as_uint(l_reg),__float_as_uint(l_reg),false,false);l_reg=__uint_as_float(rr[0])+__uint_as_float(rr[1]);}
  if(hi==0)wsf[32+r32]=l_reg;asm volatile("s_waitcnt lgkmcnt(0)":::"memory");
  float rli[16];
  #pragma unroll
  for(int r=0;r<16;++r)rli[r]=__builtin_amdgcn_rcpf(wsf[32+crow(r,hi)]);
  bf16*Ow=O+(rowbase+q0+wid*QBLK)*DM+h*D;
  { bf16*stg=(bf16*)(shm+LDS_OST)+wid*2048;
    #pragma unroll
    for(int r=0;r<16;++r){const int orow=crow(r,hi);
      #pragma unroll
      for(int d0=0;d0<2;++d0)stg[orow*64+d0*32+r32]=__float2bfloat16(o[d0][r]*rli[r]);}
    asm volatile("s_waitcnt lgkmcnt(0)":::"memory");
    #pragma unroll
    for(int i=0;i<4;++i){const int row=i*8+(lane>>3),ch=lane&7; const u32x4 v=*(const u32x4*)(stg+row*64+ch*8); ATTN_STORE16(Ow+(long)row*DM+ch*8,v);} }
  asm volatile("s_waitcnt lgkmcnt(0)\n\ts_barrier":::"memory");
  #undef DMA_K
  #undef DMA_V
  #undef TMAP
  #undef CMASK
  #undef START
  #undef RESC
  #undef ROT
}
constexpr int ATTN_LDS_BYTES=LDS_BYTES;
struct AttnTensors { const bf16* Q; const bf16* K; const bf16* V; bf16* O; const float* kmsum; const float* rel_bias; const unsigned char* t5b; };
struct AttnUnit { int bh; int qb; };
struct StaticOrder {
  int vcu,G;
  __device__ __forceinline__ explicit StaticOrder(int grid,int vcu_):vcu(vcu_),G(grid){}
  __device__ __forceinline__ bool next(int i,AttnUnit&u)const{ const int w=i*G+vcu; if(w>=512)return false; const int s=w&7; u.bh=(w&255)>>3; u.qb=(w<256)?s:15-s; return true; }
  __device__ __forceinline__ void a_ready(const AttnUnit&)const{}
  __device__ __forceinline__ void done(const AttnUnit&)const{}
};
template<class Sched,int THRL=8> __device__ __forceinline__ void attn_phase(char*lds,const AttnTensors&T,const Sched&S){
  AttnUnit u;
  for(int i=0;S.next(i,u);++i){ S.a_ready(u); attn_unit<THRL>(u.bh/NHEAD,u.bh%NHEAD,u.qb,T.Q,T.K,T.V,T.O,T.kmsum,T.rel_bias,T.t5b,lds); S.done(u); }
}
#undef SBAR
#undef WAIT_BAR
}

#define GAS __attribute__((address_space(1)))
#define LAS __attribute__((address_space(3)))
typedef unsigned short bf16;
typedef unsigned v4u __attribute__((ext_vector_type(4)));
typedef float f32x4 __attribute__((ext_vector_type(4)));
typedef short bf16x8 __attribute__((ext_vector_type(8)));
typedef GAS unsigned gu32;
typedef GAS unsigned long long gu64;
#define RLX_AGENT __ATOMIC_RELAXED, __HIP_MEMORY_SCOPE_AGENT
#define LDS_WAIT() asm volatile("s_waitcnt lgkmcnt(0)" ::: "memory")
#define VM_WAIT() asm volatile("s_waitcnt vmcnt(0)" ::: "memory")
__device__ __forceinline__ unsigned long long rt() { return __builtin_amdgcn_s_memrealtime(); }
__device__ __forceinline__ unsigned f2bf(float f) { unsigned u = __builtin_bit_cast(unsigned, f); return (u + 0x7fffu + ((u >> 16) & 1u)) >> 16; }
__device__ __forceinline__ unsigned pk2(float lo, float hi) { return f2bf(lo) | (f2bf(hi) << 16); }


#define XB_TMO      128
#define XB_XCNT(j)  (256  + 64 * (j))
#define XB_XSUB(j)  (1280 + 64 * (j))
#define XB_XGEN(j)  (2304 + 64 * (j))
#define XB_TOP      3328
#define XB_TOPGEN   3392
#define XCD_BAR_WORDS 3456
#define XB_SPIN_CAP (1u << 18)

__device__ __forceinline__ unsigned xb_ld(unsigned* p)              { return __hip_atomic_load(p, __ATOMIC_RELAXED, __HIP_MEMORY_SCOPE_AGENT); }
__device__ __forceinline__ unsigned xb_add(unsigned* p, unsigned v) { return __hip_atomic_fetch_add(p, v, __ATOMIC_RELAXED, __HIP_MEMORY_SCOPE_AGENT); }
__device__ __forceinline__ unsigned xb_xcc_id() { return (unsigned)__builtin_amdgcn_s_getreg((3 << 11) | 20) & 0xFu; }
#define XB_SPIN(cond, bar) do { unsigned _sp = 0; while (cond) { __builtin_amdgcn_s_sleep(1); \
    if ((++_sp & 255u) == 0u) { if (xb_ld(&(bar)[XB_TMO])) break; if (_sp > XB_SPIN_CAP) { atomicAdd(&(bar)[XB_TMO], 1u); break; } } } } while (0)

struct XcdBarrier {
    unsigned* bar; unsigned x;
    volatile LAS unsigned* st;
};

__device__ __forceinline__ XcdBarrier xcd_barrier_post(unsigned* bar, volatile LAS unsigned* st) {
    XcdBarrier b; b.bar = bar; b.x = xb_xcc_id(); b.st = st;
    if (threadIdx.x == 0) (void)xb_add(&bar[XB_XCNT(b.x)], 1u);
    return b;
}
__device__ __forceinline__ void xcd_barrier_complete(unsigned* bar, unsigned x, unsigned& nloc, unsigned& nx) {
    const unsigned G = gridDim.x * gridDim.y * gridDim.z;
    unsigned sum, cnt, mine, sp = 0u;
    for (;;) {
        sum = 0u; cnt = 0u; mine = 0u;
#pragma unroll
        for (unsigned j = 0; j < 16; ++j) { const unsigned c = xb_ld(&bar[XB_XCNT(j)]); sum += c; cnt += (c > 0u) ? 1u : 0u; mine = (j == x) ? c : mine; }
        if (sum == G) break;
        __builtin_amdgcn_s_sleep(1);
        if ((++sp & 255u) == 0u) { if (xb_ld(&bar[XB_TMO])) break; if (sp > XB_SPIN_CAP) { atomicAdd(&bar[XB_TMO], 1u); break; } }
    }
    nloc = mine > 0u ? mine : 1u; nx = cnt > 0u ? cnt : 1u;
}

__device__ __forceinline__ void xcd_barrier(const XcdBarrier& b) {
    asm volatile("s_waitcnt vmcnt(0)" ::: "memory");
    __syncthreads();
    if (threadIdx.x == 0) {
        unsigned* bar = b.bar;
        __builtin_amdgcn_s_waitcnt(0);
        unsigned nloc = b.st[0], nx = b.st[1];
        if (nloc == 0u) { xcd_barrier_complete(bar, b.x, nloc, nx); b.st[0] = nloc; b.st[1] = nx; }
        const unsigned old = xb_add(&bar[XB_XSUB(b.x)], 1u);
        const unsigned gen = old / nloc;
        if (old + 1u == (gen + 1u) * nloc) {
            __builtin_amdgcn_fence(__ATOMIC_RELEASE, "agent");
            asm volatile("s_waitcnt vmcnt(0)" ::: "memory");
            const unsigned og = xb_add(&bar[XB_TOP], 1u);
            const unsigned tg = og / nx;
            if (og + 1u == (tg + 1u) * nx) xb_add(&bar[XB_TOPGEN], 1u);
            else XB_SPIN(xb_ld(&bar[XB_TOPGEN]) == tg, bar);
            __builtin_amdgcn_fence(__ATOMIC_ACQUIRE, "agent");
            xb_add(&bar[XB_XGEN(b.x)], 1u);
            asm volatile("s_waitcnt vmcnt(0)" ::: "memory");
        } else {
            XB_SPIN(xb_ld(&bar[XB_XGEN(b.x)]) == gen, bar);
            __builtin_amdgcn_fence(__ATOMIC_ACQUIRE, "agent");
            asm volatile("s_waitcnt vmcnt(0)" ::: "memory");
        }
    }
    __syncthreads();
}

constexpr int NWAVES = 8, NTHR = NWAVES * 64;
constexpr int D = 1024, NB = 4, S = 4096, M = NB * S;
constexpr int DL = 512, DA = 512, NH = 8, HD = 64, BLK = 256, NBLK = S / BLK;
constexpr int NPROJ = 2560, NMOD = 6;
constexpr int NG = 4, EPG = 8, NE = 32, DE = 256;
constexpr float LN_EPS = 1e-5f;
constexpr float ALPHA = 1.189207115002721f;
constexpr float LOG2E = 1.4426950408889634f;
constexpr float QSCALE = 0.125f * LOG2E;

constexpr size_t MiB = 1u << 20, KiB = 1u << 10;
constexpr size_t WS_CTL = 0, CTL_ZERO_BYTES = 1 * MiB;
constexpr int CW_TMO = 0, CW_CODE = 1, CW_BAR = 4096;
constexpr size_t WS_KMSUM = 256 * KiB;
constexpr size_t WS_ECNT = 512 * KiB;
constexpr size_t WS_MOD = 768 * KiB;
constexpr size_t WS_WIN = 1 * MiB;
constexpr size_t WS_WO = 6 * MiB;
constexpr size_t WS_W13 = 8 * MiB;
constexpr size_t WS_W2 = 40 * MiB;
constexpr size_t WS_U = 56 * MiB;
constexpr size_t WS_XL = 88 * MiB, WS_YL = 104 * MiB, WS_Q = 120 * MiB, WS_K = 136 * MiB, WS_V = 152 * MiB;
constexpr size_t WS_HL = 168 * MiB, WS_CA = 184 * MiB, WS_AO = 200 * MiB;
constexpr size_t WS_MIX = 88 * MiB;
constexpr size_t WS_X1 = 168 * MiB;
constexpr size_t WS_YS = 88 * MiB;
constexpr size_t WS_HDN = 232 * MiB;
constexpr size_t WS_LIST = 253 * MiB;
constexpr size_t WS_SUMM = 255 * MiB;
constexpr size_t WS_GW = 255 * MiB + 256 * KiB;
constexpr size_t WS_RI = 255 * MiB + 512 * KiB, WS_RW = 255 * MiB + 640 * KiB;
constexpr size_t WS_DUMP = 255 * MiB + 768 * KiB;
constexpr size_t WS_END = 256 * MiB;

constexpr int RING_OFF = 0, RING_BYTES = 131072;
constexpr int LDSCTL_OFF = RING_BYTES, MISC_OFF = LDSCTL_OFF + 320;
constexpr int TOKTAB_OFF = LDSCTL_OFF + 1024, TOKTAB_UNITS = 8, MOEOFF_OFF = TOKTAB_OFF + TOKTAB_UNITS * 1024;
constexpr int LDS_BYTES = 147456;
static_assert(MOEOFF_OFF + 512 <= LDS_BYTES, "LDS map");

__device__ __constant__ unsigned char T5_BUCKET[128] = {
    0, 1, 2, 3, 4, 5, 6, 7, 8, 9, 10, 11, 12, 13, 14, 15, 16, 16, 16, 17, 17, 18, 18, 18, 19, 19, 19, 20, 20, 20, 20, 21, 21, 21, 21, 22, 22, 22, 22, 22,
    23, 23, 23, 23, 23, 23, 24, 24, 24, 24, 24, 24, 25, 25, 25, 25, 25, 25, 25, 26, 26, 26, 26, 26, 26, 26, 26, 27, 27, 27, 27, 27, 27, 27, 27, 27, 27,
    28, 28, 28, 28, 28, 28, 28, 28, 28, 28, 29, 29, 29, 29, 29, 29, 29, 29, 29, 29, 29, 29, 30, 30, 30, 30, 30, 30, 30, 30, 30, 30, 30, 30, 30, 30,
    31, 31, 31, 31, 31, 31, 31, 31, 31, 31, 31, 31, 31, 31, 31};

struct Frame {
    LAS unsigned char* lds;
    volatile LAS unsigned* MISC;
    gu32* ctl;
    int tid, lane, wave, vcu, G;
};
__device__ __forceinline__ float wave_sum(float v) {
#pragma unroll
    for (int o = 1; o < 64; o <<= 1) v += __shfl_xor(v, o);
    return v;
}
__device__ __forceinline__ float bf2f(unsigned short h) { return __builtin_bit_cast(float, (unsigned)h << 16); }
__device__ __forceinline__ float bflo(unsigned w) { return __builtin_bit_cast(float, w << 16); }
__device__ __forceinline__ float bfhi(unsigned w) { return __builtin_bit_cast(float, w & 0xffff0000u); }
__device__ __forceinline__ float fsigmoid(float x) { return 1.f / (1.f + __expf(-x)); }
__device__ __forceinline__ float fsilu(float x) { return x * fsigmoid(x); }
__device__ __forceinline__ float fgelu_tanh(float x) { const float z = 0.7978845608028654f * (x + 0.044715f * x * x * x); return x / (1.f + __expf(-2.f * z)); }

__device__ __forceinline__ void p0_transpose_item(const float* W, int N, int k0, int n0, bf16* WT, int ldk, int dst_row0, const float* kgain, LAS float* scr, int lane) {
#pragma unroll 8
    for (int i = 0; i < 32; ++i) { const int kk = 2 * i + (lane >> 5); float v = W[(size_t)(k0 + kk) * N + n0 + (lane & 31)]; if (kgain) v *= kgain[k0 + kk]; scr[kk * 33 + (lane & 31)] = v; }
    LDS_WAIT(); asm volatile("" ::: "memory");
    const int c = lane & 7;
#pragma unroll
    for (int j = 0; j < 4; ++j) { const int n = (lane >> 3) + 8 * j; const LAS float* s = scr + (8 * c) * 33 + n;
        v4u o; o.x = pk2(s[0 * 33], s[1 * 33]); o.y = pk2(s[2 * 33], s[3 * 33]); o.z = pk2(s[4 * 33], s[5 * 33]); o.w = pk2(s[6 * 33], s[7 * 33]);
        *(GAS v4u*)(WT + (size_t)(dst_row0 + n) * ldk + k0 + 8 * c) = o; }
    LDS_WAIT(); asm volatile("" ::: "memory");
}

struct Ptrs {
    const float *x, *c, *w_ada, *b_ada, *w_in, *conv_w, *conv_b, *w_ga, *b_ga, *w_gx, *b_gx, *lam, *rel_bias, *g_l, *g_a, *w_out, *ln1_g, *ln1_b, *w_rg, *b_rg, *w_re, *b_re, *w1, *w3, *w2, *ln2_g, *ln2_b;
    float* out; unsigned char* ws;
};
__device__ __forceinline__ void p0_prologue(Frame& F, const Ptrs& P) {
    float* mod = (float*)(P.ws + WS_MOD);
    if (blockIdx.x < (NMOD * D) / 32) {
        LAS float* sc = (LAS float*)(F.lds + RING_OFF);
        LAS float* part = (LAS float*)(F.lds + RING_OFF + 16384);
        for (int i = F.tid; i < NB * D; i += NTHR) sc[i] = fsilu(P.c[i]);
        __syncthreads();
        const int n0 = 32 * blockIdx.x, col = F.tid & 31, ks = F.tid >> 5, k0 = ks * 64;
        float a0 = 0.f, a1 = 0.f, a2 = 0.f, a3 = 0.f;
#pragma unroll 16
        for (int kk = 0; kk < 64; ++kk) { const float w = P.w_ada[(size_t)(k0 + kk) * (NMOD * D) + n0 + col];
            a0 += sc[k0 + kk] * w; a1 += sc[D + k0 + kk] * w; a2 += sc[2 * D + k0 + kk] * w; a3 += sc[3 * D + k0 + kk] * w; }
        part[(ks * 32 + col) * 4 + 0] = a0; part[(ks * 32 + col) * 4 + 1] = a1; part[(ks * 32 + col) * 4 + 2] = a2; part[(ks * 32 + col) * 4 + 3] = a3;
        __syncthreads();
        if (F.tid < 128) { const int cc = F.tid & 31, b = F.tid >> 5; float s = 0.f;
#pragma unroll
            for (int k = 0; k < 16; ++k) s += part[(k * 32 + cc) * 4 + b];
            mod[b * NMOD * D + n0 + cc] = s + P.b_ada[n0 + cc]; }
        __syncthreads();
    }
    LAS float* scr = (LAS float*)(F.lds + RING_OFF + F.wave * 16384);
    const int gw = F.vcu * NWAVES + F.wave, NGW = F.G * NWAVES;
    constexpr int I_IN = 16 * 80, I_OUT = 16 * 32, I_W1 = NE * 16 * 8, I_W2 = NE * 4 * 32, NITEMS = I_IN + I_OUT + 2 * I_W1 + I_W2;
    bf16* WinT = (bf16*)(P.ws + WS_WIN); bf16* WoT = (bf16*)(P.ws + WS_WO); bf16* W13T = (bf16*)(P.ws + WS_W13); bf16* W2T = (bf16*)(P.ws + WS_W2);
    for (int it = gw; it < NITEMS; it += NGW) {
        int r = it;
        if (r < I_IN) { const int kb = r / 80, nb = r % 80; p0_transpose_item(P.w_in, NPROJ, 64 * kb, 32 * nb, WinT, D, 32 * nb, nullptr, scr, F.lane); continue; } r -= I_IN;
        if (r < I_OUT) { const int kb = r / 32, nb = r % 32; p0_transpose_item(P.w_out, D, 64 * kb, 32 * nb, WoT, D, 32 * nb, (64 * kb < DL) ? P.g_l : (P.g_a - DL), scr, F.lane); continue; } r -= I_OUT;
        if (r < I_W1) { const int e = r / 128, q = r % 128, kb = q / 8, n0 = 32 * (q % 8);
            p0_transpose_item(P.w1 + (size_t)e * D * DE, DE, 64 * kb, n0, W13T + (size_t)e * 512 * D, D, (n0 / 128) * 256 + (n0 % 128), nullptr, scr, F.lane); continue; } r -= I_W1;
        if (r < I_W1) { const int e = r / 128, q = r % 128, kb = q / 8, n0 = 32 * (q % 8);
            p0_transpose_item(P.w3 + (size_t)e * D * DE, DE, 64 * kb, n0, W13T + (size_t)e * 512 * D, D, (n0 / 128) * 256 + 128 + (n0 % 128), nullptr, scr, F.lane); continue; } r -= I_W1;
        { const int e = r / 128, q = r % 128, kb = q / 32, n0 = 32 * (q % 32);
            p0_transpose_item(P.w2 + (size_t)e * DE * D, D, 64 * kb, n0, W2T + (size_t)e * D * DE, DE, n0, nullptr, scr, F.lane); }
    }
    { bf16* GW = (bf16*)(P.ws + WS_GW);
      for (int f = F.vcu * NTHR + F.tid; f < 8 * 2 * 2 * 4 * 64; f += F.G * NTHR) {
          const int ln = f & 63, s = (f >> 6) & 3, T = (f >> 8) & 1, g = (f >> 9) & 1, n = f >> 10;
          const int rho = ln & 31, h = ln >> 5, hi = (rho >> 2) & 1, reg = (rho & 3) + 4 * (rho >> 3), chan = 16 * (2 * T + (reg >> 3)) + 8 * hi + (reg & 7);
          const float* W = (g ? P.w_gx : P.w_ga) + (size_t)n * 64 * 64 + chan; const int i0 = 16 * s + 8 * h;
          v4u o; o.x = pk2(W[(i0 + 0) * 64], W[(i0 + 1) * 64]); o.y = pk2(W[(i0 + 2) * 64], W[(i0 + 3) * 64]); o.z = pk2(W[(i0 + 4) * 64], W[(i0 + 5) * 64]); o.w = pk2(W[(i0 + 6) * 64], W[(i0 + 7) * 64]);
          *(GAS v4u*)(GW + (size_t)f * 8) = o; } }
}
__device__ __forceinline__ void p1_modulate(Frame& F, const Ptrs& P) {
    const int gw = F.vcu * NWAVES + F.wave, NGW = F.G * NWAVES;
    const float* mod = (const float*)(P.ws + WS_MOD); bf16* U = (bf16*)(P.ws + WS_U);
    for (int m = gw; m < M; m += NGW) {
        const GAS f32x4* xr = (const GAS f32x4*)(P.x + (size_t)m * D) + F.lane;
        f32x4 v[4]; float s = 0.f;
#pragma unroll
        for (int j = 0; j < 4; ++j) { v[j] = xr[64 * j]; s += (v[j].x + v[j].y) + (v[j].z + v[j].w); }
        const float mean = wave_sum(s) * (1.f / D); float s2 = 0.f;
#pragma unroll
        for (int j = 0; j < 4; ++j) { v[j] = v[j] - mean; s2 += (v[j].x * v[j].x + v[j].y * v[j].y) + (v[j].z * v[j].z + v[j].w * v[j].w); }
        const float rstd = 1.f / sqrtf(wave_sum(s2) * (1.f / D) + LN_EPS);
        const f32x4* sh = (const f32x4*)(mod + (size_t)(m / S) * NMOD * D) + F.lane; const f32x4* sc = sh + D / 4;
        GAS unsigned long long* o8 = (GAS unsigned long long*)(U + (size_t)m * D) + F.lane;
#pragma unroll
        for (int j = 0; j < 4; ++j) { const f32x4 a = v[j] * rstd * (sc[64 * j] + 1.f) + sh[64 * j];
            o8[64 * j] = (unsigned long long)pk2(a.x, a.y) | ((unsigned long long)pk2(a.z, a.w) << 32); }
    }
}
__device__ __forceinline__ void lru_unit(Frame& F, const Ptrs& P, int b, int c, int n) {
    typedef float f32x16 __attribute__((ext_vector_type(16)));
    LAS float* cst = (LAS float*)(F.lds + RING_OFF);
    LAS float* tot = cst + 192;
    LAS float* pre = tot + 1024;
    const bf16* XL = (const bf16*)(P.ws + WS_XL); const bf16* GW = (const bf16*)(P.ws + WS_GW);
    bf16* HL = (bf16*)(P.ws + WS_HL); bf16* CA = (bf16*)(P.ws + WS_CA); float* SUMM = (float*)(P.ws + WS_SUMM);
    const int r = F.lane & 31, hi = F.lane >> 5, w = F.wave;
    if (F.tid < 64) { const int ch = 64 * n + F.tid; cst[F.tid] = P.b_ga[ch]; cst[64 + F.tid] = P.b_gx[ch]; cst[128 + F.tid] = 8.0f * log1pf(__expf(-P.lam[ch])); }
    const int srow = c * BLK + 32 * w + r; const size_t grow = (size_t)b * S + srow;
    float xc[4][8]; bf16x8 bfr[4];
#pragma unroll
    for (int s = 0; s < 4; ++s) { const int cb = 64 * n + 16 * s + 8 * hi;
        { const f32x4 b0 = *(const f32x4*)(P.conv_b + cb), b1 = *(const f32x4*)(P.conv_b + cb + 4);
          xc[s][0] = b0[0]; xc[s][1] = b0[1]; xc[s][2] = b0[2]; xc[s][3] = b0[3]; xc[s][4] = b1[0]; xc[s][5] = b1[1]; xc[s][6] = b1[2]; xc[s][7] = b1[3]; }
#pragma unroll
        for (int k = 0; k < 4; ++k) { v4u xv = (v4u){0u, 0u, 0u, 0u}; if (srow - 3 + k >= 0) xv = *(const GAS v4u*)(XL + (grow - 3 + k) * DL + cb);
            const f32x4 w0 = *(const f32x4*)(P.conv_w + k * DL + cb), w1 = *(const f32x4*)(P.conv_w + k * DL + cb + 4);
            xc[s][0] += w0[0] * bflo(xv[0]); xc[s][1] += w0[1] * bfhi(xv[0]); xc[s][2] += w0[2] * bflo(xv[1]); xc[s][3] += w0[3] * bfhi(xv[1]);
            xc[s][4] += w1[0] * bflo(xv[2]); xc[s][5] += w1[1] * bfhi(xv[2]); xc[s][6] += w1[2] * bflo(xv[3]); xc[s][7] += w1[3] * bfhi(xv[3]); }
        v4u pk; pk.x = pk2(xc[s][0], xc[s][1]); pk.y = pk2(xc[s][2], xc[s][3]); pk.z = pk2(xc[s][4], xc[s][5]); pk.w = pk2(xc[s][6], xc[s][7]);
        bfr[s] = __builtin_bit_cast(bf16x8, pk); }
    f32x16 acc[2][2];
#pragma unroll
    for (int g = 0; g < 2; ++g)
#pragma unroll
        for (int T = 0; T < 2; ++T) { acc[g][T] = (f32x16){0.f, 0.f, 0.f, 0.f, 0.f, 0.f, 0.f, 0.f, 0.f, 0.f, 0.f, 0.f, 0.f, 0.f, 0.f, 0.f};
#pragma unroll
            for (int s = 0; s < 4; ++s) { const bf16x8 af = __builtin_bit_cast(bf16x8, *(const GAS v4u*)(GW + ((size_t)((((n * 2 + g) * 2 + T) * 4 + s) * 64 + F.lane)) * 8));
                acc[g][T] = __builtin_amdgcn_mfma_f32_32x32x16_bf16(af, bfr[s], acc[g][T], 0, 0, 0); } }
    __syncthreads();
#pragma unroll
    for (int T = 0; T < 2; ++T)
#pragma unroll
        for (int rg = 0; rg < 16; ++rg) { const int sp_ = 2 * T + (rg >> 3), jj = rg & 7, chl = 16 * sp_ + 8 * hi + jj;
            const float ra = acc[0][T][rg] + cst[chl], rx = acc[1][T][rg] + cst[64 + chl];
            const float rr = 1.f / (1.f + __expf(-ra)), ig = 1.f / (1.f + __expf(-rx));
            const float a = __expf(-rr * cst[128 + chl]), mult = sqrtf(fmaxf(1.f - a * a, 0.f));
            acc[0][T][rg] = a; acc[1][T][rg] = mult * ig * xc[sp_][jj]; }
#pragma unroll
    for (int d = 1; d < 32; d <<= 1) {
#pragma unroll
        for (int T = 0; T < 2; ++T)
#pragma unroll
            for (int rg = 0; rg < 16; ++rg) { const float ap = __shfl_up(acc[0][T][rg], d, 32), hp = __shfl_up(acc[1][T][rg], d, 32);
                if (r >= d) { acc[1][T][rg] = acc[0][T][rg] * hp + acc[1][T][rg]; acc[0][T][rg] = acc[0][T][rg] * ap; } } }
    if (r == 31) {
#pragma unroll
        for (int T = 0; T < 2; ++T)
#pragma unroll
            for (int rg = 0; rg < 16; ++rg) { const int chl = 16 * (2 * T + (rg >> 3)) + 8 * hi + (rg & 7); tot[(w * 64 + chl) * 2] = acc[0][T][rg]; tot[(w * 64 + chl) * 2 + 1] = acc[1][T][rg]; } }
    __syncthreads();
    if (F.tid < 64) { float cin = 1.f, hin = 0.f;
#pragma unroll
        for (int ww = 0; ww < 8; ++ww) { pre[(ww * 64 + F.tid) * 2] = cin; pre[(ww * 64 + F.tid) * 2 + 1] = hin; const float pa = tot[(ww * 64 + F.tid) * 2], hh = tot[(ww * 64 + F.tid) * 2 + 1]; hin = pa * hin + hh; cin *= pa; }
        float* sp = SUMM + ((size_t)(b * NBLK + c) * DL + 64 * n + F.tid) * 2; sp[0] = cin; sp[1] = hin; }
    __syncthreads();
#pragma unroll
    for (int s = 0; s < 4; ++s) { const int T = s >> 1; float hl[8], ca[8];
#pragma unroll
        for (int jj = 0; jj < 8; ++jj) { const int rg = 8 * (s & 1) + jj, chl = 16 * s + 8 * hi + jj; const float cin = pre[(w * 64 + chl) * 2], hin = pre[(w * 64 + chl) * 2 + 1];
            hl[jj] = acc[1][T][rg] + acc[0][T][rg] * hin; ca[jj] = acc[0][T][rg] * cin; }
        v4u oh, oc; oh.x = pk2(hl[0], hl[1]); oh.y = pk2(hl[2], hl[3]); oh.z = pk2(hl[4], hl[5]); oh.w = pk2(hl[6], hl[7]);
        oc.x = pk2(ca[0], ca[1]); oc.y = pk2(ca[2], ca[3]); oc.z = pk2(ca[4], ca[5]); oc.w = pk2(ca[6], ca[7]);
        *(GAS v4u*)(HL + grow * DL + 64 * n + 16 * s + 8 * hi) = oh; *(GAS v4u*)(CA + grow * DL + 64 * n + 16 * s + 8 * hi) = oc; }
    __syncthreads();
}
__device__ __forceinline__ void p3_lru(Frame& F, const Ptrs& P) {
    for (int u = F.vcu; u < NB * NBLK * 8; u += F.G) lru_unit(F, P, u >> 7, (u >> 3) & 15, u & 7);
}
__device__ __forceinline__ void p4_merge(Frame& F, const Ptrs& P) {
    const bf16* HL = (const bf16*)(P.ws + WS_HL); const bf16* CA = (const bf16*)(P.ws + WS_CA); const bf16* YL = (const bf16*)(P.ws + WS_YL); const bf16* AO = (const bf16*)(P.ws + WS_AO);
    const float* SUMM = (const float*)(P.ws + WS_SUMM); bf16* MG = (bf16*)(P.ws + WS_U);
    LAS float* hin = (LAS float*)(F.lds + RING_OFF);
    for (int u = F.vcu; u < M / 64; u += F.G) {
        const int r0 = 64 * u, b = r0 / S, ck = (r0 % S) / BLK;
        { float h = 0.f; const float* sp = SUMM + ((size_t)b * NBLK * DL + F.tid) * 2;
            for (int c = 0; c < ck; ++c) { const float pa = sp[(size_t)c * DL * 2], hh = sp[(size_t)c * DL * 2 + 1]; h = pa * h + hh; }
            hin[F.tid] = h; }
        __syncthreads();
        float hn[8]; { const f32x4 hi0 = *(const LAS f32x4*)(hin + 8 * F.lane), hi1 = *(const LAS f32x4*)(hin + 8 * F.lane + 4);
            hn[0] = hi0[0]; hn[1] = hi0[1]; hn[2] = hi0[2]; hn[3] = hi0[3]; hn[4] = hi1[0]; hn[5] = hi1[1]; hn[6] = hi1[2]; hn[7] = hi1[3]; }
        for (int rr = 0; rr < 8; ++rr) { const size_t row = (size_t)r0 + F.wave * 8 + rr;
            const v4u hl = *(const GAS v4u*)(HL + row * DL + 8 * F.lane), ca = *(const GAS v4u*)(CA + row * DL + 8 * F.lane), yl = *(const GAS v4u*)(YL + row * DL + 8 * F.lane), ao = *(const GAS v4u*)(AO + row * DA + 8 * F.lane);
            float l[8], a[8]; float sl = 0.f, sa = 0.f;
#pragma unroll
            for (int i = 0; i < 4; ++i) { const float hlo = bflo(hl[i]) + bflo(ca[i]) * hn[2 * i], hhi = bfhi(hl[i]) + bfhi(ca[i]) * hn[2 * i + 1];
                l[2 * i] = hlo * fgelu_tanh(bflo(yl[i])); l[2 * i + 1] = hhi * fgelu_tanh(bfhi(yl[i])); a[2 * i] = bflo(ao[i]); a[2 * i + 1] = bfhi(ao[i]);
                sl += l[2 * i] * l[2 * i] + l[2 * i + 1] * l[2 * i + 1]; sa += a[2 * i] * a[2 * i] + a[2 * i + 1] * a[2 * i + 1]; }
            const float rl = 1.f / sqrtf(wave_sum(sl) * (1.f / DL) + LN_EPS), ra = 1.f / sqrtf(wave_sum(sa) * (1.f / DA) + LN_EPS);
            v4u ol, oa;
#pragma unroll
            for (int i = 0; i < 4; ++i) { ol[i] = pk2(l[2 * i] * rl, l[2 * i + 1] * rl); oa[i] = pk2(a[2 * i] * ra, a[2 * i + 1] * ra); }
            *(GAS v4u*)(MG + row * D + 8 * F.lane) = ol; *(GAS v4u*)(MG + row * D + DL + 8 * F.lane) = oa; }
        __syncthreads();
    }
}
__device__ __forceinline__ void p6_post(Frame& F, const Ptrs& P) {
    const int gw = F.vcu * NWAVES + F.wave, NGW = F.G * NWAVES;
    const float* mod = (const float*)(P.ws + WS_MOD); const float* MIX = (const float*)(P.ws + WS_MIX); float* X1 = (float*)(P.ws + WS_X1); bf16* U2 = (bf16*)(P.ws + WS_U);
    int* RI = (int*)(P.ws + WS_RI); float* RW = (float*)(P.ws + WS_RW); unsigned* ecnt = (unsigned*)(P.ws + WS_ECNT); unsigned* list = (unsigned*)(P.ws + WS_LIST);
    for (int m = gw; m < M; m += NGW) {
        const f32x4* md = (const f32x4*)(mod + (size_t)(m / S) * NMOD * D) + F.lane;
        const GAS f32x4* xr = (const GAS f32x4*)(P.x + (size_t)m * D) + F.lane; const GAS f32x4* mr = (const GAS f32x4*)(MIX + (size_t)m * D) + F.lane;
        f32x4 v[4]; float s = 0.f;
#pragma unroll
        for (int j = 0; j < 4; ++j) { v[j] = xr[64 * j] * ALPHA + md[2 * (D / 4) + 64 * j] * mr[64 * j]; s += (v[j].x + v[j].y) + (v[j].z + v[j].w); }
        float mean = wave_sum(s) * (1.f / D), s2 = 0.f;
#pragma unroll
        for (int j = 0; j < 4; ++j) { v[j] = v[j] - mean; s2 += (v[j].x * v[j].x + v[j].y * v[j].y) + (v[j].z * v[j].z + v[j].w * v[j].w); }
        float rstd = 1.f / sqrtf(wave_sum(s2) * (1.f / D) + LN_EPS); s = 0.f;
        GAS f32x4* x1r = (GAS f32x4*)(X1 + (size_t)m * D) + F.lane;
#pragma unroll
        for (int j = 0; j < 4; ++j) { v[j] = v[j] * rstd * ((const f32x4*)P.ln1_g)[F.lane + 64 * j] + ((const f32x4*)P.ln1_b)[F.lane + 64 * j]; x1r[64 * j] = v[j]; s += (v[j].x + v[j].y) + (v[j].z + v[j].w); }
        mean = wave_sum(s) * (1.f / D); s2 = 0.f;
#pragma unroll
        for (int j = 0; j < 4; ++j) { v[j] = v[j] - mean; s2 += (v[j].x * v[j].x + v[j].y * v[j].y) + (v[j].z * v[j].z + v[j].w * v[j].w); }
        rstd = 1.f / sqrtf(wave_sum(s2) * (1.f / D) + LN_EPS);
        GAS unsigned long long* o8 = (GAS unsigned long long*)(U2 + (size_t)m * D) + F.lane;
#pragma unroll
        for (int j = 0; j < 4; ++j) { v[j] = v[j] * rstd * (md[4 * (D / 4) + 64 * j] + 1.f) + md[3 * (D / 4) + 64 * j];
            o8[64 * j] = (unsigned long long)pk2(v[j].x, v[j].y) | ((unsigned long long)pk2(v[j].z, v[j].w) << 32); }
        float lg[NG], le[NE];
#pragma unroll
        for (int g = 0; g < NG; ++g) lg[g] = 0.f;
#pragma unroll
        for (int e = 0; e < NE; ++e) le[e] = 0.f;
        { LAS float* urow = (LAS float*)(F.lds + RING_OFF) + F.wave * D;
#pragma unroll
            for (int j = 0; j < 4; ++j) *(LAS f32x4*)(urow + 4 * F.lane + 256 * j) = v[j];
            LDS_WAIT();
#pragma unroll 1
            for (int kk = 0; kk < 16; ++kk) { const int k = 4 * F.lane + 256 * (kk >> 2) + (kk & 3); const float uv = urow[k];
                const f32x4 wg = *(const f32x4*)(P.w_rg + (size_t)k * NG);
#pragma unroll
                for (int g = 0; g < NG; ++g) lg[g] += uv * wg[g];
#pragma unroll
                for (int q = 0; q < NE / 4; ++q) { const f32x4 we = *(const f32x4*)(P.w_re + (size_t)k * NE + 4 * q);
#pragma unroll
                    for (int t = 0; t < 4; ++t) le[4 * q + t] += uv * we[t]; } }
            LDS_WAIT(); }
#pragma unroll
        for (int g = 0; g < NG; ++g) lg[g] = wave_sum(lg[g]) + P.b_rg[g];
#pragma unroll
        for (int e = 0; e < NE; ++e) le[e] = wave_sum(le[e]) + P.b_re[e];
        if (F.lane == 0) {
            int gi = 0; float gmax = lg[0];
#pragma unroll
            for (int g = 1; g < NG; ++g) if (lg[g] > gmax) { gi = g; gmax = lg[g]; }
            float gs = 0.f;
#pragma unroll
            for (int g = 0; g < NG; ++g) gs += __expf(lg[g] - gmax);
            const float gtop = 1.f / gs;
            float ev[EPG];
#pragma unroll
            for (int e = 0; e < EPG; ++e) { float t = 0.f;
#pragma unroll
                for (int g = 0; g < NG; ++g) if (g == gi) t = le[g * EPG + e];
                ev[e] = t; }
            int e0 = 0; float v0 = ev[0];
#pragma unroll
            for (int e = 1; e < EPG; ++e) if (ev[e] > v0) { e0 = e; v0 = ev[e]; }
            int e1 = -1; float v1 = 0.f;
#pragma unroll
            for (int e = 0; e < EPG; ++e) if (e != e0 && (e1 < 0 || ev[e] > v1)) { e1 = e; v1 = ev[e]; }
            const float p1 = __expf(v1 - v0), w0 = 1.f / (1.f + p1), w1 = p1 / (1.f + p1);
            const int ge0 = gi * EPG + e0, ge1 = gi * EPG + e1;
            RI[m * 2 + 0] = ge0; RI[m * 2 + 1] = ge1; RW[m * 2 + 0] = gtop * w0; RW[m * 2 + 1] = gtop * w1;
            const unsigned p0 = atomicAdd(ecnt + 64 * ge0, 1u), p1i = atomicAdd(ecnt + 64 * ge1, 1u);
            list[(size_t)ge0 * M + p0] = (unsigned)m * 2u; list[(size_t)ge1 * M + p1i] = (unsigned)m * 2u + 1u;
        }
    }
}
__device__ __forceinline__ void moe_setup(Frame& F, const Ptrs& P, int nct) {
    LAS unsigned* toff = (LAS unsigned*)(F.lds + MOEOFF_OFF); LAS unsigned* cnts = toff + 40; LAS unsigned* toktab = (LAS unsigned*)(F.lds + TOKTAB_OFF);
    const unsigned* ecnt = (const unsigned*)(P.ws + WS_ECNT); const unsigned* list = (const unsigned*)(P.ws + WS_LIST);
    if (F.tid < NE) cnts[F.tid] = ecnt[64 * F.tid];
    __syncthreads();
    if (F.tid == 0) { unsigned a = 0; for (int e = 0; e < NE; ++e) { toff[e] = a; a += (cnts[e] + 255u) >> 8; } toff[NE] = a; }
    __syncthreads();
    const int total = (int)toff[NE] * nct;
    for (int i = 0; i < TOKTAB_UNITS; ++i) { const int L = i * F.G + F.vcu; if (L >= total) break;
        const int rt = L / nct; int e = 0; while ((int)toff[e + 1] <= rt) ++e;
        if (F.tid < 256) { const unsigned pos = 256u * (unsigned)(rt - (int)toff[e]) + (unsigned)F.tid; toktab[i * 256 + F.tid] = pos < cnts[e] ? list[(size_t)e * M + pos] : pg8::TOK_NONE; } }
    __syncthreads();
}
__device__ __forceinline__ void p9_final(Frame& F, const Ptrs& P) {
    const int gw = F.vcu * NWAVES + F.wave, NGW = F.G * NWAVES;
    const float* mod = (const float*)(P.ws + WS_MOD); const float* X1 = (const float*)(P.ws + WS_X1); const bf16* YS = (const bf16*)(P.ws + WS_YS);
    for (int m = gw; m < M; m += NGW) {
        const f32x4* md = (const f32x4*)(mod + (size_t)(m / S) * NMOD * D) + F.lane;
        const GAS f32x4* xr = (const GAS f32x4*)(X1 + (size_t)m * D) + F.lane;
        const GAS unsigned long long* y0 = (const GAS unsigned long long*)(YS + (size_t)m * 2 * D) + F.lane; const GAS unsigned long long* y1 = y0 + D / 4;
        f32x4 v[4]; float s = 0.f;
#pragma unroll
        for (int j = 0; j < 4; ++j) { const unsigned long long a = y0[64 * j], b = y1[64 * j];
            const f32x4 f = (f32x4){bflo((unsigned)a) + bflo((unsigned)b), bfhi((unsigned)a) + bfhi((unsigned)b), bflo((unsigned)(a >> 32)) + bflo((unsigned)(b >> 32)), bfhi((unsigned)(a >> 32)) + bfhi((unsigned)(b >> 32))};
            v[j] = xr[64 * j] * ALPHA + md[5 * (D / 4) + 64 * j] * f; s += (v[j].x + v[j].y) + (v[j].z + v[j].w); }
        const float mean = wave_sum(s) * (1.f / D); float s2 = 0.f;
#pragma unroll
        for (int j = 0; j < 4; ++j) { v[j] = v[j] - mean; s2 += (v[j].x * v[j].x + v[j].y * v[j].y) + (v[j].z * v[j].z + v[j].w * v[j].w); }
        const float rstd = 1.f / sqrtf(wave_sum(s2) * (1.f / D) + LN_EPS);
        GAS f32x4* orow = (GAS f32x4*)(P.out + (size_t)m * D) + F.lane;
#pragma unroll
        for (int j = 0; j < 4; ++j) orow[64 * j] = v[j] * rstd * ((const f32x4*)P.ln2_g)[F.lane + 64 * j] + ((const f32x4*)P.ln2_b)[F.lane + 64 * j];
    }
}

constexpr int N_PHASES = 10;
struct Args { Ptrs p; int ph_lo, ph_hi, li, pad; };
__global__ void __launch_bounds__(NTHR, 2) mk_fwd(Args args) {
    extern __shared__ __attribute__((aligned(16))) unsigned char lds[];
    Frame F;
    F.lds = (LAS unsigned char*)lds;
    F.MISC = (volatile LAS unsigned*)(F.lds + MISC_OFF);
    F.tid = threadIdx.x; F.lane = F.tid & 63; F.wave = __builtin_amdgcn_readfirstlane(F.tid >> 6);
    F.G = gridDim.x; { const int bx = blockIdx.x; F.vcu = (F.G % 8 == 0) ? (bx % 8) * (F.G / 8) + bx / 8 : bx; }
    const Ptrs& P = args.p;
    F.ctl = (gu32*)(P.ws + WS_CTL);
    for (int u = F.tid; u < (LDS_BYTES - LDSCTL_OFF) / 4; u += NTHR) ((LAS unsigned*)(F.lds + LDSCTL_OFF))[u] = 0u;
    __syncthreads();
    const int lo = args.ph_lo, hi = args.ph_hi;
    XcdBarrier bar; bar.bar = (unsigned*)(F.ctl + CW_BAR) + args.li * XCD_BAR_WORDS; bar.x = 0; bar.st = nullptr;
    if (hi - lo > 1) bar = xcd_barrier_post((unsigned*)(F.ctl + CW_BAR) + args.li * XCD_BAR_WORDS, F.MISC + 8);
#define IN(k) (lo <= (k) && (k) < hi)
#define BOTH(k) (IN(k) && IN((k) + 1))
#define SEAM(k) do { if (BOTH(k)) xcd_barrier(bar); } while (0)
    if (IN(0)) { p0_prologue(F, P); SEAM(0); }
    if (IN(1)) { p1_modulate(F, P); SEAM(1); }
    if (IN(2)) {
        pg8::Gemm g{(const pg8::bf16_t*)(P.ws + WS_U), (const pg8::bf16_t*)(P.ws + WS_WIN), M, NPROJ, D}; pg8::StaticOrder So; So.init(M, NPROJ, F.G, (int)blockIdx.x);
        pg8::EpiProj E{(pg8::bf16_t*)(P.ws + WS_XL), (size_t)(WS_YL - WS_XL) / 2, (float*)(P.ws + WS_KMSUM), QSCALE};
        pg8::gemm_phase<pg8::EpiProj, pg8::StaticOrder, PG8_ALIGN, PG8_SP2>(F.lds + RING_OFF, g, So, E);
        SEAM(2);
    }
    if (IN(3)) {
        p3_lru(F, P);
        static_assert(attn_body::LDS_BYTES <= RING_BYTES && attn_body::DM == DA, "attention body geometry vs frame");
        const attn_body::AttnTensors AT{(const attn_body::bf16*)(P.ws + WS_Q), (const attn_body::bf16*)(P.ws + WS_K), (const attn_body::bf16*)(P.ws + WS_V), (attn_body::bf16*)(P.ws + WS_AO),
                                        (const float*)(P.ws + WS_KMSUM), P.rel_bias, T5_BUCKET};
        const attn_body::StaticOrder So((int)F.G, F.vcu);
        attn_body::attn_phase<attn_body::StaticOrder>((char*)lds + RING_OFF, AT, So);
        SEAM(3);
    }
    if (IN(4)) { p4_merge(F, P); SEAM(4); }
    if (IN(5)) {
        pg8::Gemm g{(const pg8::bf16_t*)(P.ws + WS_U), (const pg8::bf16_t*)(P.ws + WS_WO), M, D, D}; pg8::StaticOrder So; So.init(M, D, F.G, (int)blockIdx.x);
        pg8::EpiF32 E{(float*)(P.ws + WS_MIX), D};
        pg8::gemm_phase<pg8::EpiF32, pg8::StaticOrder, PG8_ALIGN, PG8_SP2>(F.lds + RING_OFF, g, So, E);
        SEAM(5);
    }
    if (IN(6)) { p6_post(F, P); SEAM(6); }
    if (IN(7)) {
        moe_setup(F, P, 2);
        const LAS unsigned* toktab = (const LAS unsigned*)(F.lds + TOKTAB_OFF);
        pg8::Gemm g{(const pg8::bf16_t*)(P.ws + WS_U), (const pg8::bf16_t*)(P.ws + WS_W13), 0, 0, D}; const pg8::MoeOrder So{(const LAS unsigned*)(F.lds + MOEOFF_OFF), 2, F.G, F.vcu};
        pg8::EpiMoeUp E{(pg8::bf16_t*)(P.ws + WS_HDN), (const float*)(P.ws + WS_RW), toktab};
        pg8::gemm_phase_g<pg8::EpiMoeUp, pg8::MoeOrder, true>(F.lds + RING_OFF, g, So, E, toktab);
        SEAM(7);
    }
    if (IN(8)) {
        moe_setup(F, P, 4);
        const LAS unsigned* toktab = (const LAS unsigned*)(F.lds + TOKTAB_OFF);
        pg8::Gemm g{(const pg8::bf16_t*)(P.ws + WS_HDN), (const pg8::bf16_t*)(P.ws + WS_W2), 0, 0, DE}; const pg8::MoeOrder So{(const LAS unsigned*)(F.lds + MOEOFF_OFF), 4, F.G, F.vcu};
        pg8::EpiMoeDown E{(pg8::bf16_t*)(P.ws + WS_YS), (pg8::bf16_t*)(P.ws + WS_DUMP), toktab};
        pg8::gemm_phase_g<pg8::EpiMoeDown, pg8::MoeOrder, false>(F.lds + RING_OFF, g, So, E, toktab);
        SEAM(8);
    }
    if (IN(9)) { p9_final(F, P); }
#undef IN
#undef BOTH
#undef SEAM
}

extern "C" void kernel_launch(void* const* d_in, const int* in_sizes, int n_in, void* d_out, int out_size, void* d_ws, size_t ws_size, hipStream_t stream) {
    static int grid = 0;
    if (grid == 0) {
        if (n_in != 27 || in_sizes[0] != M * D || out_size != M * D || ws_size < WS_END) { fprintf(stderr, "kernel_launch: unexpected shapes / workspace (n_in %d, ws %zu)\n", n_in, ws_size); grid = -1; return; }
        int dev = 0, cus = 0, per_cu = 0;
        if (hipGetDevice(&dev) != hipSuccess || hipDeviceGetAttribute(&cus, hipDeviceAttributeMultiprocessorCount, dev) != hipSuccess) { grid = -1; return; }
        if (hipFuncSetAttribute((const void*)mk_fwd, hipFuncAttributeMaxDynamicSharedMemorySize, LDS_BYTES) != hipSuccess) { fprintf(stderr, "kernel_launch: hipFuncSetAttribute failed\n"); grid = -1; return; }
        if (hipOccupancyMaxActiveBlocksPerMultiprocessor(&per_cu, (const void*)mk_fwd, NTHR, LDS_BYTES) != hipSuccess || per_cu < 1) fprintf(stderr, "kernel_launch: occupancy query reports %d\n", per_cu);
        (void)hipGetLastError();
        grid = cus;
    }
    if (grid < 0) return;
    unsigned char* ws = (unsigned char*)d_ws;
    (void)hipMemsetAsync(ws + WS_CTL, 0, CTL_ZERO_BYTES, stream);
    Args a{};
    const float** pp = (const float**)&a.p;
    for (int i = 0; i < 27; ++i) pp[i] = (const float*)d_in[i];
    a.p.out = (float*)d_out; a.p.ws = ws;
    auto run = [&](int lo, int hi, int li) { a.ph_lo = lo; a.ph_hi = hi; a.li = li; hipLaunchKernelGGL(mk_fwd, dim3(grid), dim3(NTHR), LDS_BYTES, stream, a); };
    run(0, N_PHASES, 0);
}
```

```cpp
#include <hip/hip_runtime.h>
#include <cstdio>
#include <cstdint>

namespace pg8 {
#define PG8_LAS __attribute__((address_space(3)))
typedef unsigned short bf16_t;
typedef short bf16x8 __attribute__((ext_vector_type(8)));
typedef float f32x4 __attribute__((ext_vector_type(4)));
typedef unsigned u32x4 __attribute__((ext_vector_type(4)));
constexpr int BM = 256, BK = 64, HALF = 128, HTB = HALF * BK * 2  , STAGE_BYTES = 8 * HTB, NXCD = 8, WGM = 8;

__host__ __device__ __forceinline__ int lds_byte(int r, int c) { const int st = (r >> 4) * 2 + (c >> 5), rr = r & 15, cc = c & 31, ob = rr * 64 + cc * 2; return st * 1024 + (ob ^ (((ob >> 9) & 1) << 5)); }
__host__ __device__ __forceinline__ void stage_rc(int b, int& R, int& C) { const int st = b / 1024, sb = b % 1024, swz = sb ^ (((sb >> 9) & 1) << 5); R = (st >> 1) * 16 + swz / 64; C = (st & 1) * 32 + (swz % 64) / 2; }
__host__ __device__ __forceinline__ int perm32(int rho) { const int n = rho >> 4, i = rho & 15; return 8 * (i >> 2) + 4 * n + (i & 3); }

struct Unit { int pm, pn; };
struct Gemm { const bf16_t* A; const bf16_t* Bt; int M, N, K; };

struct StaticOrder {
    int nM, nN, nwg, G, c;
    __host__ __device__ void init(int M, int N, int G_, int c_) { nM = M / BM; nN = N / BM; nwg = nM * nN; G = G_; c = c_; }
    __host__ __device__ bool next(int i, Unit& u) const {
        const long L = (long)i * G + c; if (L >= nwg) return false;
        int wgid = (int)L; { const int q = nwg / NXCD, r = nwg % NXCD, xcd = wgid % NXCD, off = wgid / NXCD; wgid = (xcd < r ? xcd * (q + 1) : r * (q + 1) + (xcd - r) * q) + off; }
        const int nig = WGM * nN, gid = wgid / nig, fm = gid * WGM, gsz = (nM - fm) < WGM ? (nM - fm) : WGM;
        u.pm = fm + ((wgid % nig) % gsz); u.pn = (wgid % nig) / gsz; return true;
    }
    __device__ __forceinline__ void a_ready(const Unit&) const {}
    __device__ __forceinline__ void done(const Unit&) const {}
};

__device__ __forceinline__ unsigned cvt_pk_bf16(float lo, float hi) { unsigned r; asm volatile("v_cvt_pk_bf16_f32 %0, %1, %2" : "=v"(r) : "v"(lo), "v"(hi)); return r; }
typedef float f32x2 __attribute__((ext_vector_type(2)));
__device__ __forceinline__ f32x2 gelu_pk(f32x2 v) {
    const f32x2 av = __builtin_elementwise_abs(v), d = av * 0.2316418882f + 1.0f;
    f32x2 t; t.x = __builtin_amdgcn_rcpf(d.x); t.y = __builtin_amdgcn_rcpf(d.y);
    f32x2 q = t * 0.5307027145f + (-0.7265760135f); q = q * t + 0.7107068705f; q = q * t + (-0.142248368f); q = q * t + 0.127414796f; q = q * t;
    const f32x2 s = (v * v) * (-0.72134752044f);
    f32x2 e; e.x = __builtin_amdgcn_exp2f(s.x); e.y = __builtin_amdgcn_exp2f(s.y);
    const f32x2 m = v * (q * e), r = v - m;
    f32x2 o; o.x = v.x < 0.f ? m.x : r.x; o.y = v.y < 0.f ? m.y : r.y; return o;
}

template <int ACT  > struct EpiBf16 {
    static constexpr bool PERM = true, AFTER_DRAIN = false; static_assert(ACT == 0 || ACT == 1, "EpiBf16: ACT is 0 (none) or 1 (gelu_pk)");
    bf16_t* O; int ldc; const float* bias; int split_cols; size_t split_stride; float scale0;
    __device__ __forceinline__ void operator()(const f32x4 (&acc)[2][2][4][2], const Unit& u, int wr, int wc, int fr, int fq) const {
        const int row0 = u.pm * BM + wr * 64 + fr; int colt = u.pn * BM; bf16_t* base = O;
        float sc = 1.f; if (split_cols) { const int t = colt / split_cols; base += (size_t)t * split_stride; colt -= t * split_cols; if (t == 0) sc = scale0; }
        const int col0 = colt + wc * 32 + 8 * fq, bcol0 = u.pn * BM + wc * 32 + 8 * fq;
        f32x4 bv[2][2];
#pragma unroll
        for (int bj = 0; bj < 2; ++bj)
#pragma unroll
            for (int n = 0; n < 2; ++n) bv[bj][n] = bias ? *(const f32x4*)(bias + bcol0 + bj * HALF + 4 * n) : (f32x4){0.f, 0.f, 0.f, 0.f};
#pragma unroll
        for (int ai = 0; ai < 2; ++ai)
#pragma unroll
            for (int m = 0; m < 4; ++m) { bf16_t* rowp = base + (size_t)(row0 + ai * HALF + m * 16) * ldc + col0;
#pragma unroll
                for (int bj = 0; bj < 2; ++bj) { f32x4 v0 = acc[ai][bj][m][0] + bv[bj][0], v1 = acc[ai][bj][m][1] + bv[bj][1];
                    if (ACT == 1) { f32x2 a = gelu_pk((f32x2){v0[0], v0[1]}), b = gelu_pk((f32x2){v0[2], v0[3]}), c = gelu_pk((f32x2){v1[0], v1[1]}), d = gelu_pk((f32x2){v1[2], v1[3]});
                        v0 = (f32x4){a.x, a.y, b.x, b.y}; v1 = (f32x4){c.x, c.y, d.x, d.y}; }
                    v0 = v0 * sc; v1 = v1 * sc; u32x4 w; w.x = cvt_pk_bf16(v0[0], v0[1]); w.y = cvt_pk_bf16(v0[2], v0[3]); w.z = cvt_pk_bf16(v1[0], v1[1]); w.w = cvt_pk_bf16(v1[2], v1[3]);
                    *(u32x4*)(rowp + bj * HALF) = w; } }
    }
};

struct PanelStats {
    unsigned* xbuf;
    unsigned* cnt;
    unsigned* tmo;
    int ntn; float eps;
    unsigned code;
    __device__ __forceinline__ bool run(const f32x4 (&v)[2][2][4][2], const Unit& u, int wr, int wc, int fr, int fq, PG8_LAS unsigned char* lds, int wid, int lane) const {
        typedef float f32x2v __attribute__((ext_vector_type(2)));
        PG8_LAS f32x2v* P = (PG8_LAS f32x2v*)lds;
        PG8_LAS f32x2v* S = (PG8_LAS f32x2v*)(lds + 8192);
        PG8_LAS unsigned* flag = (PG8_LAS unsigned*)(lds + 8192 + 2048);
#pragma unroll
        for (int ai = 0; ai < 2; ++ai)
#pragma unroll
            for (int m = 0; m < 4; ++m) {
                float s = 0.f;
#pragma unroll
                for (int bj = 0; bj < 2; ++bj)
#pragma unroll
                    for (int n = 0; n < 2; ++n) { const f32x4 x = v[ai][bj][m][n]; s += (x[0] + x[1]) + (x[2] + x[3]); }
                s += __shfl_xor(s, 16); s += __shfl_xor(s, 32);
                const float mw = s * (1.0f / 64.0f); float q = 0.f;
#pragma unroll
                for (int bj = 0; bj < 2; ++bj)
#pragma unroll
                    for (int n = 0; n < 2; ++n) { const f32x4 d = v[ai][bj][m][n] - mw; q += (d[0] * d[0] + d[1] * d[1]) + (d[2] * d[2] + d[3] * d[3]); }
                q += __shfl_xor(q, 16); q += __shfl_xor(q, 32);
                if (fq == 0) P[(ai * HALF + wr * 64 + m * 16 + fr) * 4 + wc] = (f32x2v){mw, q};
            }
        asm volatile("s_waitcnt lgkmcnt(0)" ::: "memory"); __builtin_amdgcn_s_barrier(); asm volatile("" ::: "memory");
#if defined(BROKEN_EXCHANGE_NO_WAIT)
#warning BROKEN CONTROL BUILD: the row-statistics exchange does not wait; results are wrong by design
        if (blockIdx.x >= 64) { const long long t0_ = clock64(); while (clock64() - t0_ < 60000) __builtin_amdgcn_s_sleep(8); }
#endif
        const int row = wid * 32 + (lane & 31);
        if (lane < 32) {
            const f32x2v a = P[row * 4 + 0], b = P[row * 4 + 1], c = P[row * 4 + 2], d = P[row * 4 + 3];
            const float mt = (a.x + b.x + c.x + d.x) * 0.25f;
            const float da = a.x - mt, db = b.x - mt, dc = c.x - mt, dd = d.x - mt;
            const float m2 = (a.y + b.y) + (c.y + d.y) + 64.0f * ((da * da + db * db) + (dc * dc + dd * dd));
            unsigned long long* slot = (unsigned long long*)xbuf + ((size_t)(u.pm * BM + row) * 4 + u.pn);
            __hip_atomic_store(slot, ((unsigned long long)__float_as_uint(m2) << 32) | __float_as_uint(mt), __ATOMIC_RELAXED, __HIP_MEMORY_SCOPE_AGENT);
        }
        asm volatile("s_waitcnt vmcnt(0)" ::: "memory");
        if (lane == 0) __hip_atomic_fetch_add(cnt + 64 * u.pm, 1u, __ATOMIC_RELAXED, __HIP_MEMORY_SCOPE_AGENT);
        if (wid == 0) {
            bool dead = false; const unsigned long long t0 = __builtin_amdgcn_s_memrealtime(); const unsigned want = 8u * (unsigned)ntn;
            for (;;) {
#if defined(BROKEN_EXCHANGE_NO_WAIT)
                break;
#endif
                if ((unsigned)__builtin_amdgcn_readfirstlane(__hip_atomic_load(cnt + 64 * u.pm, __ATOMIC_RELAXED, __HIP_MEMORY_SCOPE_AGENT)) >= want) break;
                if (__builtin_amdgcn_s_memrealtime() - t0 > 2000000ull) {
                    if (lane == 0) { unsigned expect = 0u; __hip_atomic_compare_exchange_strong(tmo + 1, &expect, code | (unsigned)(u.pm & 0xff), __ATOMIC_RELAXED, __ATOMIC_RELAXED, __HIP_MEMORY_SCOPE_AGENT);
                                     __hip_atomic_store(tmo, 1u, __ATOMIC_RELAXED, __HIP_MEMORY_SCOPE_AGENT); }
                    dead = true; break; }
                __builtin_amdgcn_s_sleep(2);
            }
            __builtin_amdgcn_fence(__ATOMIC_ACQUIRE, "agent");
            if (lane == 0) flag[0] = dead ? 1u : 0u;
        }
        asm volatile("s_waitcnt vmcnt(0) lgkmcnt(0)" ::: "memory"); __builtin_amdgcn_s_barrier(); asm volatile("" ::: "memory");
        const bool bad = flag[0] != 0u;
        if (lane < 32) {
            const unsigned long long* slot = (const unsigned long long*)xbuf + (size_t)(u.pm * BM + row) * 4; float mt[4], m2[4]; float ms = 0.f;
#pragma unroll
            for (int t = 0; t < 4; ++t) { if (t < ntn) { const unsigned long long w = __hip_atomic_load(slot + t, __ATOMIC_RELAXED, __HIP_MEMORY_SCOPE_AGENT); mt[t] = __uint_as_float((unsigned)w); m2[t] = __uint_as_float((unsigned)(w >> 32)); } else { mt[t] = 0.f; m2[t] = 0.f; } ms += mt[t]; }
            const float mean = ms / (float)ntn; float q = 0.f;
#pragma unroll
            for (int t = 0; t < 4; ++t) if (t < ntn) { const float dm = mt[t] - mean; q += m2[t] + 256.0f * dm * dm; }
            S[row] = (f32x2v){mean, 1.0f / sqrtf(q / (256.0f * (float)ntn) + eps)};
        }
        asm volatile("s_waitcnt lgkmcnt(0)" ::: "memory"); __builtin_amdgcn_s_barrier(); asm volatile("" ::: "memory");
        return bad;
    }
};
struct EpiLnRes {
    static constexpr bool PERM = false, AFTER_DRAIN = true;
    const float* base; float* out; int ldc; const float* bias; PanelStats st; unsigned poison;
    __device__ __forceinline__ void fused(f32x4 (&acc)[2][2][4][2], const Unit& u, int wr, int wc, int fr, int fq, PG8_LAS unsigned char* lds, int wid, int lane) const {
        typedef float f32x2v __attribute__((ext_vector_type(2)));
        const PG8_LAS f32x2v* S = (const PG8_LAS f32x2v*)(lds + 8192);
        const int col0 = u.pn * BM + wc * 32 + 4 * fq;
#pragma unroll
        for (int bj = 0; bj < 2; ++bj)
#pragma unroll
            for (int n = 0; n < 2; ++n) { const f32x4 bv = bias ? *(const f32x4*)(bias + col0 + bj * HALF + n * 16) : (f32x4){0.f, 0.f, 0.f, 0.f};
#pragma unroll
                for (int ai = 0; ai < 2; ++ai)
#pragma unroll
                    for (int m = 0; m < 4; ++m) acc[ai][bj][m][n] += bv; }
        f32x4 pre[4][2][2];
#pragma unroll
        for (int m = 0; m < 4; ++m) { const size_t off = (size_t)(u.pm * BM + wr * 64 + m * 16 + fr) * ldc + col0;
#pragma unroll
            for (int bj = 0; bj < 2; ++bj)
#pragma unroll
                for (int n = 0; n < 2; ++n) pre[m][bj][n] = *(const f32x4*)(base + off + bj * HALF + n * 16); }
        const bool bad = st.run(acc, u, wr, wc, fr, fq, lds, wid, lane) || poison != 0u;
        const float qnan = __builtin_nanf("");
#pragma unroll
        for (int ai = 0; ai < 2; ++ai)
#pragma unroll
            for (int m = 0; m < 4; ++m) { const int r = ai * HALF + wr * 64 + m * 16 + fr; const f32x2v sr = S[r]; const size_t off = (size_t)(u.pm * BM + r) * ldc + col0;
#pragma unroll
                for (int bj = 0; bj < 2; ++bj)
#pragma unroll
                    for (int n = 0; n < 2; ++n) { const f32x4 bs = ai == 0 ? pre[m][bj][n] : *(const f32x4*)(base + off + bj * HALF + n * 16); f32x4 o = bs + (acc[ai][bj][m][n] - sr.x) * sr.y;
                        if (bad) o = (f32x4){qnan, qnan, qnan, qnan}; *(f32x4*)(out + off + bj * HALF + n * 16) = o; }
                if (m & 1) asm volatile("" ::: "memory"); }
    }
};
struct EpiLnResLn {
    static constexpr bool PERM = false, AFTER_DRAIN = true;
    const float* base; float* out; bf16_t* xn; int ldc; const float* bias; PanelStats st1, st2; unsigned poison;
    __device__ __forceinline__ void fused(f32x4 (&acc)[2][2][4][2], const Unit& u, int wr, int wc, int fr, int fq, PG8_LAS unsigned char* lds, int wid, int lane) const {
        typedef float f32x2v __attribute__((ext_vector_type(2))); typedef unsigned u32x2v __attribute__((ext_vector_type(2)));
        const PG8_LAS f32x2v* S = (const PG8_LAS f32x2v*)(lds + 8192);
        const int col0 = u.pn * BM + wc * 32 + 4 * fq;
#pragma unroll
        for (int bj = 0; bj < 2; ++bj)
#pragma unroll
            for (int n = 0; n < 2; ++n) { const f32x4 bv = bias ? *(const f32x4*)(bias + col0 + bj * HALF + n * 16) : (f32x4){0.f, 0.f, 0.f, 0.f};
#pragma unroll
                for (int ai = 0; ai < 2; ++ai)
#pragma unroll
                    for (int m = 0; m < 4; ++m) acc[ai][bj][m][n] += bv; }
        bool bad = st1.run(acc, u, wr, wc, fr, fq, lds, wid, lane) || poison != 0u;
        const float qnan = __builtin_nanf("");
#pragma unroll
        for (int ai = 0; ai < 2; ++ai)
#pragma unroll
            for (int m = 0; m < 4; ++m) { const int r = ai * HALF + wr * 64 + m * 16 + fr; const f32x2v sr = S[r]; const size_t off = (size_t)(u.pm * BM + r) * ldc + col0;
#pragma unroll
                for (int bj = 0; bj < 2; ++bj)
#pragma unroll
                    for (int n = 0; n < 2; ++n) { const f32x4 bs = *(const f32x4*)(base + off + bj * HALF + n * 16); acc[ai][bj][m][n] = bs + (acc[ai][bj][m][n] - sr.x) * sr.y; }
                asm volatile("" : "+v"(acc[ai][0][m][0]), "+v"(acc[ai][0][m][1]), "+v"(acc[ai][1][m][0]), "+v"(acc[ai][1][m][1]));
                if (m & 1) asm volatile("" ::: "memory"); }
        const bool bad1 = bad;
        bad = st2.run(acc, u, wr, wc, fr, fq, lds, wid, lane) || bad;
#pragma unroll
        for (int ai = 0; ai < 2; ++ai)
#pragma unroll
            for (int m = 0; m < 4; ++m) { const int r = ai * HALF + wr * 64 + m * 16 + fr; const f32x2v sr = S[r]; const size_t off = (size_t)(u.pm * BM + r) * ldc + col0;
#pragma unroll
                for (int bj = 0; bj < 2; ++bj)
#pragma unroll
                    for (int n = 0; n < 2; ++n) { const f32x4 x1 = acc[ai][bj][m][n]; *(f32x4*)(out + off + bj * HALF + n * 16) = bad1 ? (f32x4){qnan, qnan, qnan, qnan} : x1;
                        const f32x4 o = (x1 - sr.x) * sr.y; u32x2v w; w.x = cvt_pk_bf16(o[0], o[1]); w.y = cvt_pk_bf16(o[2], o[3]);
                        if (bad) { w.x = 0x7fc07fc0u; w.y = 0x7fc07fc0u; } *(u32x2v*)(xn + off + bj * HALF + n * 16) = w; }
                asm volatile("" ::: "memory"); }
    }
};

template <class Epi, class Sched, bool ALIGN_EPI = false, bool SP2 = false>
__device__ __forceinline__ void gemm_phase(PG8_LAS unsigned char* lds, const Gemm g, const Sched& S, const Epi& E) {
    const int tid = threadIdx.x, wid = __builtin_amdgcn_readfirstlane(tid >> 6), lane = tid & 63, wr = wid >> 2, wc = wid & 3, fr = lane & 15, fq = lane >> 4;
    const int K = g.K, nt = K / BK;
    unsigned voffA[2], voffB[2];
#pragma unroll
    for (int i = 0; i < 2; ++i) { int R, C; stage_rc(tid * 16 + i * 8192, R, C); const int Rb = Epi::PERM ? ((R & ~31) + perm32(R & 31)) : R;
        voffA[i] = (unsigned)(R * K + C) * 2u; voffB[i] = (unsigned)(Rb * K + C) * 2u; }
    const size_t kstep = (size_t)(BK * 2);
    const size_t hstep = (size_t)HALF * K * 2;
    const size_t tstep = 2 * hstep;
    const unsigned ldsw = (unsigned)wid * 1024u;
    const int aoff = lds_byte(wr * 64 + fr, fq * 8), boff = lds_byte(wc * 32 + fr, fq * 8);
#define PG8_SA(b, h) (((b) * 2 + (h)) * HTB)
#define PG8_SB(b, h) ((4 + (b) * 2 + (h)) * HTB)
#define PG8_STAGE(bufoff, gbase, voff) do { _Pragma("unroll") for (int _i = 0; _i < 2; ++_i) \
        __builtin_amdgcn_global_load_lds((const unsigned*)((const char*)(gbase) + (voff)[_i]), (PG8_LAS unsigned*)(lds + (bufoff) + ldsw + _i * 8192), 16, 0, 0); } while (0)
#define PG8_LDA(dst, b, h) do { _Pragma("unroll") for (int m = 0; m < 4; ++m) _Pragma("unroll") for (int k = 0; k < 2; ++k) dst[m][k] = *(const PG8_LAS bf16x8*)(lds + PG8_SA(b, h) + aoff + m * 2048 + k * 1024); } while (0)
#define PG8_LDB(dst, b, h) do { _Pragma("unroll") for (int n = 0; n < 2; ++n) _Pragma("unroll") for (int k = 0; k < 2; ++k) dst[n][k] = *(const PG8_LAS bf16x8*)(lds + PG8_SB(b, h) + boff + n * 2048 + k * 1024); } while (0)
#define PG8_MMA(ai, bj, At, Bt) do { __builtin_amdgcn_s_setprio(1); _Pragma("unroll") for (int m = 0; m < 4; ++m) _Pragma("unroll") for (int n = 0; n < 2; ++n) _Pragma("unroll") for (int k = 0; k < 2; ++k) \
        acc[ai][bj][m][n] = __builtin_amdgcn_mfma_f32_16x16x32_bf16(Bt[n][k], At[m][k], acc[ai][bj][m][n], 0, 0, 0); __builtin_amdgcn_s_setprio(0); } while (0)
#define PG8_WAIT_V(n) asm volatile("s_waitcnt vmcnt(" #n ")" ::: "memory")
#define PG8_WAIT_L(n) asm volatile("s_waitcnt lgkmcnt(" #n ")" ::: "memory")
#define PG8_BAR __builtin_amdgcn_s_barrier()
#define PG8_SCHED __builtin_amdgcn_sched_barrier(0)
    Unit cur, nxt; int ui = 0;
    if (!S.next(0, cur)) return;
    f32x4 acc[2][2][4][2];
#pragma unroll
    for (int a = 0; a < 2; ++a)
#pragma unroll
        for (int b = 0; b < 2; ++b)
#pragma unroll
            for (int m = 0; m < 4; ++m)
#pragma unroll
                for (int n = 0; n < 2; ++n) acc[a][b][m][n] = (f32x4){0.f, 0.f, 0.f, 0.f};
    bf16x8 At[4][2], B0[2][2], B1[2][2];
    const char* cA = (const char*)g.A + (size_t)cur.pm * tstep; const char* cB = (const char*)g.Bt + (size_t)cur.pn * tstep;
    S.a_ready(cur);
    if constexpr (SP2) {
        PG8_STAGE(PG8_SB(0, 0), cB, voffB); PG8_STAGE(PG8_SB(0, 1), cB + hstep, voffB); PG8_STAGE(PG8_SA(0, 0), cA, voffA); PG8_STAGE(PG8_SA(0, 1), cA + hstep, voffA);
        if (wr == 1) PG8_BAR;
        PG8_WAIT_V(2); PG8_BAR;
        PG8_STAGE(PG8_SB(1, 0), cB + kstep, voffB); PG8_STAGE(PG8_SA(1, 0), cA + kstep, voffA); PG8_STAGE(PG8_SB(1, 1), cB + hstep + kstep, voffB);
        PG8_WAIT_V(6); PG8_BAR;
    } else {
        PG8_STAGE(PG8_SB(0, 0), cB, voffB); PG8_STAGE(PG8_SA(0, 0), cA, voffA); PG8_STAGE(PG8_SB(0, 1), cB + hstep, voffB); PG8_STAGE(PG8_SA(0, 1), cA + hstep, voffA);
        if (wr == 1) PG8_BAR;
        PG8_WAIT_V(4); PG8_BAR;
        PG8_STAGE(PG8_SB(1, 0), cB + kstep, voffB); PG8_STAGE(PG8_SA(1, 0), cA + kstep, voffA); PG8_STAGE(PG8_SB(1, 1), cB + hstep + kstep, voffB);
        PG8_WAIT_V(6); PG8_BAR;
    }
    for (;;) {
        const bool has_next = S.next(ui + 1, nxt);
        const char* nA = has_next ? (const char*)g.A + (size_t)nxt.pm * tstep : cA; const char* nB = has_next ? (const char*)g.Bt + (size_t)nxt.pn * tstep : cB;
        for (int t = 0; t < nt; t += 2) {
            const bool last = (t == nt - 2);
            const char* a1 = cA + (size_t)(t + 1) * kstep;
            const char* a2 = last ? nA : cA + (size_t)(t + 2) * kstep; const char* b2 = last ? nB : cB + (size_t)(t + 2) * kstep;
            const char* a3 = a2 + kstep; const char* b3 = b2 + kstep;
            if (last && has_next) S.a_ready(nxt);
            if constexpr (SP2) {
            PG8_LDB(B0, 0, 0); PG8_LDB(B1, 0, 1); PG8_SCHED; PG8_LDA(At, 0, 0); PG8_STAGE(PG8_SA(1, 1), a1 + hstep, voffA);
            PG8_WAIT_V(8); PG8_WAIT_L(0); PG8_BAR; PG8_MMA(0, 0, At, B0); PG8_MMA(0, 1, At, B1); PG8_BAR; PG8_SCHED;
            PG8_LDA(At, 0, 1); PG8_STAGE(PG8_SB(0, 0), b2, voffB); PG8_STAGE(PG8_SB(0, 1), b2 + hstep, voffB); PG8_STAGE(PG8_SA(0, 0), a2, voffA);
            PG8_WAIT_V(8); PG8_WAIT_L(0); PG8_BAR; PG8_MMA(1, 0, At, B0); PG8_MMA(1, 1, At, B1); PG8_BAR; PG8_SCHED;
            PG8_LDB(B0, 1, 0); PG8_LDB(B1, 1, 1); PG8_SCHED; PG8_LDA(At, 1, 0); PG8_STAGE(PG8_SA(0, 1), a2 + hstep, voffA);
            PG8_WAIT_V(8); PG8_WAIT_L(0); PG8_BAR; PG8_MMA(0, 0, At, B0); PG8_MMA(0, 1, At, B1); PG8_BAR; PG8_SCHED;
            PG8_LDA(At, 1, 1); PG8_STAGE(PG8_SB(1, 0), b3, voffB); PG8_STAGE(PG8_SB(1, 1), b3 + hstep, voffB); PG8_STAGE(PG8_SA(1, 0), a3, voffA);
            PG8_WAIT_V(8); PG8_WAIT_L(0); PG8_BAR; PG8_MMA(1, 0, At, B0); PG8_MMA(1, 1, At, B1); PG8_BAR; PG8_SCHED;
            } else {
            PG8_LDB(B0, 0, 0); PG8_SCHED; PG8_LDA(At, 0, 0); PG8_STAGE(PG8_SA(1, 1), a1 + hstep, voffA);
            PG8_WAIT_L(8); PG8_BAR; PG8_WAIT_L(0); PG8_MMA(0, 0, At, B0); PG8_BAR; PG8_SCHED;
            PG8_LDB(B1, 0, 1); PG8_STAGE(PG8_SB(0, 0), b2, voffB);
            PG8_BAR; PG8_WAIT_L(0); PG8_MMA(0, 1, At, B1); PG8_BAR;
            PG8_LDA(At, 0, 1); PG8_STAGE(PG8_SA(0, 0), a2, voffA);
            PG8_BAR; PG8_WAIT_L(0); PG8_MMA(1, 0, At, B0); PG8_BAR; PG8_SCHED;
            PG8_STAGE(PG8_SB(0, 1), b2 + hstep, voffB);
            PG8_WAIT_V(6); PG8_BAR; PG8_MMA(1, 1, At, B1); PG8_BAR;
            PG8_LDB(B0, 1, 0); PG8_SCHED; PG8_LDA(At, 1, 0); PG8_STAGE(PG8_SA(0, 1), a2 + hstep, voffA);
            PG8_WAIT_L(8); PG8_BAR; PG8_WAIT_L(0); PG8_MMA(0, 0, At, B0); PG8_BAR; PG8_SCHED;
            PG8_LDB(B1, 1, 1); PG8_STAGE(PG8_SB(1, 0), b3, voffB);
            PG8_BAR; PG8_WAIT_L(0); PG8_MMA(0, 1, At, B1); PG8_BAR;
            PG8_LDA(At, 1, 1); PG8_STAGE(PG8_SA(1, 0), a3, voffA);
            PG8_BAR; PG8_WAIT_L(0); PG8_MMA(1, 0, At, B0); PG8_BAR; PG8_SCHED;
            PG8_STAGE(PG8_SB(1, 1), b3 + hstep, voffB);
            PG8_WAIT_V(6); PG8_BAR; PG8_MMA(1, 1, At, B1); PG8_BAR;
            }
        }
        if constexpr (ALIGN_EPI) { if (wr == 0) PG8_BAR; }
        if constexpr (!Epi::AFTER_DRAIN) { E(acc, cur, wr, wc, fr, fq); S.done(cur); }
        if (!has_next) break;
#pragma unroll
        for (int a = 0; a < 2; ++a)
#pragma unroll
            for (int b = 0; b < 2; ++b)
#pragma unroll
                for (int m = 0; m < 4; ++m)
#pragma unroll
                    for (int n = 0; n < 2; ++n) acc[a][b][m][n] = (f32x4){0.f, 0.f, 0.f, 0.f};
        cur = nxt; cA = nA; cB = nB; ++ui;
        if constexpr (ALIGN_EPI) { if (wr == 1) PG8_BAR; }
    }
    PG8_WAIT_V(0);
    if constexpr (!ALIGN_EPI) { if (wr == 0) PG8_BAR; }
    PG8_BAR;
    if constexpr (Epi::AFTER_DRAIN) { E.fused(acc, cur, wr, wc, fr, fq, lds, wid, lane); S.done(cur); }
#undef PG8_SA
#undef PG8_SB
#undef PG8_STAGE
#undef PG8_LDA
#undef PG8_LDB
#undef PG8_MMA
#undef PG8_WAIT_V
#undef PG8_WAIT_L
#undef PG8_BAR
#undef PG8_SCHED
}
}

#ifndef PG8_SP2
#define PG8_SP2 true
#endif
#ifndef PG8_ALIGN
#define PG8_ALIGN true
#endif

namespace pg8 {
struct EpiProj {
    static constexpr bool PERM = true, AFTER_DRAIN = false;
    bf16_t* O; size_t stride; float* kmsum; float qscale;
    __device__ __forceinline__ void operator()(const f32x4 (&acc)[2][2][4][2], const Unit& u, int wr, int wc, int fr, int fq) const {
        const int t = u.pn >> 1, colt = (u.pn & 1) * BM;
        const int row0 = u.pm * BM + wr * 64 + fr, col0 = colt + wc * 32 + 8 * fq;
        bf16_t* base = O + (size_t)t * stride; const float sc = (t == 2) ? qscale : 1.f;
#pragma unroll
        for (int ai = 0; ai < 2; ++ai)
#pragma unroll
            for (int m = 0; m < 4; ++m) { bf16_t* rowp = base + (size_t)(row0 + ai * HALF + m * 16) * 512 + col0;
#pragma unroll
                for (int bj = 0; bj < 2; ++bj) { const f32x4 v0 = acc[ai][bj][m][0] * sc, v1 = acc[ai][bj][m][1] * sc;
                    u32x4 w; w.x = cvt_pk_bf16(v0[0], v0[1]); w.y = cvt_pk_bf16(v0[2], v0[3]); w.z = cvt_pk_bf16(v1[0], v1[1]); w.w = cvt_pk_bf16(v1[2], v1[3]);
                    *(u32x4*)(rowp + bj * HALF) = w; } }
        if (t == 3) {
#pragma unroll
            for (int bj = 0; bj < 2; ++bj)
#pragma unroll
                for (int n = 0; n < 2; ++n) { f32x4 s = (f32x4){0.f, 0.f, 0.f, 0.f};
#pragma unroll
                    for (int ai = 0; ai < 2; ++ai)
#pragma unroll
                        for (int m = 0; m < 4; ++m) s += acc[ai][bj][m][n];
#pragma unroll
                    for (int o = 1; o < 16; o <<= 1) { s[0] += __shfl_xor(s[0], o); s[1] += __shfl_xor(s[1], o); s[2] += __shfl_xor(s[2], o); s[3] += __shfl_xor(s[3], o); }
                    if (fr == 0) { float* kp = kmsum + (size_t)u.pm * 512 + col0 + bj * HALF + 4 * n;
                        atomicAdd(kp + 0, s[0]); atomicAdd(kp + 1, s[1]); atomicAdd(kp + 2, s[2]); atomicAdd(kp + 3, s[3]); } }
        }
    }
};
struct EpiF32 {
    static constexpr bool PERM = false, AFTER_DRAIN = false;
    float* C; int ldc;
    __device__ __forceinline__ void operator()(const f32x4 (&acc)[2][2][4][2], const Unit& u, int wr, int wc, int fr, int fq) const {
        const int row0 = u.pm * BM + wr * 64 + fr, col0 = u.pn * BM + wc * 32 + 4 * fq;
#pragma unroll
        for (int ai = 0; ai < 2; ++ai)
#pragma unroll
            for (int m = 0; m < 4; ++m) { float* rowp = C + (size_t)(row0 + ai * HALF + m * 16) * ldc + col0;
#pragma unroll
                for (int bj = 0; bj < 2; ++bj)
#pragma unroll
                    for (int n = 0; n < 2; ++n) *(f32x4*)(rowp + bj * HALF + n * 16) = acc[ai][bj][m][n]; }
    }
};
}

namespace pg8 {
constexpr unsigned TOK_NONE = 0xffffffffu;
template <class Epi, class Sched, bool GATHER, bool ALIGN_EPI = true>
__device__ __forceinline__ void gemm_phase_g(PG8_LAS unsigned char* lds, const Gemm g, const Sched& S, const Epi& E, const PG8_LAS unsigned* toktab) {
    const int tid = threadIdx.x, wid = __builtin_amdgcn_readfirstlane(tid >> 6), lane = tid & 63, wr = wid >> 2, wc = wid & 3, fr = lane & 15, fq = lane >> 4;
    const int K = g.K, nt = K / BK;
    unsigned voffB[2]; int RA[2]; unsigned CA2[2];
#pragma unroll
    for (int i = 0; i < 2; ++i) { int R, C; stage_rc(tid * 16 + i * 8192, R, C); const int Rb = Epi::PERM ? ((R & ~31) + perm32(R & 31)) : R;
        RA[i] = R; CA2[i] = (unsigned)C * 2u; voffB[i] = (unsigned)(Rb * K + C) * 2u; }
    const size_t kstep = (size_t)(BK * 2), hstep = (size_t)HALF * K * 2, tstep = 2 * hstep;
    const unsigned ldsw = (unsigned)wid * 1024u;
    const int aoff = lds_byte(wr * 64 + fr, fq * 8), boff = lds_byte(wc * 32 + fr, fq * 8);
#define PG8_SA(b, h) (((b) * 2 + (h)) * HTB)
#define PG8_SB(b, h) ((4 + (b) * 2 + (h)) * HTB)
#define PG8_STAGE(bufoff, gbase, voff) do { _Pragma("unroll") for (int _i = 0; _i < 2; ++_i) \
        __builtin_amdgcn_global_load_lds((const unsigned*)((const char*)(gbase) + (voff)[_i]), (PG8_LAS unsigned*)(lds + (bufoff) + ldsw + _i * 8192), 16, 0, 0); } while (0)
#define PG8_LDA(dst, b, h) do { _Pragma("unroll") for (int m = 0; m < 4; ++m) _Pragma("unroll") for (int k = 0; k < 2; ++k) dst[m][k] = *(const PG8_LAS bf16x8*)(lds + PG8_SA(b, h) + aoff + m * 2048 + k * 1024); } while (0)
#define PG8_LDB(dst, b, h) do { _Pragma("unroll") for (int n = 0; n < 2; ++n) _Pragma("unroll") for (int k = 0; k < 2; ++k) dst[n][k] = *(const PG8_LAS bf16x8*)(lds + PG8_SB(b, h) + boff + n * 2048 + k * 1024); } while (0)
#define PG8_MMA(ai, bj, At, Bt) do { __builtin_amdgcn_s_setprio(1); _Pragma("unroll") for (int m = 0; m < 4; ++m) _Pragma("unroll") for (int n = 0; n < 2; ++n) _Pragma("unroll") for (int k = 0; k < 2; ++k) \
        acc[ai][bj][m][n] = __builtin_amdgcn_mfma_f32_16x16x32_bf16(Bt[n][k], At[m][k], acc[ai][bj][m][n], 0, 0, 0); __builtin_amdgcn_s_setprio(0); } while (0)
#define PG8_WAIT_V(n) asm volatile("s_waitcnt vmcnt(" #n ")" ::: "memory")
#define PG8_WAIT_L(n) asm volatile("s_waitcnt lgkmcnt(" #n ")" ::: "memory")
#define PG8_BAR __builtin_amdgcn_s_barrier()
#define PG8_SCHED __builtin_amdgcn_sched_barrier(0)
#define PG8_MKOFF(VO, UI, U) do { _Pragma("unroll") for (int _h = 0; _h < 2; ++_h) _Pragma("unroll") for (int _i = 0; _i < 2; ++_i) { \
        unsigned _row; if (GATHER) { const unsigned _t = toktab[(UI) * 256 + _h * HALF + RA[_i]]; _row = (_t == TOK_NONE) ? 0u : (_t >> 1); } else _row = (unsigned)((U).pm * BM + _h * HALF + RA[_i]); \
        VO[_h][_i] = _row * (unsigned)(K * 2) + CA2[_i]; } } while (0)
    Unit cur, nxt; int ui = 0;
    if (!S.next(0, cur)) return;
    f32x4 acc[2][2][4][2];
#pragma unroll
    for (int a = 0; a < 2; ++a)
#pragma unroll
        for (int b = 0; b < 2; ++b)
#pragma unroll
            for (int m = 0; m < 4; ++m)
#pragma unroll
                for (int n = 0; n < 2; ++n) acc[a][b][m][n] = (f32x4){0.f, 0.f, 0.f, 0.f};
    bf16x8 At[4][2], B0[2][2], B1[2][2];
    const char* Ab = (const char*)g.A; const char* cB = (const char*)g.Bt + (size_t)cur.pn * tstep;
    unsigned vc[2][2], vn[2][2];
    PG8_MKOFF(vc, 0, cur);
    PG8_STAGE(PG8_SB(0, 0), cB, voffB); PG8_STAGE(PG8_SB(0, 1), cB + hstep, voffB); PG8_STAGE(PG8_SA(0, 0), Ab, vc[0]); PG8_STAGE(PG8_SA(0, 1), Ab, vc[1]);
    if (wr == 1) PG8_BAR;
    PG8_WAIT_V(2); PG8_BAR;
    PG8_STAGE(PG8_SB(1, 0), cB + kstep, voffB); PG8_STAGE(PG8_SA(1, 0), Ab + kstep, vc[0]); PG8_STAGE(PG8_SB(1, 1), cB + hstep + kstep, voffB);
    PG8_WAIT_V(6); PG8_BAR;
    for (;;) {
        const bool has_next = S.next(ui + 1, nxt);
        const char* nB = has_next ? (const char*)g.Bt + (size_t)nxt.pn * tstep : cB;
        if (has_next) { PG8_MKOFF(vn, ui + 1, nxt); } else { vn[0][0] = vc[0][0]; vn[0][1] = vc[0][1]; vn[1][0] = vc[1][0]; vn[1][1] = vc[1][1]; }
#pragma unroll 1
        for (int t = 0; t < nt; t += 2) {
            const bool last = (t == nt - 2);
            const char* a1 = Ab + (size_t)(t + 1) * kstep;
            const char* a2 = last ? Ab : Ab + (size_t)(t + 2) * kstep; const char* b2 = last ? nB : cB + (size_t)(t + 2) * kstep;
            const char* a3 = a2 + kstep; const char* b3 = b2 + kstep;
            unsigned v2[2][2];
#pragma unroll
            for (int h = 0; h < 2; ++h)
#pragma unroll
                for (int i = 0; i < 2; ++i) v2[h][i] = last ? vn[h][i] : vc[h][i];
            PG8_LDB(B0, 0, 0); PG8_LDB(B1, 0, 1); PG8_SCHED; PG8_LDA(At, 0, 0); PG8_STAGE(PG8_SA(1, 1), a1, vc[1]);
            PG8_WAIT_V(8); PG8_WAIT_L(0); PG8_BAR; PG8_MMA(0, 0, At, B0); PG8_MMA(0, 1, At, B1); PG8_BAR; PG8_SCHED;
            PG8_LDA(At, 0, 1); PG8_STAGE(PG8_SB(0, 0), b2, voffB); PG8_STAGE(PG8_SB(0, 1), b2 + hstep, voffB); PG8_STAGE(PG8_SA(0, 0), a2, v2[0]);
            PG8_WAIT_V(8); PG8_WAIT_L(0); PG8_BAR; PG8_MMA(1, 0, At, B0); PG8_MMA(1, 1, At, B1); PG8_BAR; PG8_SCHED;
            PG8_LDB(B0, 1, 0); PG8_LDB(B1, 1, 1); PG8_SCHED; PG8_LDA(At, 1, 0); PG8_STAGE(PG8_SA(0, 1), a2, v2[1]);
            PG8_WAIT_V(8); PG8_WAIT_L(0); PG8_BAR; PG8_MMA(0, 0, At, B0); PG8_MMA(0, 1, At, B1); PG8_BAR; PG8_SCHED;
            PG8_LDA(At, 1, 1); PG8_STAGE(PG8_SB(1, 0), b3, voffB); PG8_STAGE(PG8_SB(1, 1), b3 + hstep, voffB); PG8_STAGE(PG8_SA(1, 0), a3, v2[0]);
            PG8_WAIT_V(8); PG8_WAIT_L(0); PG8_BAR; PG8_MMA(1, 0, At, B0); PG8_MMA(1, 1, At, B1); PG8_BAR; PG8_SCHED;
        }
        if constexpr (ALIGN_EPI) { if (wr == 0) PG8_BAR; }
        E(acc, cur, ui, wr, wc, fr, fq);
        if (!has_next) break;
#pragma unroll
        for (int a = 0; a < 2; ++a)
#pragma unroll
            for (int b = 0; b < 2; ++b)
#pragma unroll
                for (int m = 0; m < 4; ++m)
#pragma unroll
                    for (int n = 0; n < 2; ++n) acc[a][b][m][n] = (f32x4){0.f, 0.f, 0.f, 0.f};
        cur = nxt; cB = nB; ++ui;
#pragma unroll
        for (int h = 0; h < 2; ++h)
#pragma unroll
            for (int i = 0; i < 2; ++i) vc[h][i] = vn[h][i];
        if constexpr (ALIGN_EPI) { if (wr == 1) PG8_BAR; }
    }
    PG8_WAIT_V(0);
    if constexpr (!ALIGN_EPI) { if (wr == 0) PG8_BAR; }
    PG8_BAR;
#undef PG8_SA
#undef PG8_SB
#undef PG8_STAGE
#undef PG8_LDA
#undef PG8_LDB
#undef PG8_MMA
#undef PG8_WAIT_V
#undef PG8_WAIT_L
#undef PG8_BAR
#undef PG8_SCHED
#undef PG8_MKOFF
}
struct MoeOrder {
    const PG8_LAS unsigned* toff; int nct, G, c;
    __device__ __forceinline__ bool next(int i, Unit& u) const {
        const int L = i * G + c; const int total = (int)toff[32] * nct; if (L >= total) return false;
        const int rt = L / nct, ct = L % nct; int e = 0; while ((int)toff[e + 1] <= rt) ++e;
        u.pm = rt; u.pn = e * nct + ct; return true;
    }
};
struct EpiMoeUp {
    static constexpr bool PERM = true, AFTER_DRAIN = false;
    bf16_t* H; const float* RW; const PG8_LAS unsigned* toktab;
    __device__ __forceinline__ void operator()(const f32x4 (&acc)[2][2][4][2], const Unit& u, int ui, int wr, int wc, int fr, int fq) const {
        const int col0 = (u.pn & 1) * HALF + wc * 32 + 8 * fq;
#pragma unroll
        for (int ai = 0; ai < 2; ++ai)
#pragma unroll
            for (int m = 0; m < 4; ++m) { const int r = ai * HALF + wr * 64 + m * 16 + fr; const unsigned tk = toktab[ui * 256 + r]; const float w = (tk != TOK_NONE) ? RW[tk] : 0.f;
                float h[8];
#pragma unroll
                for (int n = 0; n < 2; ++n)
#pragma unroll
                    for (int j = 0; j < 4; ++j) { const float a = acc[ai][0][m][n][j], b = acc[ai][1][m][n][j]; h[4 * n + j] = a / (1.f + __expf(-a)) * b * w; }
                u32x4 o; o.x = cvt_pk_bf16(h[0], h[1]); o.y = cvt_pk_bf16(h[2], h[3]); o.z = cvt_pk_bf16(h[4], h[5]); o.w = cvt_pk_bf16(h[6], h[7]);
                *(u32x4*)(H + (size_t)(u.pm * BM + r) * 256 + col0) = o; }
    }
};
struct EpiMoeDown {
    static constexpr bool PERM = true, AFTER_DRAIN = false;
    bf16_t* YS; bf16_t* dump; const PG8_LAS unsigned* toktab;
    __device__ __forceinline__ void operator()(const f32x4 (&acc)[2][2][4][2], const Unit& u, int ui, int wr, int wc, int fr, int fq) const {
        const int col0 = (u.pn & 3) * BM + wc * 32 + 8 * fq;
#pragma unroll
        for (int ai = 0; ai < 2; ++ai)
#pragma unroll
            for (int m = 0; m < 4; ++m) { const int r = ai * HALF + wr * 64 + m * 16 + fr; const unsigned tk = toktab[ui * 256 + r];
                bf16_t* rowp = ((tk != TOK_NONE) ? YS + (size_t)tk * 1024 : dump) + col0;
#pragma unroll
                for (int bj = 0; bj < 2; ++bj) { const f32x4 v0 = acc[ai][bj][m][0], v1 = acc[ai][bj][m][1];
                    u32x4 o; o.x = cvt_pk_bf16(v0[0], v0[1]); o.y = cvt_pk_bf16(v0[2], v0[3]); o.z = cvt_pk_bf16(v1[0], v1[1]); o.w = cvt_pk_bf16(v1[2], v1[3]);
                    *(u32x4*)(rowp + bj * HALF) = o; }
                asm volatile("" ::: "memory"); }
    }
};
}

#include <hip/hip_bf16.h>
#include <cmath>
namespace attn_body {
using bf16=__hip_bfloat16;
using bf16x8=__attribute__((ext_vector_type(8)))short;
using s16x4=__attribute__((ext_vector_type(4)))short;
using f32x16=__attribute__((ext_vector_type(16)))float;
using u32x4=__attribute__((ext_vector_type(4)))unsigned;
constexpr int BATCH=4,NHEAD=8,SEQ=4096,D=64,DM=NHEAD*D;
constexpr int NW=8,QBLK=32,QB=QBLK*NW,KVBLK=64,NQB=SEQ/QB;
constexpr int ATTN_PITCH=DM, ATTN_UNIT_ROWS=QB;
__device__ __forceinline__ int crow(int r,int hi){return (r&3)+8*(r>>2)+4*hi;}
#define SBAR() __builtin_amdgcn_sched_barrier(0)
__device__ __forceinline__ void maskbias(f32x16&p0,f32x16&p1,int relbase,int hi,const __attribute__((address_space(3))) float*RT){
  const __attribute__((address_space(3))) float*p=RT+(511-relbase+4*hi);
  #pragma unroll
  for(int r=0;r<16;++r){ p0[r]+=p[(r&3)+8*(r>>2)]; p1[r]+=p[32+(r&3)+8*(r>>2)]; if((r&3)==3)__builtin_amdgcn_sched_barrier(0); }
}

constexpr int NSLOT=3, SLOTB=8192;
constexpr int LDS_K=0, LDS_V=NSLOT*SLOTB, LDS_WS=2*NSLOT*SLOTB, LDS_OST=LDS_WS+NW*64*4, LDS_KM=LDS_OST+NW*4096, LDS_BT=LDS_KM+4096, LDS_BYTES=LDS_BT+3072;
constexpr float C2=0.125f*1.4426950408889634f;
__device__ __forceinline__ void glds16(const void*gsrc,unsigned lds_dst){unsigned keep;
  asm volatile("s_mov_b32 %0, m0\n\ts_mov_b32 m0, %2\n\ts_nop 0\n\tglobal_load_lds_dwordx4 %1, off\n\ts_mov_b32 m0, %0":"=&s"(keep):"v"(gsrc),"s"(lds_dst):"memory");}
__device__ __forceinline__ float max3f(float a,float b,float c){float r;asm("v_max3_f32 %0, %1, %2, %3":"=v"(r):"v"(a),"v"(b),"v"(c));return r;}
__device__ __forceinline__ float max2f(float a,float b){float r;asm("v_max_f32_e32 %0, %1, %2":"=v"(r):"v"(a),"v"(b));return r;}
__device__ __forceinline__ float fadd_s(float a,float b){float r;asm("v_add_f32_e32 %0, %1, %2":"=v"(r):"v"(a),"v"(b));return r;}
__device__ __forceinline__ float fsub_s(float a,float b){float r;asm("v_sub_f32_e32 %0, %1, %2":"=v"(r):"v"(a),"v"(b));return r;}
typedef float f32x4_t __attribute__((ext_vector_type(4))); typedef float f32x2_t __attribute__((ext_vector_type(2))); typedef __bf16 bf16x2_t __attribute__((ext_vector_type(2)));
__device__ __forceinline__ unsigned cvtpk_s(float lo,float hi){f32x2_t v={lo,hi};bf16x2_t b=__builtin_convertvector(v,bf16x2_t);return __builtin_bit_cast(unsigned,b);}
#define WAIT_BAR(N) asm volatile("s_waitcnt vmcnt(" #N ") lgkmcnt(0)\n\ts_barrier":::"memory")

__device__ __forceinline__ void qkt(f32x16&p0,f32x16&p1,const char*Kslot,const bf16x8*qr,int r32,int hi){
  const char*kb=Kslot+hi*1024+r32*16;
  #pragma unroll
  for(int d0=0;d0<4;++d0){
    const bf16x8 b0=*reinterpret_cast<const bf16x8*>(kb+d0*2048);
    const bf16x8 b1=*reinterpret_cast<const bf16x8*>(kb+d0*2048+512);
    if(d0==0){p0=__builtin_amdgcn_mfma_f32_32x32x16_bf16(b0,qr[0],f32x16{},0,0,0);p1=__builtin_amdgcn_mfma_f32_32x32x16_bf16(b1,qr[0],f32x16{},0,0,0);}
    else{p0=__builtin_amdgcn_mfma_f32_32x32x16_bf16(b0,qr[d0],p0,0,0,0);p1=__builtin_amdgcn_mfma_f32_32x32x16_bf16(b1,qr[d0],p1,0,0,0);}}
}
typedef __attribute__((address_space(3))) const char* lds_cptr;
typedef short v4i16_t __attribute__((ext_vector_type(4)));
__device__ __forceinline__ void kload8(bf16x8*kf,lds_cptr kp){
  kf[0]=*(const __attribute__((address_space(3))) bf16x8*)(kp);      kf[1]=*(const __attribute__((address_space(3))) bf16x8*)(kp+512);
  kf[2]=*(const __attribute__((address_space(3))) bf16x8*)(kp+2048); kf[3]=*(const __attribute__((address_space(3))) bf16x8*)(kp+2560);
  kf[4]=*(const __attribute__((address_space(3))) bf16x8*)(kp+4096); kf[5]=*(const __attribute__((address_space(3))) bf16x8*)(kp+4608);
  kf[6]=*(const __attribute__((address_space(3))) bf16x8*)(kp+6144); kf[7]=*(const __attribute__((address_space(3))) bf16x8*)(kp+6656);
}
__device__ __forceinline__ void kload2(bf16x8*kf,lds_cptr kp,int j){ kf[2*j]=*(const __attribute__((address_space(3))) bf16x8*)(kp+j*2048); kf[2*j+1]=*(const __attribute__((address_space(3))) bf16x8*)(kp+j*2048+512); }
__device__ __forceinline__ s16x4 vtr(lds_cptr p){ return __builtin_bit_cast(s16x4,__builtin_amdgcn_ds_read_tr16_b64_v4i16((__attribute__((address_space(3))) v4i16_t*)p)); }
__device__ __forceinline__ float rowmax(const f32x16&p0,const f32x16&p1){
  float a=max3f(p0[0],p0[1],p1[0]),b=max3f(p0[2],p0[3],p1[1]);a=max3f(a,p1[2],p1[3]);
  #pragma unroll
  for(int r=4;r<16;r+=4){a=max3f(a,p0[r],p0[r+1]);b=max3f(b,p0[r+2],p0[r+3]);a=max3f(a,p1[r],p1[r+1]);b=max3f(b,p1[r+2],p1[r+3]);}
  const float m=max2f(a,b);
  auto rr=__builtin_amdgcn_permlane32_swap(__float_as_uint(m),__float_as_uint(m),false,false);
  return max2f(__uint_as_float(rr[0]),__uint_as_float(rr[1]));
}
__device__ __forceinline__ void pv(f32x16*o,int vb,bf16x8 pa0,bf16x8 pa1,bf16x8 pa2,bf16x8 pa3){
  #pragma unroll
  for(int d0=0;d0<2;++d0){s16x4 lo[4],hi[4];
    #pragma unroll
    for(int ks=0;ks<4;++ks){
      asm volatile("ds_read_b64_tr_b16 %0,%1 offset:%c2":"=&v"(lo[ks]):"v"(vb),"i"(d0*4096+ks*1024):"memory");
      asm volatile("ds_read_b64_tr_b16 %0,%1 offset:%c2":"=&v"(hi[ks]):"v"(vb),"i"(d0*4096+ks*1024+512):"memory");}
    asm volatile("s_waitcnt lgkmcnt(0)":::"memory");SBAR();
    #define PK(k) (bf16x8){lo[k][0],lo[k][1],lo[k][2],lo[k][3],hi[k][0],hi[k][1],hi[k][2],hi[k][3]}
    o[d0]=__builtin_amdgcn_mfma_f32_32x32x16_bf16(pa0,PK(0),o[d0],0,0,0);
    o[d0]=__builtin_amdgcn_mfma_f32_32x32x16_bf16(pa1,PK(1),o[d0],0,0,0);
    o[d0]=__builtin_amdgcn_mfma_f32_32x32x16_bf16(pa2,PK(2),o[d0],0,0,0);
    o[d0]=__builtin_amdgcn_mfma_f32_32x32x16_bf16(pa3,PK(3),o[d0],0,0,0);
    #undef PK
  }
}

#ifndef ATTN_STORE16
#define ATTN_STORE16(p,v) (*(u32x4*)(p)=(v))
#endif
template<int THRL> __device__ __forceinline__ void attn_unit(int b,int h,int qb,const bf16*Q,const bf16*__restrict__ K,const bf16*__restrict__ V,bf16*O,const float*kmsum,const float*rel_bias,const unsigned char*t5b,char*shm){
  const int tid=threadIdx.x,lane=tid&63,r32=lane&31,hi=lane>>5; const int wid=__builtin_amdgcn_readfirstlane(tid>>6);
  const long rowbase=(long)b*SEQ; const int q0=qb*QB;
  const bf16*Qw=Q+(rowbase+q0+wid*QBLK)*DM+h*D;
  const bf16*Kh=K+rowbase*DM+h*D,*Vh=V+rowbase*DM+h*D;
  typedef __attribute__((address_space(3))) char* lds_wptr; const lds_wptr shm3=(lds_wptr)shm;
  const unsigned lds0=(unsigned)(uintptr_t)shm;
  float*wsf=(float*)(shm+LDS_WS)+wid*64;
  const bf16*ksrc=Kh+(long)lane*DM+wid*8;
  const bf16*vsrc=Vh+(long)(16*(wid&3)+(lane>>2))*DM+(wid>>2)*32+(lane&3)*8;
  const unsigned kdst=lds0+LDS_K+wid*1024, vdst=lds0+LDS_V+wid*1024;
  #define TMAP(t) (((t)<4)?(4*qb+(t)):((t)-4))
  #define DMA_K(t,slot) glds16(ksrc+(long)TMAP(t)*KVBLK*DM,(unsigned)__builtin_amdgcn_readfirstlane(kdst+(slot)))
  #define DMA_V(t,slot) glds16(vsrc+(long)TMAP(t)*KVBLK*DM,(unsigned)__builtin_amdgcn_readfirstlane(vdst+(slot)))
  const int vb0=(int)(lds0+LDS_V)+((lane>>4)&1)*32+(lane&3)*8+(4*hi+((lane&15)>>2))*64;
  const char*Kbase=shm+LDS_K; bf16x8 kf[8];
  const lds_cptr kp0=shm3+LDS_K+hi*1024+r32*16; const lds_cptr vp0=shm3+LDS_V+((lane>>4)&1)*32+(lane&3)*8+(4*hi+((lane&15)>>2))*64;
  const int NT=(q0+QB)/KVBLK;
  {
    if(tid<256){ const int jb_=tid>>4,d4_=(tid&15)*4; *(__attribute__((address_space(3))) f32x4_t*)(shm3+LDS_KM+tid*16)=*(const f32x4_t*)(kmsum+((long)(b*(SEQ/QB)+jb_)*DM+h*D+d4_)); }
    for(int k_=tid;k_<767;k_+=NW*64){ const int rel_=511-k_; float v_=0.f; if(rel_<0)v_=-INFINITY; else if(rel_<113)v_=(rel_bias[(int)t5b[rel_]*NHEAD+h]-rel_bias[31*NHEAD+h])*1.4426950408889634f;
      ((__attribute__((address_space(3))) float*)(shm3+LDS_BT))[k_]=v_; } }
  DMA_K(0,0);DMA_V(0,0);DMA_K(1,SLOTB);
  bf16x8 qr[4];
  #pragma unroll
  for(int d0=0;d0<4;++d0)qr[d0]=*reinterpret_cast<const bf16x8*>(&Qw[(long)r32*DM+d0*16+hi*8]);
  float mhat=0.f,l_reg=0.f;f32x16 o[2];o[0]=f32x16{};o[1]=f32x16{};
  const int qrel=wid*QBLK+r32;
  #define CMASK(P0,P1,t) do{ const int t_=(t); if(t_<4){ if(32*wid-64*t_-63<113) maskbias(P0,P1,qrel-64*t_,hi,BT); } \
    else if(((t_-4)>>2)==qb-1){ const int ko_=256-64*((t_-4)&3); if(32*wid+ko_-63<113) maskbias(P0,P1,qrel+ko_,hi,BT); } }while(0)
  bool resc=false;
  #define START(P0,P1) do{ const float rm=rowmax(P0,P1); resc=false; \
    { const float dl=rm; mhat=fadd_s(mhat,dl); \
      _Pragma("unroll") for(int r=0;r<16;++r){P0[r]=fsub_s(P0[r],dl);P1[r]=fsub_s(P1[r],dl);} \
      } \
    _Pragma("unroll") for(int r=0;r<16;++r)P0[r]=__builtin_amdgcn_exp2f(P0[r]); }while(0)
  #define RESC() do{ if(resc){ asm volatile("s_waitcnt lgkmcnt(0)":::"memory"); \
      _Pragma("unroll") for(int d_=0;d_<2;++d_) _Pragma("unroll") for(int r=0;r<16;++r)o[d_][r]*=wsf[crow(r,hi)]; } }while(0)
  f32x16 pA0,pA1,pB0,pB1;
  int sl_prev=0,sl_cur=0,sl_next=SLOTB;
  #define ROT() do{sl_prev=sl_cur;sl_cur=sl_next;sl_next=(sl_next==(NSLOT-1)*SLOTB)?0:sl_next+SLOTB;}while(0)
  DMA_K(2,2*SLOTB);
  WAIT_BAR(3);
  unsigned selmask;
  { const __attribute__((address_space(3))) float*KM=(const __attribute__((address_space(3))) float*)(shm3+LDS_KM);
    float v0=-INFINITY,v1=-INFINITY,v2=-INFINITY;int i0=0,i1=0,i2=0;
    #define QF(d0,j) __builtin_bit_cast(float,(unsigned)(unsigned short)qr[d0][j]<<16)
    #pragma unroll 1
    for(int jb=0;jb<qb;++jb){ float g=0.f;
      #pragma unroll
      for(int d0=0;d0<4;++d0){ const f32x4_t ka=*(const __attribute__((address_space(3))) f32x4_t*)(KM+jb*64+16*d0+8*hi), kb2=*(const __attribute__((address_space(3))) f32x4_t*)(KM+jb*64+16*d0+8*hi+4);
        g+=QF(d0,0)*ka[0]+QF(d0,1)*ka[1]+QF(d0,2)*ka[2]+QF(d0,3)*ka[3]+QF(d0,4)*kb2[0]+QF(d0,5)*kb2[1]+QF(d0,6)*kb2[2]+QF(d0,7)*kb2[3]; }
    #undef QF
      g+=__shfl_xor(g,32);
      if(g>v0){v2=v1;i2=i1;v1=v0;i1=i0;v0=g;i0=jb;} else if(g>v1){v2=v1;i2=i1;v1=g;i1=jb;} else if(g>v2){v2=g;i2=jb;} }
    selmask=(qb>=3)?((1u<<i0)|(1u<<i1)|(1u<<i2)):((1u<<qb)-1u); }
  const __attribute__((address_space(3))) float*BT=(const __attribute__((address_space(3))) float*)(shm3+LDS_BT);
  qkt(pA0,pA1,Kbase,qr,r32,hi);asm volatile("s_nop 15\n\ts_nop 7":"+v"(pA0),"+v"(pA1));CMASK(pA0,pA1,0);
  START(pA0,pA1);
  _Pragma("unroll") for(int r=0;r<16;++r)pA1[r]=__builtin_amdgcn_exp2f(pA1[r]);
  WAIT_BAR(0);
  DMA_K(3,0);DMA_V(1,SLOTB);
  ROT();
  kload8(kf,kp0+sl_cur);
  WAIT_BAR(2);
  s16x4 vlo[8],vhi[8]; u32x4 pw0,pw1,pw2,pw3;
  #define PKW(P,B) cvtpk_s(P[B],P[B+1])
  #define PAF(k) __builtin_bit_cast(bf16x8,pw##k)
  #define VFR(i) (bf16x8){vlo[i][0],vlo[i][1],vlo[i][2],vlo[i][3],vhi[i][0],vhi[i][1],vhi[i][2],vhi[i][3]}
  #define PIN(x) asm volatile("":"+v"(x))
  #define MX3(a,b,c) __builtin_fmaxf(__builtin_fmaxf((a),(b)),(c))
  #define GAPA(MF,A0,A1,A2,A3,W0,W1,PW) do{ MF; sacc+=A0; sacc+=A1; sacc+=A2; sacc+=A3; PIN(sacc); W0; W1; PIN(PW); SBAR(); }while(0)
  #define EX(v) __builtin_amdgcn_exp2f(v)
  #define GAPB(MF,X,B) do{ MF; X[B]=EX(X[B]); X[B+1]=EX(X[B+1]); X[B+2]=EX(X[B+2]); X[B+3]=EX(X[B+3]); PIN(X); SBAR(); }while(0)
  #define VRD(i) do{ vlo[i]=vtr(vp_+(((i)>>2)*4096+((i)&3)*1024)); vhi[i]=vtr(vp_+(((i)>>2)*4096+((i)&3)*1024+512)); }while(0)
  #define KRD(G,j) do{ if(G){ kload2(kf,kp0+sl_next,j); SBAR(); } }while(0)
  #define STEP(C0,C1,P0,P1,t,GK,GV,GL) do{ SBAR(); \
    const lds_cptr vp_=vp0+sl_prev; \
    VRD(0); SBAR(); float sacc=(P0[0]+P0[1]); \
    GAPA(C0=__builtin_amdgcn_mfma_f32_32x32x16_bf16(kf[0],qr[0],f32x16{},0,0,0), P0[2],P0[3],P0[4],P0[5],     pw0[0]=PKW(P0,0), pw0[1]=PKW(P0,2), pw0); \
    VRD(4); SBAR(); GAPA(C1=__builtin_amdgcn_mfma_f32_32x32x16_bf16(kf[1],qr[0],f32x16{},0,0,0), P0[6],P0[7],P0[8],P0[9],     pw0[2]=PKW(P0,4), pw0[3]=PKW(P0,6), pw0); \
    VRD(1); SBAR(); GAPA(C0=__builtin_amdgcn_mfma_f32_32x32x16_bf16(kf[2],qr[1],C0,0,0,0),   P0[10],P0[11],P0[12],P0[13], pw1[0]=PKW(P0,8), pw1[1]=PKW(P0,10), pw1); \
    VRD(5); SBAR(); GAPA(C1=__builtin_amdgcn_mfma_f32_32x32x16_bf16(kf[3],qr[1],C1,0,0,0),   P0[14],P0[15],P1[0],P1[1],   pw1[2]=PKW(P0,12),pw1[3]=PKW(P0,14), pw1); \
    VRD(2); SBAR(); GAPA(C0=__builtin_amdgcn_mfma_f32_32x32x16_bf16(kf[4],qr[2],C0,0,0,0),   P1[2],P1[3],P1[4],P1[5],     pw2[0]=PKW(P1,0), pw2[1]=PKW(P1,2), pw2); \
    VRD(6); SBAR(); GAPA(C1=__builtin_amdgcn_mfma_f32_32x32x16_bf16(kf[5],qr[2],C1,0,0,0),   P1[6],P1[7],P1[8],P1[9],     pw2[2]=PKW(P1,4), pw2[3]=PKW(P1,6), pw2); \
    VRD(3); SBAR(); GAPA(C0=__builtin_amdgcn_mfma_f32_32x32x16_bf16(kf[6],qr[3],C0,0,0,0),   P1[10],P1[11],P1[12],P1[13], pw3[0]=PKW(P1,8), pw3[1]=PKW(P1,10), pw3); \
    VRD(7); SBAR(); GAPA(C1=__builtin_amdgcn_mfma_f32_32x32x16_bf16(kf[7],qr[3],C1,0,0,0),   P1[14],P1[15],0.f,0.f,       pw3[2]=PKW(P1,12),pw3[3]=PKW(P1,14), pw3); \
    l_reg+=sacc; \
    if(GK){DMA_K((t)+3,sl_cur);} if(GV){DMA_V((t)+1,sl_next);} \
    { const int tq_=(t); const bool sel_=(tq_<4)||((selmask>>((tq_-4)>>2))&1u); const float nm_=sel_?-mhat:-INFINITY; \
      _Pragma("unroll") for(int r=0;r<16;++r){C0[r]+=nm_;C1[r]+=nm_;} } \
    CMASK(C0,C1,t); \
    { float a=MX3(C0[0],C0[1],C1[0]),b=MX3(C0[2],C0[3],C1[1]); a=MX3(a,C1[2],C1[3]); \
      _Pragma("unroll") for(int r=4;r<16;r+=4){a=MX3(a,C0[r],C0[r+1]);b=MX3(b,C0[r+2],C0[r+3]);a=MX3(a,C1[r],C1[r+1]);b=MX3(b,C1[r+2],C1[r+3]);} \
      float rm=__builtin_fmaxf(a,b); { auto rr=__builtin_amdgcn_permlane32_swap(__float_as_uint(rm),__float_as_uint(rm),false,false); rm=__builtin_fmaxf(__uint_as_float(rr[0]),__uint_as_float(rr[1])); } \
      resc=false; \
      if(__builtin_expect(__any(rm>(float)THRL),0)){ const float dl=__builtin_fmaxf(rm,0.f); mhat+=dl; \
        _Pragma("unroll") for(int r=0;r<16;++r){C0[r]-=dl;C1[r]-=dl;} \
        const float f=__builtin_amdgcn_exp2f(-dl); l_reg*=f; if(hi==0)wsf[r32]=f; resc=true; } \
      } \
    SBAR(); \
    GAPB(o[0]=__builtin_amdgcn_mfma_f32_32x32x16_bf16(PAF(0),VFR(0),o[0],0,0,0), C0,0); \
    GAPB(o[1]=__builtin_amdgcn_mfma_f32_32x32x16_bf16(PAF(0),VFR(4),o[1],0,0,0), C0,4); \
    KRD(GL,0); GAPB(o[0]=__builtin_amdgcn_mfma_f32_32x32x16_bf16(PAF(1),VFR(1),o[0],0,0,0), C0,8); \
    KRD(GL,1); GAPB(o[1]=__builtin_amdgcn_mfma_f32_32x32x16_bf16(PAF(1),VFR(5),o[1],0,0,0), C0,12); \
    KRD(GL,2); GAPB(o[0]=__builtin_amdgcn_mfma_f32_32x32x16_bf16(PAF(2),VFR(2),o[0],0,0,0), C1,0); \
    KRD(GL,3); GAPB(o[1]=__builtin_amdgcn_mfma_f32_32x32x16_bf16(PAF(2),VFR(6),o[1],0,0,0), C1,4); \
    GAPB(o[0]=__builtin_amdgcn_mfma_f32_32x32x16_bf16(PAF(3),VFR(3),o[0],0,0,0), C1,8); \
    GAPB(o[1]=__builtin_amdgcn_mfma_f32_32x32x16_bf16(PAF(3),VFR(7),o[1],0,0,0), C1,12); \
    }while(0)
  int t=1;
  for(;t+5<NT;t+=2){
    STEP(pB0,pB1,pA0,pA1,t,true,true,true);     WAIT_BAR(2); RESC(); ROT();
    STEP(pA0,pA1,pB0,pB1,t+1,true,true,true);   WAIT_BAR(2); RESC(); ROT();
  }
  #define ENDW(tt) do{ if((tt)+3<NT){WAIT_BAR(2);} else if((tt)+2<NT){WAIT_BAR(1);} else {WAIT_BAR(0);} }while(0)
  for(;t+1<NT;t+=2){
    STEP(pB0,pB1,pA0,pA1,t,(t+3<NT),(t+1<NT),(t+1<NT));       ENDW(t);   RESC(); ROT();
    STEP(pA0,pA1,pB0,pB1,t+1,(t+4<NT),(t+2<NT),(t+2<NT));     ENDW(t+1); RESC(); ROT();
  }
  STEP(pB0,pB1,pA0,pA1,NT-1,false,false,false); RESC();
  { float sacc=pB0[0]+pB0[1]; _Pragma("unroll") for(int r=2;r<16;++r)sacc+=pB0[r]; _Pragma("unroll") for(int r=0;r<16;++r)sacc+=pB1[r]; l_reg+=sacc;
    pw0=(u32x4){PKW(pB0,0),PKW(pB0,2),PKW(pB0,4),PKW(pB0,6)};pw1=(u32x4){PKW(pB0,8),PKW(pB0,10),PKW(pB0,12),PKW(pB0,14)};pw2=(u32x4){PKW(pB1,0),PKW(pB1,2),PKW(pB1,4),PKW(pB1,6)};pw3=(u32x4){PKW(pB1,8),PKW(pB1,10),PKW(pB1,12),PKW(pB1,14)};
    SBAR(); pv(o,vb0+sl_cur,PAF(0),PAF(1),PAF(2),PAF(3)); }
  #undef PKW
  #undef PAF
  #undef VFR
  #undef PIN
  #undef MX3
  #undef GAPA
  #undef GAPB
  #undef EX
  #undef VRD
  #undef KRD
  #undef STEP
  #undef ENDW
  {auto rr=__builtin_amdgcn_permlane32_swap(__float_as_uint(l_reg),__float_as_uint(l_reg),false,false);l_reg=__uint_as_float(rr[0])+__uint_as_float(rr[1]);}
  if(hi==0)wsf[32+r32]=l_reg;asm volatile("s_waitcnt lgkmcnt(0)":::"memory");
  float rli[16];
  #pragma unroll
  for(int r=0;r<16;++r)rli[r]=__builtin_amdgcn_rcpf(wsf[32+crow(r,hi)]);
  bf16*Ow=O+(rowbase+q0+wid*QBLK)*DM+h*D;
  { bf16*stg=(bf16*)(shm+LDS_OST)+wid*2048;
    #pragma unroll
    for(int r=0;r<16;++r){const int orow=crow(r,hi);
      #pragma unroll
      for(int d0=0;d0<2;++d0)stg[orow*64+d0*32+r32]=__float2bfloat16(o[d0][r]*rli[r]);}
    asm volatile("s_waitcnt lgkmcnt(0)":::"memory");
    #pragma unroll
    for(int i=0;i<4;++i){const int row=i*8+(lane>>3),ch=lane&7; const u32x4 v=*(const u32x4*)(stg+row*64+ch*8); ATTN_STORE16(Ow+(long)row*DM+ch*8,v);} }
  asm volatile("s_waitcnt lgkmcnt(0)\n\ts_barrier":::"memory");
  #undef DMA_K
  #undef DMA_V
  #undef TMAP
  #undef CMASK
  #undef START
  #undef RESC
  #undef ROT
}
constexpr int ATTN_LDS_BYTES=LDS_BYTES;
struct AttnTensors { const bf16* Q; const bf16* K; const bf16* V; bf16* O; const float* kmsum; const float* rel_bias; const unsigned char* t5b; };
struct AttnUnit { int bh; int qb; };
struct StaticOrder {
  int vcu,G;
  __device__ __forceinline__ explicit StaticOrder(int grid,int vcu_):vcu(vcu_),G(grid){}
  __device__ __forceinline__ bool next(int i,AttnUnit&u)const{ const int w=i*G+vcu; if(w>=512)return false; const int s=w&7; u.bh=(w&255)>>3; u.qb=(w<256)?s:15-s; return true; }
  __device__ __forceinline__ void a_ready(const AttnUnit&)const{}
  __device__ __forceinline__ void done(const AttnUnit&)const{}
};
template<class Sched,int THRL=8> __device__ __forceinline__ void attn_phase(char*lds,const AttnTensors&T,const Sched&S){
  AttnUnit u;
  for(int i=0;S.next(i,u);++i){ S.a_ready(u); attn_unit<THRL>(u.bh/NHEAD,u.bh%NHEAD,u.qb,T.Q,T.K,T.V,T.O,T.kmsum,T.rel_bias,T.t5b,lds); S.done(u); }
}
#undef SBAR
#undef WAIT_BAR
}

#define GAS __attribute__((address_space(1)))
#define LAS __attribute__((address_space(3)))
typedef unsigned short bf16;
typedef unsigned v4u __attribute__((ext_vector_type(4)));
typedef float f32x4 __attribute__((ext_vector_type(4)));
typedef short bf16x8 __attribute__((ext_vector_type(8)));
typedef GAS unsigned gu32;
typedef GAS unsigned long long gu64;
#define RLX_AGENT __ATOMIC_RELAXED, __HIP_MEMORY_SCOPE_AGENT
#define LDS_WAIT() asm volatile("s_waitcnt lgkmcnt(0)" ::: "memory")
#define VM_WAIT() asm volatile("s_waitcnt vmcnt(0)" ::: "memory")
__device__ __forceinline__ unsigned long long rt() { return __builtin_amdgcn_s_memrealtime(); }
__device__ __forceinline__ unsigned f2bf(float f) { unsigned u = __builtin_bit_cast(unsigned, f); return (u + 0x7fffu + ((u >> 16) & 1u)) >> 16; }
__device__ __forceinline__ unsigned pk2(float lo, float hi) { return f2bf(lo) | (f2bf(hi) << 16); }


#define XB_TMO      128
#define XB_XCNT(j)  (256  + 64 * (j))
#define XB_XSUB(j)  (1280 + 64 * (j))
#define XB_XGEN(j)  (2304 + 64 * (j))
#define XB_TOP      3328
#define XB_TOPGEN   3392
#define XCD_BAR_WORDS 3456
#define XB_SPIN_CAP (1u << 18)

__device__ __forceinline__ unsigned xb_ld(unsigned* p)              { return __hip_atomic_load(p, __ATOMIC_RELAXED, __HIP_MEMORY_SCOPE_AGENT); }
__device__ __forceinline__ unsigned xb_add(unsigned* p, unsigned v) { return __hip_atomic_fetch_add(p, v, __ATOMIC_RELAXED, __HIP_MEMORY_SCOPE_AGENT); }
__device__ __forceinline__ unsigned xb_xcc_id() { return (unsigned)__builtin_amdgcn_s_getreg((3 << 11) | 20) & 0xFu; }
#define XB_SPIN(cond, bar) do { unsigned _sp = 0; while (cond) { __builtin_amdgcn_s_sleep(1); \
    if ((++_sp & 255u) == 0u) { if (xb_ld(&(bar)[XB_TMO])) break; if (_sp > XB_SPIN_CAP) { atomicAdd(&(bar)[XB_TMO], 1u); break; } } } } while (0)

struct XcdBarrier {
    unsigned* bar; unsigned x;
    volatile LAS unsigned* st;
};

__device__ __forceinline__ XcdBarrier xcd_barrier_post(unsigned* bar, volatile LAS unsigned* st) {
    XcdBarrier b; b.bar = bar; b.x = xb_xcc_id(); b.st = st;
    if (threadIdx.x == 0) (void)xb_add(&bar[XB_XCNT(b.x)], 1u);
    return b;
}
__device__ __forceinline__ void xcd_barrier_complete(unsigned* bar, unsigned x, unsigned& nloc, unsigned& nx) {
    const unsigned G = gridDim.x * gridDim.y * gridDim.z;
    unsigned sum, cnt, mine, sp = 0u;
    for (;;) {
        sum = 0u; cnt = 0u; mine = 0u;
#pragma unroll
        for (unsigned j = 0; j < 16; ++j) { const unsigned c = xb_ld(&bar[XB_XCNT(j)]); sum += c; cnt += (c > 0u) ? 1u : 0u; mine = (j == x) ? c : mine; }
        if (sum == G) break;
        __builtin_amdgcn_s_sleep(1);
        if ((++sp & 255u) == 0u) { if (xb_ld(&bar[XB_TMO])) break; if (sp > XB_SPIN_CAP) { atomicAdd(&bar[XB_TMO], 1u); break; } }
    }
    nloc = mine > 0u ? mine : 1u; nx = cnt > 0u ? cnt : 1u;
}

__device__ __forceinline__ void xcd_barrier(const XcdBarrier& b) {
    asm volatile("s_waitcnt vmcnt(0)" ::: "memory");
    __syncthreads();
    if (threadIdx.x == 0) {
        unsigned* bar = b.bar;
        __builtin_amdgcn_s_waitcnt(0);
        unsigned nloc = b.st[0], nx = b.st[1];
        if (nloc == 0u) { xcd_barrier_complete(bar, b.x, nloc, nx); b.st[0] = nloc; b.st[1] = nx; }
        const unsigned old = xb_add(&bar[XB_XSUB(b.x)], 1u);
        const unsigned gen = old / nloc;
        if (old + 1u == (gen + 1u) * nloc) {
            __builtin_amdgcn_fence(__ATOMIC_RELEASE, "agent");
            asm volatile("s_waitcnt vmcnt(0)" ::: "memory");
            const unsigned og = xb_add(&bar[XB_TOP], 1u);
            const unsigned tg = og / nx;
            if (og + 1u == (tg + 1u) * nx) xb_add(&bar[XB_TOPGEN], 1u);
            else XB_SPIN(xb_ld(&bar[XB_TOPGEN]) == tg, bar);
            __builtin_amdgcn_fence(__ATOMIC_ACQUIRE, "agent");
            xb_add(&bar[XB_XGEN(b.x)], 1u);
            asm volatile("s_waitcnt vmcnt(0)" ::: "memory");
        } else {
            XB_SPIN(xb_ld(&bar[XB_XGEN(b.x)]) == gen, bar);
            __builtin_amdgcn_fence(__ATOMIC_ACQUIRE, "agent");
            asm volatile("s_waitcnt vmcnt(0)" ::: "memory");
        }
    }
    __syncthreads();
}

constexpr int NWAVES = 8, NTHR = NWAVES * 64;
constexpr int D = 1024, NB = 4, S = 4096, M = NB * S;
constexpr int DL = 512, DA = 512, NH = 8, HD = 64, BLK = 256, NBLK = S / BLK;
constexpr int NPROJ = 2560, NMOD = 6;
constexpr int NG = 4, EPG = 8, NE = 32, DE = 256;
constexpr float LN_EPS = 1e-5f;
constexpr float ALPHA = 1.189207115002721f;
constexpr float LOG2E = 1.4426950408889634f;
constexpr float QSCALE = 0.125f * LOG2E;

constexpr size_t MiB = 1u << 20, KiB = 1u << 10;
constexpr size_t WS_CTL = 0, CTL_ZERO_BYTES = 1 * MiB;
constexpr int CW_TMO = 0, CW_CODE = 1, CW_BAR = 4096;
constexpr size_t WS_KMSUM = 256 * KiB;
constexpr size_t WS_ECNT = 512 * KiB;
constexpr size_t WS_MOD = 768 * KiB;
constexpr size_t WS_WIN = 1 * MiB;
constexpr size_t WS_WO = 6 * MiB;
constexpr size_t WS_W13 = 8 * MiB;
constexpr size_t WS_W2 = 40 * MiB;
constexpr size_t WS_U = 56 * MiB;
constexpr size_t WS_XL = 88 * MiB, WS_YL = 104 * MiB, WS_Q = 120 * MiB, WS_K = 136 * MiB, WS_V = 152 * MiB;
constexpr size_t WS_HL = 168 * MiB, WS_CA = 184 * MiB, WS_AO = 200 * MiB;
constexpr size_t WS_MIX = 88 * MiB;
constexpr size_t WS_X1 = 168 * MiB;
constexpr size_t WS_YS = 88 * MiB;
constexpr size_t WS_HDN = 232 * MiB;
constexpr size_t WS_LIST = 253 * MiB;
constexpr size_t WS_SUMM = 255 * MiB;
constexpr size_t WS_GW = 255 * MiB + 256 * KiB;
constexpr size_t WS_RI = 255 * MiB + 512 * KiB, WS_RW = 255 * MiB + 640 * KiB;
constexpr size_t WS_WR = 252 * MiB + 512 * KiB;
constexpr size_t WS_DUMP = 255 * MiB + 768 * KiB;
constexpr size_t WS_END = 256 * MiB;

constexpr int RING_OFF = 0, RING_BYTES = 131072;
constexpr int LDSCTL_OFF = RING_BYTES, MISC_OFF = LDSCTL_OFF + 320;
constexpr int TOKTAB_OFF = LDSCTL_OFF + 1024, TOKTAB_UNITS = 8, MOEOFF_OFF = TOKTAB_OFF + TOKTAB_UNITS * 1024;
constexpr int LDS_BYTES = 147456;
static_assert(MOEOFF_OFF + 512 <= LDS_BYTES, "LDS map");

__device__ __constant__ unsigned char T5_BUCKET[128] = {
    0, 1, 2, 3, 4, 5, 6, 7, 8, 9, 10, 11, 12, 13, 14, 15, 16, 16, 16, 17, 17, 18, 18, 18, 19, 19, 19, 20, 20, 20, 20, 21, 21, 21, 21, 22, 22, 22, 22, 22,
    23, 23, 23, 23, 23, 23, 24, 24, 24, 24, 24, 24, 25, 25, 25, 25, 25, 25, 25, 26, 26, 26, 26, 26, 26, 26, 26, 27, 27, 27, 27, 27, 27, 27, 27, 27, 27,
    28, 28, 28, 28, 28, 28, 28, 28, 28, 28, 29, 29, 29, 29, 29, 29, 29, 29, 29, 29, 29, 29, 30, 30, 30, 30, 30, 30, 30, 30, 30, 30, 30, 30, 30, 30,
    31, 31, 31, 31, 31, 31, 31, 31, 31, 31, 31, 31, 31, 31, 31};

struct Frame {
    LAS unsigned char* lds;
    volatile LAS unsigned* MISC;
    gu32* ctl;
    int tid, lane, wave, vcu, G;
};
__device__ __forceinline__ float wave_sum(float v) {
#pragma unroll
    for (int o = 1; o < 64; o <<= 1) v += __shfl_xor(v, o);
    return v;
}
__device__ __forceinline__ float bf2f(unsigned short h) { return __builtin_bit_cast(float, (unsigned)h << 16); }
__device__ __forceinline__ float bflo(unsigned w) { return __builtin_bit_cast(float, w << 16); }
__device__ __forceinline__ float bfhi(unsigned w) { return __builtin_bit_cast(float, w & 0xffff0000u); }
__device__ __forceinline__ float fsigmoid(float x) { return 1.f / (1.f + __expf(-x)); }
__device__ __forceinline__ float fsilu(float x) { return x * fsigmoid(x); }
__device__ __forceinline__ float fgelu_tanh(float x) { const float z = 0.7978845608028654f * (x + 0.044715f * x * x * x); return x / (1.f + __expf(-2.f * z)); }

__device__ __forceinline__ void p0_transpose_item(const float* W, int N, int k0, int n0, bf16* WT, int ldk, int dst_row0, const float* kgain, LAS float* scr, int lane) {
#pragma unroll 8
    for (int i = 0; i < 32; ++i) { const int kk = 2 * i + (lane >> 5); float v = W[(size_t)(k0 + kk) * N + n0 + (lane & 31)]; if (kgain) v *= kgain[k0 + kk]; scr[kk * 33 + (lane & 31)] = v; }
    LDS_WAIT(); asm volatile("" ::: "memory");
    const int c = lane & 7;
#pragma unroll
    for (int j = 0; j < 4; ++j) { const int n = (lane >> 3) + 8 * j; const LAS float* s = scr + (8 * c) * 33 + n;
        v4u o; o.x = pk2(s[0 * 33], s[1 * 33]); o.y = pk2(s[2 * 33], s[3 * 33]); o.z = pk2(s[4 * 33], s[5 * 33]); o.w = pk2(s[6 * 33], s[7 * 33]);
        *(GAS v4u*)(WT + (size_t)(dst_row0 + n) * ldk + k0 + 8 * c) = o; }
    LDS_WAIT(); asm volatile("" ::: "memory");
}

struct Ptrs {
    const float *x, *c, *w_ada, *b_ada, *w_in, *conv_w, *conv_b, *w_ga, *b_ga, *w_gx, *b_gx, *lam, *rel_bias, *g_l, *g_a, *w_out, *ln1_g, *ln1_b, *w_rg, *b_rg, *w_re, *b_re, *w1, *w3, *w2, *ln2_g, *ln2_b;
    float* out; unsigned char* ws;
};
__device__ __forceinline__ void p0_prologue(Frame& F, const Ptrs& P) {
    float* mod = (float*)(P.ws + WS_MOD);
    if (blockIdx.x < (NMOD * D) / 32) {
        LAS float* sc = (LAS float*)(F.lds + RING_OFF);
        LAS float* part = (LAS float*)(F.lds + RING_OFF + 16384);
        for (int i = F.tid; i < NB * D; i += NTHR) sc[i] = fsilu(P.c[i]);
        __syncthreads();
        const int n0 = 32 * blockIdx.x, col = F.tid & 31, ks = F.tid >> 5, k0 = ks * 64;
        float a0 = 0.f, a1 = 0.f, a2 = 0.f, a3 = 0.f;
#pragma unroll 16
        for (int kk = 0; kk < 64; ++kk) { const float w = P.w_ada[(size_t)(k0 + kk) * (NMOD * D) + n0 + col];
            a0 += sc[k0 + kk] * w; a1 += sc[D + k0 + kk] * w; a2 += sc[2 * D + k0 + kk] * w; a3 += sc[3 * D + k0 + kk] * w; }
        part[(ks * 32 + col) * 4 + 0] = a0; part[(ks * 32 + col) * 4 + 1] = a1; part[(ks * 32 + col) * 4 + 2] = a2; part[(ks * 32 + col) * 4 + 3] = a3;
        __syncthreads();
        if (F.tid < 128) { const int cc = F.tid & 31, b = F.tid >> 5; float s = 0.f;
#pragma unroll
            for (int k = 0; k < 16; ++k) s += part[(k * 32 + cc) * 4 + b];
            mod[b * NMOD * D + n0 + cc] = s + P.b_ada[n0 + cc]; }
        __syncthreads();
    }
    LAS float* scr = (LAS float*)(F.lds + RING_OFF + F.wave * 16384);
    const int gw = F.vcu * NWAVES + F.wave, NGW = F.G * NWAVES;
    constexpr int I_IN = 16 * 80, I_OUT = 16 * 32, I_W1 = NE * 16 * 8, I_W2 = NE * 4 * 32, NITEMS = I_IN + I_OUT + 2 * I_W1 + I_W2;
    bf16* WinT = (bf16*)(P.ws + WS_WIN); bf16* WoT = (bf16*)(P.ws + WS_WO); bf16* W13T = (bf16*)(P.ws + WS_W13); bf16* W2T = (bf16*)(P.ws + WS_W2);
    for (int it = gw; it < NITEMS; it += NGW) {
        int r = it;
        if (r < I_IN) { const int kb = r / 80, nb = r % 80; p0_transpose_item(P.w_in, NPROJ, 64 * kb, 32 * nb, WinT, D, 32 * nb, nullptr, scr, F.lane); continue; } r -= I_IN;
        if (r < I_OUT) { const int kb = r / 32, nb = r % 32; p0_transpose_item(P.w_out, D, 64 * kb, 32 * nb, WoT, D, 32 * nb, (64 * kb < DL) ? P.g_l : (P.g_a - DL), scr, F.lane); continue; } r -= I_OUT;
        if (r < I_W1) { const int e = r / 128, q = r % 128, kb = q / 8, n0 = 32 * (q % 8);
            p0_transpose_item(P.w1 + (size_t)e * D * DE, DE, 64 * kb, n0, W13T + (size_t)e * 512 * D, D, (n0 / 128) * 256 + (n0 % 128), nullptr, scr, F.lane); continue; } r -= I_W1;
        if (r < I_W1) { const int e = r / 128, q = r % 128, kb = q / 8, n0 = 32 * (q % 8);
            p0_transpose_item(P.w3 + (size_t)e * D * DE, DE, 64 * kb, n0, W13T + (size_t)e * 512 * D, D, (n0 / 128) * 256 + 128 + (n0 % 128), nullptr, scr, F.lane); continue; } r -= I_W1;
        { const int e = r / 128, q = r % 128, kb = q / 32, n0 = 32 * (q % 32);
            p0_transpose_item(P.w2 + (size_t)e * DE * D, D, 64 * kb, n0, W2T + (size_t)e * D * DE, DE, n0, nullptr, scr, F.lane); }
    }
    { float* WR = (float*)(P.ws + WS_WR);
      for (int f = F.vcu * NTHR + F.tid; f < D * 48; f += F.G * NTHR) { const int k = f / 48, col = f % 48; WR[f] = col < NG ? P.w_rg[k * NG + col] : (col < NG + NE ? P.w_re[k * NE + col - NG] : 0.f); } }
    { bf16* GW = (bf16*)(P.ws + WS_GW);
      for (int f = F.vcu * NTHR + F.tid; f < 8 * 2 * 2 * 4 * 64; f += F.G * NTHR) {
          const int ln = f & 63, s = (f >> 6) & 3, T = (f >> 8) & 1, g = (f >> 9) & 1, n = f >> 10;
          const int rho = ln & 31, h = ln >> 5, hi = (rho >> 2) & 1, reg = (rho & 3) + 4 * (rho >> 3), chan = 16 * (2 * T + (reg >> 3)) + 8 * hi + (reg & 7);
          const float* W = (g ? P.w_gx : P.w_ga) + (size_t)n * 64 * 64 + chan; const int i0 = 16 * s + 8 * h;
          v4u o; o.x = pk2(W[(i0 + 0) * 64], W[(i0 + 1) * 64]); o.y = pk2(W[(i0 + 2) * 64], W[(i0 + 3) * 64]); o.z = pk2(W[(i0 + 4) * 64], W[(i0 + 5) * 64]); o.w = pk2(W[(i0 + 6) * 64], W[(i0 + 7) * 64]);
          *(GAS v4u*)(GW + (size_t)f * 8) = o; } }
}
__device__ __forceinline__ void p1_modulate(Frame& F, const Ptrs& P) {
    const int gw = F.vcu * NWAVES + F.wave, NGW = F.G * NWAVES;
    const float* mod = (const float*)(P.ws + WS_MOD); bf16* U = (bf16*)(P.ws + WS_U);
    for (int m = gw; m < M; m += NGW) {
        const GAS f32x4* xr = (const GAS f32x4*)(P.x + (size_t)m * D) + F.lane;
        f32x4 v[4]; float s = 0.f;
#pragma unroll
        for (int j = 0; j < 4; ++j) { v[j] = xr[64 * j]; s += (v[j].x + v[j].y) + (v[j].z + v[j].w); }
        const float mean = wave_sum(s) * (1.f / D); float s2 = 0.f;
#pragma unroll
        for (int j = 0; j < 4; ++j) { v[j] = v[j] - mean; s2 += (v[j].x * v[j].x + v[j].y * v[j].y) + (v[j].z * v[j].z + v[j].w * v[j].w); }
        const float rstd = 1.f / sqrtf(wave_sum(s2) * (1.f / D) + LN_EPS);
        const f32x4* sh = (const f32x4*)(mod + (size_t)(m / S) * NMOD * D) + F.lane; const f32x4* sc = sh + D / 4;
        GAS unsigned long long* o8 = (GAS unsigned long long*)(U + (size_t)m * D) + F.lane;
#pragma unroll
        for (int j = 0; j < 4; ++j) { const f32x4 a = v[j] * rstd * (sc[64 * j] + 1.f) + sh[64 * j];
            o8[64 * j] = (unsigned long long)pk2(a.x, a.y) | ((unsigned long long)pk2(a.z, a.w) << 32); }
    }
}
__device__ __forceinline__ void lru_unit(Frame& F, const Ptrs& P, int b, int c, int n) {
    typedef float f32x16 __attribute__((ext_vector_type(16)));
    LAS float* cst = (LAS float*)(F.lds + RING_OFF);
    LAS float* tot = cst + 192;
    LAS float* pre = tot + 1024;
    const bf16* XL = (const bf16*)(P.ws + WS_XL); const bf16* GW = (const bf16*)(P.ws + WS_GW);
    bf16* HL = (bf16*)(P.ws + WS_HL); bf16* CA = (bf16*)(P.ws + WS_CA); float* SUMM = (float*)(P.ws + WS_SUMM);
    const int r = F.lane & 31, hi = F.lane >> 5, w = F.wave;
    if (F.tid < 64) { const int ch = 64 * n + F.tid; cst[F.tid] = P.b_ga[ch]; cst[64 + F.tid] = P.b_gx[ch]; cst[128 + F.tid] = 8.0f * log1pf(__expf(-P.lam[ch])); }
    const int srow = c * BLK + 32 * w + r; const size_t grow = (size_t)b * S + srow;
    float xc[4][8]; bf16x8 bfr[4];
#pragma unroll
    for (int s = 0; s < 4; ++s) { const int cb = 64 * n + 16 * s + 8 * hi;
        { const f32x4 b0 = *(const f32x4*)(P.conv_b + cb), b1 = *(const f32x4*)(P.conv_b + cb + 4);
          xc[s][0] = b0[0]; xc[s][1] = b0[1]; xc[s][2] = b0[2]; xc[s][3] = b0[3]; xc[s][4] = b1[0]; xc[s][5] = b1[1]; xc[s][6] = b1[2]; xc[s][7] = b1[3]; }
#pragma unroll
        for (int k = 0; k < 4; ++k) { v4u xv = (v4u){0u, 0u, 0u, 0u}; if (srow - 3 + k >= 0) xv = *(const GAS v4u*)(XL + (grow - 3 + k) * DL + cb);
            const f32x4 w0 = *(const f32x4*)(P.conv_w + k * DL + cb), w1 = *(const f32x4*)(P.conv_w + k * DL + cb + 4);
            xc[s][0] += w0[0] * bflo(xv[0]); xc[s][1] += w0[1] * bfhi(xv[0]); xc[s][2] += w0[2] * bflo(xv[1]); xc[s][3] += w0[3] * bfhi(xv[1]);
            xc[s][4] += w1[0] * bflo(xv[2]); xc[s][5] += w1[1] * bfhi(xv[2]); xc[s][6] += w1[2] * bflo(xv[3]); xc[s][7] += w1[3] * bfhi(xv[3]); }
        v4u pk; pk.x = pk2(xc[s][0], xc[s][1]); pk.y = pk2(xc[s][2], xc[s][3]); pk.z = pk2(xc[s][4], xc[s][5]); pk.w = pk2(xc[s][6], xc[s][7]);
        bfr[s] = __builtin_bit_cast(bf16x8, pk); }
    f32x16 acc[2][2];
#pragma unroll
    for (int g = 0; g < 2; ++g)
#pragma unroll
        for (int T = 0; T < 2; ++T) { acc[g][T] = (f32x16){0.f, 0.f, 0.f, 0.f, 0.f, 0.f, 0.f, 0.f, 0.f, 0.f, 0.f, 0.f, 0.f, 0.f, 0.f, 0.f};
#pragma unroll
            for (int s = 0; s < 4; ++s) { const bf16x8 af = __builtin_bit_cast(bf16x8, *(const GAS v4u*)(GW + ((size_t)((((n * 2 + g) * 2 + T) * 4 + s) * 64 + F.lane)) * 8));
                acc[g][T] = __builtin_amdgcn_mfma_f32_32x32x16_bf16(af, bfr[s], acc[g][T], 0, 0, 0); } }
    __syncthreads();
#pragma unroll
    for (int T = 0; T < 2; ++T)
#pragma unroll
        for (int rg = 0; rg < 16; ++rg) { const int sp_ = 2 * T + (rg >> 3), jj = rg & 7, chl = 16 * sp_ + 8 * hi + jj;
            const float ra = acc[0][T][rg] + cst[chl], rx = acc[1][T][rg] + cst[64 + chl];
            const float rr = 1.f / (1.f + __expf(-ra)), ig = 1.f / (1.f + __expf(-rx));
            const float a = __expf(-rr * cst[128 + chl]), mult = sqrtf(fmaxf(1.f - a * a, 0.f));
            acc[0][T][rg] = a; acc[1][T][rg] = mult * ig * xc[sp_][jj]; }
#pragma unroll
    for (int d = 1; d < 32; d <<= 1) {
#pragma unroll
        for (int T = 0; T < 2; ++T)
#pragma unroll
            for (int rg = 0; rg < 16; ++rg) { const float ap = __shfl_up(acc[0][T][rg], d, 32), hp = __shfl_up(acc[1][T][rg], d, 32);
                if (r >= d) { acc[1][T][rg] = acc[0][T][rg] * hp + acc[1][T][rg]; acc[0][T][rg] = acc[0][T][rg] * ap; } } }
    if (r == 31) {
#pragma unroll
        for (int T = 0; T < 2; ++T)
#pragma unroll
            for (int rg = 0; rg < 16; ++rg) { const int chl = 16 * (2 * T + (rg >> 3)) + 8 * hi + (rg & 7); tot[(w * 64 + chl) * 2] = acc[0][T][rg]; tot[(w * 64 + chl) * 2 + 1] = acc[1][T][rg]; } }
    __syncthreads();
    if (F.tid < 64) { float cin = 1.f, hin = 0.f;
#pragma unroll
        for (int ww = 0; ww < 8; ++ww) { pre[(ww * 64 + F.tid) * 2] = cin; pre[(ww * 64 + F.tid) * 2 + 1] = hin; const float pa = tot[(ww * 64 + F.tid) * 2], hh = tot[(ww * 64 + F.tid) * 2 + 1]; hin = pa * hin + hh; cin *= pa; }
        float* sp = SUMM + ((size_t)(b * NBLK + c) * DL + 64 * n + F.tid) * 2; sp[0] = cin; sp[1] = hin; }
    __syncthreads();
#pragma unroll
    for (int s = 0; s < 4; ++s) { const int T = s >> 1; float hl[8], ca[8];
#pragma unroll
        for (int jj = 0; jj < 8; ++jj) { const int rg = 8 * (s & 1) + jj, chl = 16 * s + 8 * hi + jj; const float cin = pre[(w * 64 + chl) * 2], hin = pre[(w * 64 + chl) * 2 + 1];
            hl[jj] = acc[1][T][rg] + acc[0][T][rg] * hin; ca[jj] = acc[0][T][rg] * cin; }
        v4u oh, oc; oh.x = pk2(hl[0], hl[1]); oh.y = pk2(hl[2], hl[3]); oh.z = pk2(hl[4], hl[5]); oh.w = pk2(hl[6], hl[7]);
        oc.x = pk2(ca[0], ca[1]); oc.y = pk2(ca[2], ca[3]); oc.z = pk2(ca[4], ca[5]); oc.w = pk2(ca[6], ca[7]);
        *(GAS v4u*)(HL + grow * DL + 64 * n + 16 * s + 8 * hi) = oh; *(GAS v4u*)(CA + grow * DL + 64 * n + 16 * s + 8 * hi) = oc; }
    __syncthreads();
}
__device__ __forceinline__ void p3_lru(Frame& F, const Ptrs& P) {
    for (int u = F.vcu; u < NB * NBLK * 8; u += F.G) lru_unit(F, P, u >> 7, (u >> 3) & 15, u & 7);
}
__device__ __forceinline__ void p4_merge(Frame& F, const Ptrs& P) {
    const bf16* HL = (const bf16*)(P.ws + WS_HL); const bf16* CA = (const bf16*)(P.ws + WS_CA); const bf16* YL = (const bf16*)(P.ws + WS_YL); const bf16* AO = (const bf16*)(P.ws + WS_AO);
    const float* SUMM = (const float*)(P.ws + WS_SUMM); bf16* MG = (bf16*)(P.ws + WS_U);
    LAS float* hin = (LAS float*)(F.lds + RING_OFF);
    for (int u = F.vcu; u < M / 64; u += F.G) {
        const int r0 = 64 * u, b = r0 / S, ck = (r0 % S) / BLK;
        { float h = 0.f; const float* sp = SUMM + ((size_t)b * NBLK * DL + F.tid) * 2;
            for (int c = 0; c < ck; ++c) { const float pa = sp[(size_t)c * DL * 2], hh = sp[(size_t)c * DL * 2 + 1]; h = pa * h + hh; }
            hin[F.tid] = h; }
        __syncthreads();
        float hn[8]; { const f32x4 hi0 = *(const LAS f32x4*)(hin + 8 * F.lane), hi1 = *(const LAS f32x4*)(hin + 8 * F.lane + 4);
            hn[0] = hi0[0]; hn[1] = hi0[1]; hn[2] = hi0[2]; hn[3] = hi0[3]; hn[4] = hi1[0]; hn[5] = hi1[1]; hn[6] = hi1[2]; hn[7] = hi1[3]; }
        for (int rr = 0; rr < 8; ++rr) { const size_t row = (size_t)r0 + F.wave * 8 + rr;
            const v4u hl = *(const GAS v4u*)(HL + row * DL + 8 * F.lane), ca = *(const GAS v4u*)(CA + row * DL + 8 * F.lane), yl = *(const GAS v4u*)(YL + row * DL + 8 * F.lane), ao = *(const GAS v4u*)(AO + row * DA + 8 * F.lane);
            float l[8], a[8]; float sl = 0.f, sa = 0.f;
#pragma unroll
            for (int i = 0; i < 4; ++i) { const float hlo = bflo(hl[i]) + bflo(ca[i]) * hn[2 * i], hhi = bfhi(hl[i]) + bfhi(ca[i]) * hn[2 * i + 1];
                l[2 * i] = hlo * fgelu_tanh(bflo(yl[i])); l[2 * i + 1] = hhi * fgelu_tanh(bfhi(yl[i])); a[2 * i] = bflo(ao[i]); a[2 * i + 1] = bfhi(ao[i]);
                sl += l[2 * i] * l[2 * i] + l[2 * i + 1] * l[2 * i + 1]; sa += a[2 * i] * a[2 * i] + a[2 * i + 1] * a[2 * i + 1]; }
            const float rl = 1.f / sqrtf(wave_sum(sl) * (1.f / DL) + LN_EPS), ra = 1.f / sqrtf(wave_sum(sa) * (1.f / DA) + LN_EPS);
            v4u ol, oa;
#pragma unroll
            for (int i = 0; i < 4; ++i) { ol[i] = pk2(l[2 * i] * rl, l[2 * i + 1] * rl); oa[i] = pk2(a[2 * i] * ra, a[2 * i + 1] * ra); }
            *(GAS v4u*)(MG + row * D + 8 * F.lane) = ol; *(GAS v4u*)(MG + row * D + DL + 8 * F.lane) = oa; }
        __syncthreads();
    }
}
__device__ __forceinline__ void p6_post(Frame& F, const Ptrs& P, bool publish) {
    typedef float f32x4v __attribute__((ext_vector_type(4)));
    constexpr int TS = 1026;
    LAS float* T = (LAS float*)(F.lds + RING_OFF);
    LAS float* Pt = T + 16 * TS;
    LAS float* LG = Pt + 8 * 16 * 48;
    const float* mod = (const float*)(P.ws + WS_MOD); const float* MIX = (const float*)(P.ws + WS_MIX); float* X1 = (float*)(P.ws + WS_X1); bf16* U2 = (bf16*)(P.ws + WS_U);
    const float* WR = (const float*)(P.ws + WS_WR);
    int* RI = (int*)(P.ws + WS_RI); float* RW = (float*)(P.ws + WS_RW); unsigned* ecnt = (unsigned*)(P.ws + WS_ECNT); unsigned* list = (unsigned*)(P.ws + WS_LIST);
    for (int u = F.vcu; u < M / 16; u += F.G) {
#pragma unroll 1
        for (int rr = 0; rr < 2; ++rr) { const int lr = 2 * F.wave + rr, m = 16 * u + lr;
            const f32x4* md = (const f32x4*)(mod + (size_t)(m / S) * NMOD * D) + F.lane;
            const GAS f32x4* xr = (const GAS f32x4*)(P.x + (size_t)m * D) + F.lane; const GAS f32x4* mr = (const GAS f32x4*)(MIX + (size_t)m * D) + F.lane;
            f32x4 v[4]; float s = 0.f;
#pragma unroll
            for (int j = 0; j < 4; ++j) { v[j] = xr[64 * j] * ALPHA + md[2 * (D / 4) + 64 * j] * mr[64 * j]; s += (v[j].x + v[j].y) + (v[j].z + v[j].w); }
            float mean = wave_sum(s) * (1.f / D), s2 = 0.f;
#pragma unroll
            for (int j = 0; j < 4; ++j) { v[j] = v[j] - mean; s2 += (v[j].x * v[j].x + v[j].y * v[j].y) + (v[j].z * v[j].z + v[j].w * v[j].w); }
            float rstd = 1.f / sqrtf(wave_sum(s2) * (1.f / D) + LN_EPS); s = 0.f;
            GAS f32x4* x1r = (GAS f32x4*)(X1 + (size_t)m * D) + F.lane;
#pragma unroll
            for (int j = 0; j < 4; ++j) { v[j] = v[j] * rstd * ((const f32x4*)P.ln1_g)[F.lane + 64 * j] + ((const f32x4*)P.ln1_b)[F.lane + 64 * j]; x1r[64 * j] = v[j]; s += (v[j].x + v[j].y) + (v[j].z + v[j].w); }
            mean = wave_sum(s) * (1.f / D); s2 = 0.f;
#pragma unroll
            for (int j = 0; j < 4; ++j) { v[j] = v[j] - mean; s2 += (v[j].x * v[j].x + v[j].y * v[j].y) + (v[j].z * v[j].z + v[j].w * v[j].w); }
            rstd = 1.f / sqrtf(wave_sum(s2) * (1.f / D) + LN_EPS);
            GAS unsigned long long* o8 = (GAS unsigned long long*)(U2 + (size_t)m * D) + F.lane;
#pragma unroll
            for (int j = 0; j < 4; ++j) { v[j] = v[j] * rstd * (md[4 * (D / 4) + 64 * j] + 1.f) + md[3 * (D / 4) + 64 * j];
                o8[64 * j] = (unsigned long long)pk2(v[j].x, v[j].y) | ((unsigned long long)pk2(v[j].z, v[j].w) << 32);
                LAS float* tp = T + lr * TS + 4 * F.lane + 256 * j; tp[0] = v[j].x; tp[1] = v[j].y; tp[2] = v[j].z; tp[3] = v[j].w; } }
        __syncthreads();
        { f32x4v acc[3]; acc[0] = (f32x4v){0.f, 0.f, 0.f, 0.f}; acc[1] = acc[0]; acc[2] = acc[0];
            const int ar = F.lane & 15, ak = F.lane >> 4; const LAS float* ta = T + ar * TS + 128 * F.wave + ak; const float* wb = WR + (size_t)(128 * F.wave + ak) * 48 + ar;
#pragma unroll 8
            for (int ks = 0; ks < 32; ++ks) { const float a = ta[4 * ks];
#pragma unroll
                for (int ct = 0; ct < 3; ++ct) acc[ct] = __builtin_amdgcn_mfma_f32_16x16x4f32(a, wb[(size_t)ks * 4 * 48 + 16 * ct], acc[ct], 0, 0, 0); }
#pragma unroll
            for (int ct = 0; ct < 3; ++ct)
#pragma unroll
                for (int rg = 0; rg < 4; ++rg) Pt[(F.wave * 16 + ak * 4 + rg) * 48 + 16 * ct + ar] = acc[ct][rg]; }
        __syncthreads();
        for (int o = F.tid; o < 16 * 36; o += NTHR) { const int row = o / 36, col = o % 36; float sm = 0.f;
#pragma unroll
            for (int w = 0; w < 8; ++w) sm += Pt[(w * 16 + row) * 48 + col];
            LG[row * 36 + col] = sm + (col < NG ? P.b_rg[col] : P.b_re[col - NG]); }
        __syncthreads();
        if (F.tid < 16) { const int m = 16 * u + F.tid; const LAS float* lg = LG + F.tid * 36;
            int gi = 0; float gmax = lg[0];
#pragma unroll
            for (int g = 1; g < NG; ++g) if (lg[g] > gmax) { gi = g; gmax = lg[g]; }
            float gs = 0.f;
#pragma unroll
            for (int g = 0; g < NG; ++g) gs += __expf(lg[g] - gmax);
            const float gtop = 1.f / gs; const LAS float* ev = lg + NG + gi * EPG;
            int e0 = 0; float v0 = ev[0];
#pragma unroll
            for (int e = 1; e < EPG; ++e) { const float t = ev[e]; if (t > v0) { e0 = e; v0 = t; } }
            int e1 = -1; float v1 = 0.f;
#pragma unroll
            for (int e = 0; e < EPG; ++e) { const float t = ev[e]; if (e != e0 && (e1 < 0 || t > v1)) { e1 = e; v1 = t; } }
            const float p1 = __expf(v1 - v0), w0 = 1.f / (1.f + p1), w1 = p1 / (1.f + p1);
            const int ge0 = gi * EPG + e0, ge1 = gi * EPG + e1;
            RI[m * 2 + 0] = ge0; RI[m * 2 + 1] = ge1; RW[m * 2 + 0] = gtop * w0; RW[m * 2 + 1] = gtop * w1;
            if (publish) { const unsigned p0 = atomicAdd(ecnt + 64 * ge0, 1u), p1i = atomicAdd(ecnt + 64 * ge1, 1u);
                list[(size_t)ge0 * M + p0] = (unsigned)m * 2u; list[(size_t)ge1 * M + p1i] = (unsigned)m * 2u + 1u; } }
        __syncthreads();
    }
}
__device__ __forceinline__ void moe_setup(Frame& F, const Ptrs& P, int nct) {
    LAS unsigned* toff = (LAS unsigned*)(F.lds + MOEOFF_OFF); LAS unsigned* cnts = toff + 40; LAS unsigned* toktab = (LAS unsigned*)(F.lds + TOKTAB_OFF);
    const unsigned* ecnt = (const unsigned*)(P.ws + WS_ECNT); const unsigned* list = (const unsigned*)(P.ws + WS_LIST);
    if (F.tid < NE) cnts[F.tid] = ecnt[64 * F.tid];
    __syncthreads();
    if (F.tid == 0) { unsigned a = 0; for (int e = 0; e < NE; ++e) { toff[e] = a; a += (cnts[e] + 255u) >> 8; } toff[NE] = a; }
    __syncthreads();
    const int total = (int)toff[NE] * nct;
    for (int i = 0; i < TOKTAB_UNITS; ++i) { const int L = i * F.G + F.vcu; if (L >= total) break;
        const int rt = L / nct; int e = 0; while ((int)toff[e + 1] <= rt) ++e;
        if (F.tid < 256) { const unsigned pos = 256u * (unsigned)(rt - (int)toff[e]) + (unsigned)F.tid; toktab[i * 256 + F.tid] = pos < cnts[e] ? list[(size_t)e * M + pos] : pg8::TOK_NONE; } }
    __syncthreads();
}
__device__ __forceinline__ void p9_final(Frame& F, const Ptrs& P) {
    const int gw = F.vcu * NWAVES + F.wave, NGW = F.G * NWAVES;
    const float* mod = (const float*)(P.ws + WS_MOD); const float* X1 = (const float*)(P.ws + WS_X1); const bf16* YS = (const bf16*)(P.ws + WS_YS);
    for (int m = gw; m < M; m += NGW) {
        const f32x4* md = (const f32x4*)(mod + (size_t)(m / S) * NMOD * D) + F.lane;
        const GAS f32x4* xr = (const GAS f32x4*)(X1 + (size_t)m * D) + F.lane;
        const GAS unsigned long long* y0 = (const GAS unsigned long long*)(YS + (size_t)m * 2 * D) + F.lane; const GAS unsigned long long* y1 = y0 + D / 4;
        f32x4 v[4]; float s = 0.f;
#pragma unroll
        for (int j = 0; j < 4; ++j) { const unsigned long long a = y0[64 * j], b = y1[64 * j];
            const f32x4 f = (f32x4){bflo((unsigned)a) + bflo((unsigned)b), bfhi((unsigned)a) + bfhi((unsigned)b), bflo((unsigned)(a >> 32)) + bflo((unsigned)(b >> 32)), bfhi((unsigned)(a >> 32)) + bfhi((unsigned)(b >> 32))};
            v[j] = xr[64 * j] * ALPHA + md[5 * (D / 4) + 64 * j] * f; s += (v[j].x + v[j].y) + (v[j].z + v[j].w); }
        const float mean = wave_sum(s) * (1.f / D); float s2 = 0.f;
#pragma unroll
        for (int j = 0; j < 4; ++j) { v[j] = v[j] - mean; s2 += (v[j].x * v[j].x + v[j].y * v[j].y) + (v[j].z * v[j].z + v[j].w * v[j].w); }
        const float rstd = 1.f / sqrtf(wave_sum(s2) * (1.f / D) + LN_EPS);
        GAS f32x4* orow = (GAS f32x4*)(P.out + (size_t)m * D) + F.lane;
#pragma unroll
        for (int j = 0; j < 4; ++j) orow[64 * j] = v[j] * rstd * ((const f32x4*)P.ln2_g)[F.lane + 64 * j] + ((const f32x4*)P.ln2_b)[F.lane + 64 * j];
    }
}

constexpr int N_PHASES = 10;
#ifndef PROBE_MASK
#define PROBE_MASK 0
#endif
#define NREP(k) (((PROBE_MASK) >> (k)) & 1 ? 2 : 1)
struct Args { Ptrs p; int ph_lo, ph_hi, li, pad; };
__global__ void __launch_bounds__(NTHR, 2) mk_fwd(Args args) {
    extern __shared__ __attribute__((aligned(16))) unsigned char lds[];
    Frame F;
    F.lds = (LAS unsigned char*)lds;
    F.MISC = (volatile LAS unsigned*)(F.lds + MISC_OFF);
    F.tid = threadIdx.x; F.lane = F.tid & 63; F.wave = __builtin_amdgcn_readfirstlane(F.tid >> 6);
    F.G = gridDim.x; { const int bx = blockIdx.x; F.vcu = (F.G % 8 == 0) ? (bx % 8) * (F.G / 8) + bx / 8 : bx; }
    const Ptrs& P = args.p;
    F.ctl = (gu32*)(P.ws + WS_CTL);
    for (int u = F.tid; u < (LDS_BYTES - LDSCTL_OFF) / 4; u += NTHR) ((LAS unsigned*)(F.lds + LDSCTL_OFF))[u] = 0u;
    __syncthreads();
    const int lo = args.ph_lo, hi = args.ph_hi;
    XcdBarrier bar; bar.bar = (unsigned*)(F.ctl + CW_BAR) + args.li * XCD_BAR_WORDS; bar.x = 0; bar.st = nullptr;
    if (hi - lo > 1) bar = xcd_barrier_post((unsigned*)(F.ctl + CW_BAR) + args.li * XCD_BAR_WORDS, F.MISC + 8);
#define IN(k) (lo <= (k) && (k) < hi)
#define BOTH(k) (IN(k) && IN((k) + 1))
#define SEAM(k) do { if (BOTH(k)) xcd_barrier(bar); } while (0)
    if (IN(0)) { for (int rep = 0; rep < NREP(0); ++rep) { p0_prologue(F, P); __syncthreads(); } SEAM(0); }
    if (IN(1)) { for (int rep = 0; rep < NREP(1); ++rep) p1_modulate(F, P); SEAM(1); }
    if (IN(2)) { for (int rep = 0; rep < NREP(2); ++rep) {
        pg8::Gemm g{(const pg8::bf16_t*)(P.ws + WS_U), (const pg8::bf16_t*)(P.ws + WS_WIN), M, NPROJ, D}; pg8::StaticOrder So; So.init(M, NPROJ, F.G, (int)blockIdx.x);
        pg8::EpiProj E{(pg8::bf16_t*)(P.ws + WS_XL), (size_t)(WS_YL - WS_XL) / 2, (float*)(P.ws + WS_KMSUM), QSCALE};
        pg8::gemm_phase<pg8::EpiProj, pg8::StaticOrder, PG8_ALIGN, PG8_SP2>(F.lds + RING_OFF, g, So, E); }
        SEAM(2);
    }
    if (IN(3)) { for (int rep = 0; rep < NREP(3); ++rep) {
        p3_lru(F, P);
        static_assert(attn_body::LDS_BYTES <= RING_BYTES && attn_body::DM == DA, "attention body geometry vs frame");
        const attn_body::AttnTensors AT{(const attn_body::bf16*)(P.ws + WS_Q), (const attn_body::bf16*)(P.ws + WS_K), (const attn_body::bf16*)(P.ws + WS_V), (attn_body::bf16*)(P.ws + WS_AO),
                                        (const float*)(P.ws + WS_KMSUM), P.rel_bias, T5_BUCKET};
        const attn_body::StaticOrder So((int)F.G, F.vcu);
        attn_body::attn_phase<attn_body::StaticOrder>((char*)lds + RING_OFF, AT, So); }
        SEAM(3);
    }
    if (IN(4)) { for (int rep = 0; rep < NREP(4); ++rep) p4_merge(F, P); SEAM(4); }
    if (IN(5)) { for (int rep = 0; rep < NREP(5); ++rep) {
        pg8::Gemm g{(const pg8::bf16_t*)(P.ws + WS_U), (const pg8::bf16_t*)(P.ws + WS_WO), M, D, D}; pg8::StaticOrder So; So.init(M, D, F.G, (int)blockIdx.x);
        pg8::EpiF32 E{(float*)(P.ws + WS_MIX), D};
        pg8::gemm_phase<pg8::EpiF32, pg8::StaticOrder, PG8_ALIGN, PG8_SP2>(F.lds + RING_OFF, g, So, E); }
        SEAM(5);
    }
    if (IN(6)) { for (int rep = 0; rep < NREP(6); ++rep) p6_post(F, P, rep == 0); SEAM(6); }
    if (IN(7)) { for (int rep = 0; rep < NREP(7); ++rep) {
        moe_setup(F, P, 2);
        const LAS unsigned* toktab = (const LAS unsigned*)(F.lds + TOKTAB_OFF);
        pg8::Gemm g{(const pg8::bf16_t*)(P.ws + WS_U), (const pg8::bf16_t*)(P.ws + WS_W13), 0, 0, D}; const pg8::MoeOrder So{(const LAS unsigned*)(F.lds + MOEOFF_OFF), 2, F.G, F.vcu};
        pg8::EpiMoeUp E{(pg8::bf16_t*)(P.ws + WS_HDN), (const float*)(P.ws + WS_RW), toktab};
        pg8::gemm_phase_g<pg8::EpiMoeUp, pg8::MoeOrder, true>(F.lds + RING_OFF, g, So, E, toktab); }
        SEAM(7);
    }
    if (IN(8)) { for (int rep = 0; rep < NREP(8); ++rep) {
        moe_setup(F, P, 4);
        const LAS unsigned* toktab = (const LAS unsigned*)(F.lds + TOKTAB_OFF);
        pg8::Gemm g{(const pg8::bf16_t*)(P.ws + WS_HDN), (const pg8::bf16_t*)(P.ws + WS_W2), 0, 0, DE}; const pg8::MoeOrder So{(const LAS unsigned*)(F.lds + MOEOFF_OFF), 4, F.G, F.vcu};
        pg8::EpiMoeDown E{(pg8::bf16_t*)(P.ws + WS_YS), (pg8::bf16_t*)(P.ws + WS_DUMP), toktab};
        pg8::gemm_phase_g<pg8::EpiMoeDown, pg8::MoeOrder, false>(F.lds + RING_OFF, g, So, E, toktab); }
        SEAM(8);
    }
    if (IN(9)) { for (int rep = 0; rep < NREP(9); ++rep) p9_final(F, P); }
#undef IN
#undef BOTH
#undef SEAM
}

extern "C" void kernel_launch(void* const* d_in, const int* in_sizes, int n_in, void* d_out, int out_size, void* d_ws, size_t ws_size, hipStream_t stream) {
    static int grid = 0;
    if (grid == 0) {
        if (n_in != 27 || in_sizes[0] != M * D || out_size != M * D || ws_size < WS_END) { fprintf(stderr, "kernel_launch: unexpected shapes / workspace (n_in %d, ws %zu)\n", n_in, ws_size); grid = -1; return; }
        int dev = 0, cus = 0, per_cu = 0;
        if (hipGetDevice(&dev) != hipSuccess || hipDeviceGetAttribute(&cus, hipDeviceAttributeMultiprocessorCount, dev) != hipSuccess) { grid = -1; return; }
        if (hipFuncSetAttribute((const void*)mk_fwd, hipFuncAttributeMaxDynamicSharedMemorySize, LDS_BYTES) != hipSuccess) { fprintf(stderr, "kernel_launch: hipFuncSetAttribute failed\n"); grid = -1; return; }
        if (hipOccupancyMaxActiveBlocksPerMultiprocessor(&per_cu, (const void*)mk_fwd, NTHR, LDS_BYTES) != hipSuccess || per_cu < 1) fprintf(stderr, "kernel_launch: occupancy query reports %d\n", per_cu);
        (void)hipGetLastError();
        grid = cus;
    }
    if (grid < 0) return;
    unsigned char* ws = (unsigned char*)d_ws;
    (void)hipMemsetAsync(ws + WS_CTL, 0, CTL_ZERO_BYTES, stream);
    Args a{};
    const float** pp = (const float**)&a.p;
    for (int i = 0; i < 27; ++i) pp[i] = (const float*)d_in[i];
    a.p.out = (float*)d_out; a.p.ws = ws;
    auto run = [&](int lo, int hi, int li) { a.ph_lo = lo; a.ph_hi = hi; a.li = li; hipLaunchKernelGGL(mk_fwd, dim3(grid), dim3(NTHR), LDS_BYTES, stream, a); };
    run(0, N_PHASES, 0);
}
```

```cpp
#include <hip/hip_runtime.h>
#include <cstdio>
#include <cstdint>

namespace pg8 {
#define PG8_LAS __attribute__((address_space(3)))
typedef unsigned short bf16_t;
typedef short bf16x8 __attribute__((ext_vector_type(8)));
typedef float f32x4 __attribute__((ext_vector_type(4)));
typedef unsigned u32x4 __attribute__((ext_vector_type(4)));
constexpr int BM = 256, BK = 64, HALF = 128, HTB = HALF * BK * 2  , STAGE_BYTES = 8 * HTB, NXCD = 8, WGM = 8;

__host__ __device__ __forceinline__ int lds_byte(int r, int c) { const int st = (r >> 4) * 2 + (c >> 5), rr = r & 15, cc = c & 31, ob = rr * 64 + cc * 2; return st * 1024 + (ob ^ (((ob >> 9) & 1) << 5)); }
__host__ __device__ __forceinline__ void stage_rc(int b, int& R, int& C) { const int st = b / 1024, sb = b % 1024, swz = sb ^ (((sb >> 9) & 1) << 5); R = (st >> 1) * 16 + swz / 64; C = (st & 1) * 32 + (swz % 64) / 2; }
__host__ __device__ __forceinline__ int perm32(int rho) { const int n = rho >> 4, i = rho & 15; return 8 * (i >> 2) + 4 * n + (i & 3); }

struct Unit { int pm, pn; };
struct Gemm { const bf16_t* A; const bf16_t* Bt; int M, N, K; };

struct StaticOrder {
    int nM, nN, nwg, G, c;
    __host__ __device__ void init(int M, int N, int G_, int c_) { nM = M / BM; nN = N / BM; nwg = nM * nN; G = G_; c = c_; }
    __host__ __device__ bool next(int i, Unit& u) const {
        const long L = (long)i * G + c; if (L >= nwg) return false;
        int wgid = (int)L; { const int q = nwg / NXCD, r = nwg % NXCD, xcd = wgid % NXCD, off = wgid / NXCD; wgid = (xcd < r ? xcd * (q + 1) : r * (q + 1) + (xcd - r) * q) + off; }
        const int nig = WGM * nN, gid = wgid / nig, fm = gid * WGM, gsz = (nM - fm) < WGM ? (nM - fm) : WGM;
        u.pm = fm + ((wgid % nig) % gsz); u.pn = (wgid % nig) / gsz; return true;
    }
    __device__ __forceinline__ void a_ready(const Unit&) const {}
    __device__ __forceinline__ void done(const Unit&) const {}
};

__device__ __forceinline__ unsigned cvt_pk_bf16(float lo, float hi) { unsigned r; asm volatile("v_cvt_pk_bf16_f32 %0, %1, %2" : "=v"(r) : "v"(lo), "v"(hi)); return r; }
typedef float f32x2 __attribute__((ext_vector_type(2)));
__device__ __forceinline__ f32x2 gelu_pk(f32x2 v) {
    const f32x2 av = __builtin_elementwise_abs(v), d = av * 0.2316418882f + 1.0f;
    f32x2 t; t.x = __builtin_amdgcn_rcpf(d.x); t.y = __builtin_amdgcn_rcpf(d.y);
    f32x2 q = t * 0.5307027145f + (-0.7265760135f); q = q * t + 0.7107068705f; q = q * t + (-0.142248368f); q = q * t + 0.127414796f; q = q * t;
    const f32x2 s = (v * v) * (-0.72134752044f);
    f32x2 e; e.x = __builtin_amdgcn_exp2f(s.x); e.y = __builtin_amdgcn_exp2f(s.y);
    const f32x2 m = v * (q * e), r = v - m;
    f32x2 o; o.x = v.x < 0.f ? m.x : r.x; o.y = v.y < 0.f ? m.y : r.y; return o;
}

template <int ACT  > struct EpiBf16 {
    static constexpr bool PERM = true, AFTER_DRAIN = false; static_assert(ACT == 0 || ACT == 1, "EpiBf16: ACT is 0 (none) or 1 (gelu_pk)");
    bf16_t* O; int ldc; const float* bias; int split_cols; size_t split_stride; float scale0;
    __device__ __forceinline__ void operator()(const f32x4 (&acc)[2][2][4][2], const Unit& u, int wr, int wc, int fr, int fq) const {
        const int row0 = u.pm * BM + wr * 64 + fr; int colt = u.pn * BM; bf16_t* base = O;
        float sc = 1.f; if (split_cols) { const int t = colt / split_cols; base += (size_t)t * split_stride; colt -= t * split_cols; if (t == 0) sc = scale0; }
        const int col0 = colt + wc * 32 + 8 * fq, bcol0 = u.pn * BM + wc * 32 + 8 * fq;
        f32x4 bv[2][2];
#pragma unroll
        for (int bj = 0; bj < 2; ++bj)
#pragma unroll
            for (int n = 0; n < 2; ++n) bv[bj][n] = bias ? *(const f32x4*)(bias + bcol0 + bj * HALF + 4 * n) : (f32x4){0.f, 0.f, 0.f, 0.f};
#pragma unroll
        for (int ai = 0; ai < 2; ++ai)
#pragma unroll
            for (int m = 0; m < 4; ++m) { bf16_t* rowp = base + (size_t)(row0 + ai * HALF + m * 16) * ldc + col0;
#pragma unroll
                for (int bj = 0; bj < 2; ++bj) { f32x4 v0 = acc[ai][bj][m][0] + bv[bj][0], v1 = acc[ai][bj][m][1] + bv[bj][1];
                    if (ACT == 1) { f32x2 a = gelu_pk((f32x2){v0[0], v0[1]}), b = gelu_pk((f32x2){v0[2], v0[3]}), c = gelu_pk((f32x2){v1[0], v1[1]}), d = gelu_pk((f32x2){v1[2], v1[3]});
                        v0 = (f32x4){a.x, a.y, b.x, b.y}; v1 = (f32x4){c.x, c.y, d.x, d.y}; }
                    v0 = v0 * sc; v1 = v1 * sc; u32x4 w; w.x = cvt_pk_bf16(v0[0], v0[1]); w.y = cvt_pk_bf16(v0[2], v0[3]); w.z = cvt_pk_bf16(v1[0], v1[1]); w.w = cvt_pk_bf16(v1[2], v1[3]);
                    *(u32x4*)(rowp + bj * HALF) = w; } }
    }
};

struct PanelStats {
    unsigned* xbuf;
    unsigned* cnt;
    unsigned* tmo;
    int ntn; float eps;
    unsigned code;
    __device__ __forceinline__ bool run(const f32x4 (&v)[2][2][4][2], const Unit& u, int wr, int wc, int fr, int fq, PG8_LAS unsigned char* lds, int wid, int lane) const {
        typedef float f32x2v __attribute__((ext_vector_type(2)));
        PG8_LAS f32x2v* P = (PG8_LAS f32x2v*)lds;
        PG8_LAS f32x2v* S = (PG8_LAS f32x2v*)(lds + 8192);
        PG8_LAS unsigned* flag = (PG8_LAS unsigned*)(lds + 8192 + 2048);
#pragma unroll
        for (int ai = 0; ai < 2; ++ai)
#pragma unroll
            for (int m = 0; m < 4; ++m) {
                float s = 0.f;
#pragma unroll
                for (int bj = 0; bj < 2; ++bj)
#pragma unroll
                    for (int n = 0; n < 2; ++n) { const f32x4 x = v[ai][bj][m][n]; s += (x[0] + x[1]) + (x[2] + x[3]); }
                s += __shfl_xor(s, 16); s += __shfl_xor(s, 32);
                const float mw = s * (1.0f / 64.0f); float q = 0.f;
#pragma unroll
                for (int bj = 0; bj < 2; ++bj)
#pragma unroll
                    for (int n = 0; n < 2; ++n) { const f32x4 d = v[ai][bj][m][n] - mw; q += (d[0] * d[0] + d[1] * d[1]) + (d[2] * d[2] + d[3] * d[3]); }
                q += __shfl_xor(q, 16); q += __shfl_xor(q, 32);
                if (fq == 0) P[(ai * HALF + wr * 64 + m * 16 + fr) * 4 + wc] = (f32x2v){mw, q};
            }
        asm volatile("s_waitcnt lgkmcnt(0)" ::: "memory"); __builtin_amdgcn_s_barrier(); asm volatile("" ::: "memory");
#if defined(BROKEN_EXCHANGE_NO_WAIT)
#warning BROKEN CONTROL BUILD: the row-statistics exchange does not wait; results are wrong by design
        if (blockIdx.x >= 64) { const long long t0_ = clock64(); while (clock64() - t0_ < 60000) __builtin_amdgcn_s_sleep(8); }
#endif
        const int row = wid * 32 + (lane & 31);
        if (lane < 32) {
            const f32x2v a = P[row * 4 + 0], b = P[row * 4 + 1], c = P[row * 4 + 2], d = P[row * 4 + 3];
            const float mt = (a.x + b.x + c.x + d.x) * 0.25f;
            const float da = a.x - mt, db = b.x - mt, dc = c.x - mt, dd = d.x - mt;
            const float m2 = (a.y + b.y) + (c.y + d.y) + 64.0f * ((da * da + db * db) + (dc * dc + dd * dd));
            unsigned long long* slot = (unsigned long long*)xbuf + ((size_t)(u.pm * BM + row) * 4 + u.pn);
            __hip_atomic_store(slot, ((unsigned long long)__float_as_uint(m2) << 32) | __float_as_uint(mt), __ATOMIC_RELAXED, __HIP_MEMORY_SCOPE_AGENT);
        }
        asm volatile("s_waitcnt vmcnt(0)" ::: "memory");
        if (lane == 0) __hip_atomic_fetch_add(cnt + 64 * u.pm, 1u, __ATOMIC_RELAXED, __HIP_MEMORY_SCOPE_AGENT);
        if (wid == 0) {
            bool dead = false; const unsigned long long t0 = __builtin_amdgcn_s_memrealtime(); const unsigned want = 8u * (unsigned)ntn;
            for (;;) {
#if defined(BROKEN_EXCHANGE_NO_WAIT)
                break;
#endif
                if ((unsigned)__builtin_amdgcn_readfirstlane(__hip_atomic_load(cnt + 64 * u.pm, __ATOMIC_RELAXED, __HIP_MEMORY_SCOPE_AGENT)) >= want) break;
                if (__builtin_amdgcn_s_memrealtime() - t0 > 2000000ull) {
                    if (lane == 0) { unsigned expect = 0u; __hip_atomic_compare_exchange_strong(tmo + 1, &expect, code | (unsigned)(u.pm & 0xff), __ATOMIC_RELAXED, __ATOMIC_RELAXED, __HIP_MEMORY_SCOPE_AGENT);
                                     __hip_atomic_store(tmo, 1u, __ATOMIC_RELAXED, __HIP_MEMORY_SCOPE_AGENT); }
                    dead = true; break; }
                __builtin_amdgcn_s_sleep(2);
            }
            __builtin_amdgcn_fence(__ATOMIC_ACQUIRE, "agent");
            if (lane == 0) flag[0] = dead ? 1u : 0u;
        }
        asm volatile("s_waitcnt vmcnt(0) lgkmcnt(0)" ::: "memory"); __builtin_amdgcn_s_barrier(); asm volatile("" ::: "memory");
        const bool bad = flag[0] != 0u;
        if (lane < 32) {
            const unsigned long long* slot = (const unsigned long long*)xbuf + (size_t)(u.pm * BM + row) * 4; float mt[4], m2[4]; float ms = 0.f;
#pragma unroll
            for (int t = 0; t < 4; ++t) { if (t < ntn) { const unsigned long long w = __hip_atomic_load(slot + t, __ATOMIC_RELAXED, __HIP_MEMORY_SCOPE_AGENT); mt[t] = __uint_as_float((unsigned)w); m2[t] = __uint_as_float((unsigned)(w >> 32)); } else { mt[t] = 0.f; m2[t] = 0.f; } ms += mt[t]; }
            const float mean = ms / (float)ntn; float q = 0.f;
#pragma unroll
            for (int t = 0; t < 4; ++t) if (t < ntn) { const float dm = mt[t] - mean; q += m2[t] + 256.0f * dm * dm; }
            S[row] = (f32x2v){mean, 1.0f / sqrtf(q / (256.0f * (float)ntn) + eps)};
        }
        asm volatile("s_waitcnt lgkmcnt(0)" ::: "memory"); __builtin_amdgcn_s_barrier(); asm volatile("" ::: "memory");
        return bad;
    }
};
struct EpiLnRes {
    static constexpr bool PERM = false, AFTER_DRAIN = true;
    const float* base; float* out; int ldc; const float* bias; PanelStats st; unsigned poison;
    __device__ __forceinline__ void fused(f32x4 (&acc)[2][2][4][2], const Unit& u, int wr, int wc, int fr, int fq, PG8_LAS unsigned char* lds, int wid, int lane) const {
        typedef float f32x2v __attribute__((ext_vector_type(2)));
        const PG8_LAS f32x2v* S = (const PG8_LAS f32x2v*)(lds + 8192);
        const int col0 = u.pn * BM + wc * 32 + 4 * fq;
#pragma unroll
        for (int bj = 0; bj < 2; ++bj)
#pragma unroll
            for (int n = 0; n < 2; ++n) { const f32x4 bv = bias ? *(const f32x4*)(bias + col0 + bj * HALF + n * 16) : (f32x4){0.f, 0.f, 0.f, 0.f};
#pragma unroll
                for (int ai = 0; ai < 2; ++ai)
#pragma unroll
                    for (int m = 0; m < 4; ++m) acc[ai][bj][m][n] += bv; }
        f32x4 pre[4][2][2];
#pragma unroll
        for (int m = 0; m < 4; ++m) { const size_t off = (size_t)(u.pm * BM + wr * 64 + m * 16 + fr) * ldc + col0;
#pragma unroll
            for (int bj = 0; bj < 2; ++bj)
#pragma unroll
                for (int n = 0; n < 2; ++n) pre[m][bj][n] = *(const f32x4*)(base + off + bj * HALF + n * 16); }
        const bool bad = st.run(acc, u, wr, wc, fr, fq, lds, wid, lane) || poison != 0u;
        const float qnan = __builtin_nanf("");
#pragma unroll
        for (int ai = 0; ai < 2; ++ai)
#pragma unroll
            for (int m = 0; m < 4; ++m) { const int r = ai * HALF + wr * 64 + m * 16 + fr; const f32x2v sr = S[r]; const size_t off = (size_t)(u.pm * BM + r) * ldc + col0;
#pragma unroll
                for (int bj = 0; bj < 2; ++bj)
#pragma unroll
                    for (int n = 0; n < 2; ++n) { const f32x4 bs = ai == 0 ? pre[m][bj][n] : *(const f32x4*)(base + off + bj * HALF + n * 16); f32x4 o = bs + (acc[ai][bj][m][n] - sr.x) * sr.y;
                        if (bad) o = (f32x4){qnan, qnan, qnan, qnan}; *(f32x4*)(out + off + bj * HALF + n * 16) = o; }
                if (m & 1) asm volatile("" ::: "memory"); }
    }
};
struct EpiLnResLn {
    static constexpr bool PERM = false, AFTER_DRAIN = true;
    const float* base; float* out; bf16_t* xn; int ldc; const float* bias; PanelStats st1, st2; unsigned poison;
    __device__ __forceinline__ void fused(f32x4 (&acc)[2][2][4][2], const Unit& u, int wr, int wc, int fr, int fq, PG8_LAS unsigned char* lds, int wid, int lane) const {
        typedef float f32x2v __attribute__((ext_vector_type(2))); typedef unsigned u32x2v __attribute__((ext_vector_type(2)));
        const PG8_LAS f32x2v* S = (const PG8_LAS f32x2v*)(lds + 8192);
        const int col0 = u.pn * BM + wc * 32 + 4 * fq;
#pragma unroll
        for (int bj = 0; bj < 2; ++bj)
#pragma unroll
            for (int n = 0; n < 2; ++n) { const f32x4 bv = bias ? *(const f32x4*)(bias + col0 + bj * HALF + n * 16) : (f32x4){0.f, 0.f, 0.f, 0.f};
#pragma unroll
                for (int ai = 0; ai < 2; ++ai)
#pragma unroll
                    for (int m = 0; m < 4; ++m) acc[ai][bj][m][n] += bv; }
        bool bad = st1.run(acc, u, wr, wc, fr, fq, lds, wid, lane) || poison != 0u;
        const float qnan = __builtin_nanf("");
#pragma unroll
        for (int ai = 0; ai < 2; ++ai)
#pragma unroll
            for (int m = 0; m < 4; ++m) { const int r = ai * HALF + wr * 64 + m * 16 + fr; const f32x2v sr = S[r]; const size_t off = (size_t)(u.pm * BM + r) * ldc + col0;
#pragma unroll
                for (int bj = 0; bj < 2; ++bj)
#pragma unroll
                    for (int n = 0; n < 2; ++n) { const f32x4 bs = *(const f32x4*)(base + off + bj * HALF + n * 16); acc[ai][bj][m][n] = bs + (acc[ai][bj][m][n] - sr.x) * sr.y; }
                asm volatile("" : "+v"(acc[ai][0][m][0]), "+v"(acc[ai][0][m][1]), "+v"(acc[ai][1][m][0]), "+v"(acc[ai][1][m][1]));
                if (m & 1) asm volatile("" ::: "memory"); }
        const bool bad1 = bad;
        bad = st2.run(acc, u, wr, wc, fr, fq, lds, wid, lane) || bad;
#pragma unroll
        for (int ai = 0; ai < 2; ++ai)
#pragma unroll
            for (int m = 0; m < 4; ++m) { const int r = ai * HALF + wr * 64 + m * 16 + fr; const f32x2v sr = S[r]; const size_t off = (size_t)(u.pm * BM + r) * ldc + col0;
#pragma unroll
                for (int bj = 0; bj < 2; ++bj)
#pragma unroll
                    for (int n = 0; n < 2; ++n) { const f32x4 x1 = acc[ai][bj][m][n]; *(f32x4*)(out + off + bj * HALF + n * 16) = bad1 ? (f32x4){qnan, qnan, qnan, qnan} : x1;
                        const f32x4 o = (x1 - sr.x) * sr.y; u32x2v w; w.x = cvt_pk_bf16(o[0], o[1]); w.y = cvt_pk_bf16(o[2], o[3]);
                        if (bad) { w.x = 0x7fc07fc0u; w.y = 0x7fc07fc0u; } *(u32x2v*)(xn + off + bj * HALF + n * 16) = w; }
                asm volatile("" ::: "memory"); }
    }
};

template <class Epi, class Sched, bool ALIGN_EPI = false, bool SP2 = false>
__device__ __forceinline__ void gemm_phase(PG8_LAS unsigned char* lds, const Gemm g, const Sched& S, const Epi& E) {
    const int tid = threadIdx.x, wid = __builtin_amdgcn_readfirstlane(tid >> 6), lane = tid & 63, wr = wid >> 2, wc = wid & 3, fr = lane & 15, fq = lane >> 4;
    const int K = g.K, nt = K / BK;
    unsigned voffA[2], voffB[2];
#pragma unroll
    for (int i = 0; i < 2; ++i) { int R, C; stage_rc(tid * 16 + i * 8192, R, C); const int Rb = Epi::PERM ? ((R & ~31) + perm32(R & 31)) : R;
        voffA[i] = (unsigned)(R * K + C) * 2u; voffB[i] = (unsigned)(Rb * K + C) * 2u; }
    const size_t kstep = (size_t)(BK * 2);
    const size_t hstep = (size_t)HALF * K * 2;
    const size_t tstep = 2 * hstep;
    const unsigned ldsw = (unsigned)wid * 1024u;
    const int aoff = lds_byte(wr * 64 + fr, fq * 8), boff = lds_byte(wc * 32 + fr, fq * 8);
#define PG8_SA(b, h) (((b) * 2 + (h)) * HTB)
#define PG8_SB(b, h) ((4 + (b) * 2 + (h)) * HTB)
#define PG8_STAGE(bufoff, gbase, voff) do { _Pragma("unroll") for (int _i = 0; _i < 2; ++_i) \
        __builtin_amdgcn_global_load_lds((const unsigned*)((const char*)(gbase) + (voff)[_i]), (PG8_LAS unsigned*)(lds + (bufoff) + ldsw + _i * 8192), 16, 0, 0); } while (0)
#define PG8_LDA(dst, b, h) do { _Pragma("unroll") for (int m = 0; m < 4; ++m) _Pragma("unroll") for (int k = 0; k < 2; ++k) dst[m][k] = *(const PG8_LAS bf16x8*)(lds + PG8_SA(b, h) + aoff + m * 2048 + k * 1024); } while (0)
#define PG8_LDB(dst, b, h) do { _Pragma("unroll") for (int n = 0; n < 2; ++n) _Pragma("unroll") for (int k = 0; k < 2; ++k) dst[n][k] = *(const PG8_LAS bf16x8*)(lds + PG8_SB(b, h) + boff + n * 2048 + k * 1024); } while (0)
#define PG8_MMA(ai, bj, At, Bt) do { __builtin_amdgcn_s_setprio(1); _Pragma("unroll") for (int m = 0; m < 4; ++m) _Pragma("unroll") for (int n = 0; n < 2; ++n) _Pragma("unroll") for (int k = 0; k < 2; ++k) \
        acc[ai][bj][m][n] = __builtin_amdgcn_mfma_f32_16x16x32_bf16(Bt[n][k], At[m][k], acc[ai][bj][m][n], 0, 0, 0); __builtin_amdgcn_s_setprio(0); } while (0)
#define PG8_WAIT_V(n) asm volatile("s_waitcnt vmcnt(" #n ")" ::: "memory")
#define PG8_WAIT_L(n) asm volatile("s_waitcnt lgkmcnt(" #n ")" ::: "memory")
#define PG8_BAR __builtin_amdgcn_s_barrier()
#define PG8_SCHED __builtin_amdgcn_sched_barrier(0)
    Unit cur, nxt; int ui = 0;
    if (!S.next(0, cur)) return;
    f32x4 acc[2][2][4][2];
#pragma unroll
    for (int a = 0; a < 2; ++a)
#pragma unroll
        for (int b = 0; b < 2; ++b)
#pragma unroll
            for (int m = 0; m < 4; ++m)
#pragma unroll
                for (int n = 0; n < 2; ++n) acc[a][b][m][n] = (f32x4){0.f, 0.f, 0.f, 0.f};
    bf16x8 At[4][2], B0[2][2], B1[2][2];
    const char* cA = (const char*)g.A + (size_t)cur.pm * tstep; const char* cB = (const char*)g.Bt + (size_t)cur.pn * tstep;
    S.a_ready(cur);
    if constexpr (SP2) {
        PG8_STAGE(PG8_SB(0, 0), cB, voffB); PG8_STAGE(PG8_SB(0, 1), cB + hstep, voffB); PG8_STAGE(PG8_SA(0, 0), cA, voffA); PG8_STAGE(PG8_SA(0, 1), cA + hstep, voffA);
        if (wr == 1) PG8_BAR;
        PG8_WAIT_V(2); PG8_BAR;
        PG8_STAGE(PG8_SB(1, 0), cB + kstep, voffB); PG8_STAGE(PG8_SA(1, 0), cA + kstep, voffA); PG8_STAGE(PG8_SB(1, 1), cB + hstep + kstep, voffB);
        PG8_WAIT_V(6); PG8_BAR;
    } else {
        PG8_STAGE(PG8_SB(0, 0), cB, voffB); PG8_STAGE(PG8_SA(0, 0), cA, voffA); PG8_STAGE(PG8_SB(0, 1), cB + hstep, voffB); PG8_STAGE(PG8_SA(0, 1), cA + hstep, voffA);
        if (wr == 1) PG8_BAR;
        PG8_WAIT_V(4); PG8_BAR;
        PG8_STAGE(PG8_SB(1, 0), cB + kstep, voffB); PG8_STAGE(PG8_SA(1, 0), cA + kstep, voffA); PG8_STAGE(PG8_SB(1, 1), cB + hstep + kstep, voffB);
        PG8_WAIT_V(6); PG8_BAR;
    }
    for (;;) {
        const bool has_next = S.next(ui + 1, nxt);
        const char* nA = has_next ? (const char*)g.A + (size_t)nxt.pm * tstep : cA; const char* nB = has_next ? (const char*)g.Bt + (size_t)nxt.pn * tstep : cB;
        for (int t = 0; t < nt; t += 2) {
            const bool last = (t == nt - 2);
            const char* a1 = cA + (size_t)(t + 1) * kstep;
            const char* a2 = last ? nA : cA + (size_t)(t + 2) * kstep; const char* b2 = last ? nB : cB + (size_t)(t + 2) * kstep;
            const char* a3 = a2 + kstep; const char* b3 = b2 + kstep;
            if (last && has_next) S.a_ready(nxt);
            if constexpr (SP2) {
            PG8_LDB(B0, 0, 0); PG8_LDB(B1, 0, 1); PG8_SCHED; PG8_LDA(At, 0, 0); PG8_STAGE(PG8_SA(1, 1), a1 + hstep, voffA);
            PG8_WAIT_V(8); PG8_WAIT_L(0); PG8_BAR; PG8_MMA(0, 0, At, B0); PG8_MMA(0, 1, At, B1); PG8_BAR; PG8_SCHED;
            PG8_LDA(At, 0, 1); PG8_STAGE(PG8_SB(0, 0), b2, voffB); PG8_STAGE(PG8_SB(0, 1), b2 + hstep, voffB); PG8_STAGE(PG8_SA(0, 0), a2, voffA);
            PG8_WAIT_V(8); PG8_WAIT_L(0); PG8_BAR; PG8_MMA(1, 0, At, B0); PG8_MMA(1, 1, At, B1); PG8_BAR; PG8_SCHED;
            PG8_LDB(B0, 1, 0); PG8_LDB(B1, 1, 1); PG8_SCHED; PG8_LDA(At, 1, 0); PG8_STAGE(PG8_SA(0, 1), a2 + hstep, voffA);
            PG8_WAIT_V(8); PG8_WAIT_L(0); PG8_BAR; PG8_MMA(0, 0, At, B0); PG8_MMA(0, 1, At, B1); PG8_BAR; PG8_SCHED;
            PG8_LDA(At, 1, 1); PG8_STAGE(PG8_SB(1, 0), b3, voffB); PG8_STAGE(PG8_SB(1, 1), b3 + hstep, voffB); PG8_STAGE(PG8_SA(1, 0), a3, voffA);
            PG8_WAIT_V(8); PG8_WAIT_L(0); PG8_BAR; PG8_MMA(1, 0, At, B0); PG8_MMA(1, 1, At, B1); PG8_BAR; PG8_SCHED;
            } else {
            PG8_LDB(B0, 0, 0); PG8_SCHED; PG8_LDA(At, 0, 0); PG8_STAGE(PG8_SA(1, 1), a1 + hstep, voffA);
            PG8_WAIT_L(8); PG8_BAR; PG8_WAIT_L(0); PG8_MMA(0, 0, At, B0); PG8_BAR; PG8_SCHED;
            PG8_LDB(B1, 0, 1); PG8_STAGE(PG8_SB(0, 0), b2, voffB);
            PG8_BAR; PG8_WAIT_L(0); PG8_MMA(0, 1, At, B1); PG8_BAR;
            PG8_LDA(At, 0, 1); PG8_STAGE(PG8_SA(0, 0), a2, voffA);
            PG8_BAR; PG8_WAIT_L(0); PG8_MMA(1, 0, At, B0); PG8_BAR; PG8_SCHED;
            PG8_STAGE(PG8_SB(0, 1), b2 + hstep, voffB);
            PG8_WAIT_V(6); PG8_BAR; PG8_MMA(1, 1, At, B1); PG8_BAR;
            PG8_LDB(B0, 1, 0); PG8_SCHED; PG8_LDA(At, 1, 0); PG8_STAGE(PG8_SA(0, 1), a2 + hstep, voffA);
            PG8_WAIT_L(8); PG8_BAR; PG8_WAIT_L(0); PG8_MMA(0, 0, At, B0); PG8_BAR; PG8_SCHED;
            PG8_LDB(B1, 1, 1); PG8_STAGE(PG8_SB(1, 0), b3, voffB);
            PG8_BAR; PG8_WAIT_L(0); PG8_MMA(0, 1, At, B1); PG8_BAR;
            PG8_LDA(At, 1, 1); PG8_STAGE(PG8_SA(1, 0), a3, voffA);
            PG8_BAR; PG8_WAIT_L(0); PG8_MMA(1, 0, At, B0); PG8_BAR; PG8_SCHED;
            PG8_STAGE(PG8_SB(1, 1), b3 + hstep, voffB);
            PG8_WAIT_V(6); PG8_BAR; PG8_MMA(1, 1, At, B1); PG8_BAR;
            }
        }
        if constexpr (ALIGN_EPI) { if (wr == 0) PG8_BAR; }
        if constexpr (!Epi::AFTER_DRAIN) { E(acc, cur, wr, wc, fr, fq); S.done(cur); }
        if (!has_next) break;
#pragma unroll
        for (int a = 0; a < 2; ++a)
#pragma unroll
            for (int b = 0; b < 2; ++b)
#pragma unroll
                for (int m = 0; m < 4; ++m)
#pragma unroll
                    for (int n = 0; n < 2; ++n) acc[a][b][m][n] = (f32x4){0.f, 0.f, 0.f, 0.f};
        cur = nxt; cA = nA; cB = nB; ++ui;
        if constexpr (ALIGN_EPI) { if (wr == 1) PG8_BAR; }
    }
    PG8_WAIT_V(0);
    if constexpr (!ALIGN_EPI) { if (wr == 0) PG8_BAR; }
    PG8_BAR;
    if constexpr (Epi::AFTER_DRAIN) { E.fused(acc, cur, wr, wc, fr, fq, lds, wid, lane); S.done(cur); }
#undef PG8_SA
#undef PG8_SB
#undef PG8_STAGE
#undef PG8_LDA
#undef PG8_LDB
#undef PG8_MMA
#undef PG8_WAIT_V
#undef PG8_WAIT_L
#undef PG8_BAR
#undef PG8_SCHED
}
}

#ifndef PG8_SP2
#define PG8_SP2 true
#endif
#ifndef PG8_ALIGN
#define PG8_ALIGN true
#endif

namespace pg8 {
struct EpiProj {
    static constexpr bool PERM = true, AFTER_DRAIN = false;
    bf16_t* O; size_t stride; float* kmsum; float qscale;
    __device__ __forceinline__ void operator()(const f32x4 (&acc)[2][2][4][2], const Unit& u, int wr, int wc, int fr, int fq) const {
        const int t = u.pn >> 1, colt = (u.pn & 1) * BM;
        const int row0 = u.pm * BM + wr * 64 + fr, col0 = colt + wc * 32 + 8 * fq;
        bf16_t* base = O + (size_t)t * stride; const float sc = (t == 2) ? qscale : 1.f;
#pragma unroll
        for (int ai = 0; ai < 2; ++ai)
#pragma unroll
            for (int m = 0; m < 4; ++m) { bf16_t* rowp = base + (size_t)(row0 + ai * HALF + m * 16) * 512 + col0;
#pragma unroll
                for (int bj = 0; bj < 2; ++bj) { const f32x4 v0 = acc[ai][bj][m][0] * sc, v1 = acc[ai][bj][m][1] * sc;
                    u32x4 w; w.x = cvt_pk_bf16(v0[0], v0[1]); w.y = cvt_pk_bf16(v0[2], v0[3]); w.z = cvt_pk_bf16(v1[0], v1[1]); w.w = cvt_pk_bf16(v1[2], v1[3]);
                    *(u32x4*)(rowp + bj * HALF) = w; } }
        if (t == 3) {
#pragma unroll
            for (int bj = 0; bj < 2; ++bj)
#pragma unroll
                for (int n = 0; n < 2; ++n) { f32x4 s = (f32x4){0.f, 0.f, 0.f, 0.f};
#pragma unroll
                    for (int ai = 0; ai < 2; ++ai)
#pragma unroll
                        for (int m = 0; m < 4; ++m) s += acc[ai][bj][m][n];
#pragma unroll
                    for (int o = 1; o < 16; o <<= 1) { s[0] += __shfl_xor(s[0], o); s[1] += __shfl_xor(s[1], o); s[2] += __shfl_xor(s[2], o); s[3] += __shfl_xor(s[3], o); }
                    if (fr == 0) { float* kp = kmsum + (size_t)u.pm * 512 + col0 + bj * HALF + 4 * n;
                        atomicAdd(kp + 0, s[0]); atomicAdd(kp + 1, s[1]); atomicAdd(kp + 2, s[2]); atomicAdd(kp + 3, s[3]); } }
        }
    }
};
struct EpiF32 {
    static constexpr bool PERM = false, AFTER_DRAIN = false;
    float* C; int ldc;
    __device__ __forceinline__ void operator()(const f32x4 (&acc)[2][2][4][2], const Unit& u, int wr, int wc, int fr, int fq) const {
        const int row0 = u.pm * BM + wr * 64 + fr, col0 = u.pn * BM + wc * 32 + 4 * fq;
#pragma unroll
        for (int ai = 0; ai < 2; ++ai)
#pragma unroll
            for (int m = 0; m < 4; ++m) { float* rowp = C + (size_t)(row0 + ai * HALF + m * 16) * ldc + col0;
#pragma unroll
                for (int bj = 0; bj < 2; ++bj)
#pragma unroll
                    for (int n = 0; n < 2; ++n) *(f32x4*)(rowp + bj * HALF + n * 16) = acc[ai][bj][m][n]; }
    }
};
}

namespace pg8 {
constexpr unsigned TOK_NONE = 0xffffffffu;
template <class Epi, class Sched, bool GATHER, bool ALIGN_EPI = true>
__device__ __forceinline__ void gemm_phase_g(PG8_LAS unsigned char* lds, const Gemm g, const Sched& S, const Epi& E, const PG8_LAS unsigned* toktab) {
    const int tid = threadIdx.x, wid = __builtin_amdgcn_readfirstlane(tid >> 6), lane = tid & 63, wr = wid >> 2, wc = wid & 3, fr = lane & 15, fq = lane >> 4;
    const int K = g.K, nt = K / BK;
    unsigned voffB[2]; int RA[2]; unsigned CA2[2];
#pragma unroll
    for (int i = 0; i < 2; ++i) { int R, C; stage_rc(tid * 16 + i * 8192, R, C); const int Rb = Epi::PERM ? ((R & ~31) + perm32(R & 31)) : R;
        RA[i] = R; CA2[i] = (unsigned)C * 2u; voffB[i] = (unsigned)(Rb * K + C) * 2u; }
    const size_t kstep = (size_t)(BK * 2), hstep = (size_t)HALF * K * 2, tstep = 2 * hstep;
    const unsigned ldsw = (unsigned)wid * 1024u;
    const int aoff = lds_byte(wr * 64 + fr, fq * 8), boff = lds_byte(wc * 32 + fr, fq * 8);
#define PG8_SA(b, h) (((b) * 2 + (h)) * HTB)
#define PG8_SB(b, h) ((4 + (b) * 2 + (h)) * HTB)
#define PG8_STAGE(bufoff, gbase, voff) do { _Pragma("unroll") for (int _i = 0; _i < 2; ++_i) \
        __builtin_amdgcn_global_load_lds((const unsigned*)((const char*)(gbase) + (voff)[_i]), (PG8_LAS unsigned*)(lds + (bufoff) + ldsw + _i * 8192), 16, 0, 0); } while (0)
#define PG8_LDA(dst, b, h) do { _Pragma("unroll") for (int m = 0; m < 4; ++m) _Pragma("unroll") for (int k = 0; k < 2; ++k) dst[m][k] = *(const PG8_LAS bf16x8*)(lds + PG8_SA(b, h) + aoff + m * 2048 + k * 1024); } while (0)
#define PG8_LDB(dst, b, h) do { _Pragma("unroll") for (int n = 0; n < 2; ++n) _Pragma("unroll") for (int k = 0; k < 2; ++k) dst[n][k] = *(const PG8_LAS bf16x8*)(lds + PG8_SB(b, h) + boff + n * 2048 + k * 1024); } while (0)
#define PG8_MMA(ai, bj, At, Bt) do { __builtin_amdgcn_s_setprio(1); _Pragma("unroll") for (int m = 0; m < 4; ++m) _Pragma("unroll") for (int n = 0; n < 2; ++n) _Pragma("unroll") for (int k = 0; k < 2; ++k) \
        acc[ai][bj][m][n] = __builtin_amdgcn_mfma_f32_16x16x32_bf16(Bt[n][k], At[m][k], acc[ai][bj][m][n], 0, 0, 0); __builtin_amdgcn_s_setprio(0); } while (0)
#define PG8_WAIT_V(n) asm volatile("s_waitcnt vmcnt(" #n ")" ::: "memory")
#define PG8_WAIT_L(n) asm volatile("s_waitcnt lgkmcnt(" #n ")" ::: "memory")
#define PG8_BAR __builtin_amdgcn_s_barrier()
#define PG8_SCHED __builtin_amdgcn_sched_barrier(0)
#define PG8_MKOFF(VO, UI, U) do { _Pragma("unroll") for (int _h = 0; _h < 2; ++_h) _Pragma("unroll") for (int _i = 0; _i < 2; ++_i) { \
        unsigned _row; if (GATHER) { const unsigned _t = toktab[(UI) * 256 + _h * HALF + RA[_i]]; _row = (_t == TOK_NONE) ? 0u : (_t >> 1); } else _row = (unsigned)((U).pm * BM + _h * HALF + RA[_i]); \
        VO[_h][_i] = _row * (unsigned)(K * 2) + CA2[_i]; } } while (0)
    Unit cur, nxt; int ui = 0;
    if (!S.next(0, cur)) return;
    f32x4 acc[2][2][4][2];
#pragma unroll
    for (int a = 0; a < 2; ++a)
#pragma unroll
        for (int b = 0; b < 2; ++b)
#pragma unroll
            for (int m = 0; m < 4; ++m)
#pragma unroll
                for (int n = 0; n < 2; ++n) acc[a][b][m][n] = (f32x4){0.f, 0.f, 0.f, 0.f};
    bf16x8 At[4][2], B0[2][2], B1[2][2];
    const char* Ab = (const char*)g.A; const char* cB = (const char*)g.Bt + (size_t)cur.pn * tstep;
    unsigned vc[2][2], vn[2][2];
    PG8_MKOFF(vc, 0, cur);
    PG8_STAGE(PG8_SB(0, 0), cB, voffB); PG8_STAGE(PG8_SB(0, 1), cB + hstep, voffB); PG8_STAGE(PG8_SA(0, 0), Ab, vc[0]); PG8_STAGE(PG8_SA(0, 1), Ab, vc[1]);
    if (wr == 1) PG8_BAR;
    PG8_WAIT_V(2); PG8_BAR;
    PG8_STAGE(PG8_SB(1, 0), cB + kstep, voffB); PG8_STAGE(PG8_SA(1, 0), Ab + kstep, vc[0]); PG8_STAGE(PG8_SB(1, 1), cB + hstep + kstep, voffB);
    PG8_WAIT_V(6); PG8_BAR;
    for (;;) {
        const bool has_next = S.next(ui + 1, nxt);
        const char* nB = has_next ? (const char*)g.Bt + (size_t)nxt.pn * tstep : cB;
        if (has_next) { PG8_MKOFF(vn, ui + 1, nxt); } else { vn[0][0] = vc[0][0]; vn[0][1] = vc[0][1]; vn[1][0] = vc[1][0]; vn[1][1] = vc[1][1]; }
#pragma unroll 1
        for (int t = 0; t < nt; t += 2) {
            const bool last = (t == nt - 2);
            const char* a1 = Ab + (size_t)(t + 1) * kstep;
            const char* a2 = last ? Ab : Ab + (size_t)(t + 2) * kstep; const char* b2 = last ? nB : cB + (size_t)(t + 2) * kstep;
            const char* a3 = a2 + kstep; const char* b3 = b2 + kstep;
            unsigned v2[2][2];
#pragma unroll
            for (int h = 0; h < 2; ++h)
#pragma unroll
                for (int i = 0; i < 2; ++i) v2[h][i] = last ? vn[h][i] : vc[h][i];
            PG8_LDB(B0, 0, 0); PG8_LDB(B1, 0, 1); PG8_SCHED; PG8_LDA(At, 0, 0); PG8_STAGE(PG8_SA(1, 1), a1, vc[1]);
            PG8_WAIT_V(8); PG8_WAIT_L(0); PG8_BAR; PG8_MMA(0, 0, At, B0); PG8_MMA(0, 1, At, B1); PG8_BAR; PG8_SCHED;
            PG8_LDA(At, 0, 1); PG8_STAGE(PG8_SB(0, 0), b2, voffB); PG8_STAGE(PG8_SB(0, 1), b2 + hstep, voffB); PG8_STAGE(PG8_SA(0, 0), a2, v2[0]);
            PG8_WAIT_V(8); PG8_WAIT_L(0); PG8_BAR; PG8_MMA(1, 0, At, B0); PG8_MMA(1, 1, At, B1); PG8_BAR; PG8_SCHED;
            PG8_LDB(B0, 1, 0); PG8_LDB(B1, 1, 1); PG8_SCHED; PG8_LDA(At, 1, 0); PG8_STAGE(PG8_SA(0, 1), a2, v2[1]);
            PG8_WAIT_V(8); PG8_WAIT_L(0); PG8_BAR; PG8_MMA(0, 0, At, B0); PG8_MMA(0, 1, At, B1); PG8_BAR; PG8_SCHED;
            PG8_LDA(At, 1, 1); PG8_STAGE(PG8_SB(1, 0), b3, voffB); PG8_STAGE(PG8_SB(1, 1), b3 + hstep, voffB); PG8_STAGE(PG8_SA(1, 0), a3, v2[0]);
            PG8_WAIT_V(8); PG8_WAIT_L(0); PG8_BAR; PG8_MMA(1, 0, At, B0); PG8_MMA(1, 1, At, B1); PG8_BAR; PG8_SCHED;
        }
        if constexpr (ALIGN_EPI) { if (wr == 0) PG8_BAR; }
        E(acc, cur, ui, wr, wc, fr, fq);
        if (!has_next) break;
#pragma unroll
        for (int a = 0; a < 2; ++a)
#pragma unroll
            for (int b = 0; b < 2; ++b)
#pragma unroll
                for (int m = 0; m < 4; ++m)
#pragma unroll
                    for (int n = 0; n < 2; ++n) acc[a][b][m][n] = (f32x4){0.f, 0.f, 0.f, 0.f};
        cur = nxt; cB = nB; ++ui;
#pragma unroll
        for (int h = 0; h < 2; ++h)
#pragma unroll
            for (int i = 0; i < 2; ++i) vc[h][i] = vn[h][i];
        if constexpr (ALIGN_EPI) { if (wr == 1) PG8_BAR; }
    }
    PG8_WAIT_V(0);
    if constexpr (!ALIGN_EPI) { if (wr == 0) PG8_BAR; }
    PG8_BAR;
#undef PG8_SA
#undef PG8_SB
#undef PG8_STAGE
#undef PG8_LDA
#undef PG8_LDB
#undef PG8_MMA
#undef PG8_WAIT_V
#undef PG8_WAIT_L
#undef PG8_BAR
#undef PG8_SCHED
#undef PG8_MKOFF
}
struct MoeOrder {
    const PG8_LAS unsigned* toff; int nct, G, c;
    __device__ __forceinline__ bool next(int i, Unit& u) const {
        const int L = i * G + c; const int total = (int)toff[32] * nct; if (L >= total) return false;
        const int rt = L / nct, ct = L % nct; int e = 0; while ((int)toff[e + 1] <= rt) ++e;
        u.pm = rt; u.pn = e * nct + ct; return true;
    }
};
struct EpiMoeUp {
    static constexpr bool PERM = true, AFTER_DRAIN = false;
    bf16_t* H; const float* RW; const PG8_LAS unsigned* toktab;
    __device__ __forceinline__ void operator()(const f32x4 (&acc)[2][2][4][2], const Unit& u, int ui, int wr, int wc, int fr, int fq) const {
        const int col0 = (u.pn & 1) * HALF + wc * 32 + 8 * fq;
#pragma unroll
        for (int ai = 0; ai < 2; ++ai)
#pragma unroll
            for (int m = 0; m < 4; ++m) { const int r = ai * HALF + wr * 64 + m * 16 + fr; const unsigned tk = toktab[ui * 256 + r]; const float w = (tk != TOK_NONE) ? RW[tk] : 0.f;
                float h[8];
#pragma unroll
                for (int n = 0; n < 2; ++n)
#pragma unroll
                    for (int j = 0; j < 4; ++j) { const float a = acc[ai][0][m][n][j], b = acc[ai][1][m][n][j]; h[4 * n + j] = a / (1.f + __expf(-a)) * b * w; }
                u32x4 o; o.x = cvt_pk_bf16(h[0], h[1]); o.y = cvt_pk_bf16(h[2], h[3]); o.z = cvt_pk_bf16(h[4], h[5]); o.w = cvt_pk_bf16(h[6], h[7]);
                *(u32x4*)(H + (size_t)(u.pm * BM + r) * 256 + col0) = o; }
    }
};
struct EpiMoeDown {
    static constexpr bool PERM = true, AFTER_DRAIN = false;
    bf16_t* YS; bf16_t* dump; const PG8_LAS unsigned* toktab;
    __device__ __forceinline__ void operator()(const f32x4 (&acc)[2][2][4][2], const Unit& u, int ui, int wr, int wc, int fr, int fq) const {
        const int col0 = (u.pn & 3) * BM + wc * 32 + 8 * fq;
#pragma unroll
        for (int ai = 0; ai < 2; ++ai)
#pragma unroll
            for (int m = 0; m < 4; ++m) { const int r = ai * HALF + wr * 64 + m * 16 + fr; const unsigned tk = toktab[ui * 256 + r];
                bf16_t* rowp = ((tk != TOK_NONE) ? YS + (size_t)tk * 1024 : dump) + col0;
#pragma unroll
                for (int bj = 0; bj < 2; ++bj) { const f32x4 v0 = acc[ai][bj][m][0], v1 = acc[ai][bj][m][1];
                    u32x4 o; o.x = cvt_pk_bf16(v0[0], v0[1]); o.y = cvt_pk_bf16(v0[2], v0[3]); o.z = cvt_pk_bf16(v1[0], v1[1]); o.w = cvt_pk_bf16(v1[2], v1[3]);
                    *(u32x4*)(rowp + bj * HALF) = o; }
                asm volatile("" ::: "memory"); }
    }
};
}

#include <hip/hip_bf16.h>
#include <cmath>
namespace attn_body {
using bf16=__hip_bfloat16;
using bf16x8=__attribute__((ext_vector_type(8)))short;
using s16x4=__attribute__((ext_vector_type(4)))short;
using f32x16=__attribute__((ext_vector_type(16)))float;
using u32x4=__attribute__((ext_vector_type(4)))unsigned;
constexpr int BATCH=4,NHEAD=8,SEQ=4096,D=64,DM=NHEAD*D;
constexpr int NW=8,QBLK=32,QB=QBLK*NW,KVBLK=64,NQB=SEQ/QB;
constexpr int ATTN_PITCH=DM, ATTN_UNIT_ROWS=QB;
__device__ __forceinline__ int crow(int r,int hi){return (r&3)+8*(r>>2)+4*hi;}
#define SBAR() __builtin_amdgcn_sched_barrier(0)
__device__ __forceinline__ void maskbias(f32x16&p0,f32x16&p1,int relbase,int hi,const __attribute__((address_space(3))) float*RT){
  const __attribute__((address_space(3))) float*p=RT+(511-relbase+4*hi);
  #pragma unroll
  for(int r=0;r<16;++r){ p0[r]+=p[(r&3)+8*(r>>2)]; p1[r]+=p[32+(r&3)+8*(r>>2)]; if((r&3)==3)__builtin_amdgcn_sched_barrier(0); }
}

constexpr int NSLOT=3, SLOTB=8192;
constexpr int LDS_K=0, LDS_V=NSLOT*SLOTB, LDS_WS=2*NSLOT*SLOTB, LDS_OST=LDS_WS+NW*64*4, LDS_KM=LDS_OST+NW*4096, LDS_BT=LDS_KM+4096, LDS_BYTES=LDS_BT+3072;
constexpr float C2=0.125f*1.4426950408889634f;
__device__ __forceinline__ void glds16(const void*gsrc,unsigned lds_dst){unsigned keep;
  asm volatile("s_mov_b32 %0, m0\n\ts_mov_b32 m0, %2\n\ts_nop 0\n\tglobal_load_lds_dwordx4 %1, off\n\ts_mov_b32 m0, %0":"=&s"(keep):"v"(gsrc),"s"(lds_dst):"memory");}
__device__ __forceinline__ float max3f(float a,float b,float c){float r;asm("v_max3_f32 %0, %1, %2, %3":"=v"(r):"v"(a),"v"(b),"v"(c));return r;}
__device__ __forceinline__ float max2f(float a,float b){float r;asm("v_max_f32_e32 %0, %1, %2":"=v"(r):"v"(a),"v"(b));return r;}
__device__ __forceinline__ float fadd_s(float a,float b){float r;asm("v_add_f32_e32 %0, %1, %2":"=v"(r):"v"(a),"v"(b));return r;}
__device__ __forceinline__ float fsub_s(float a,float b){float r;asm("v_sub_f32_e32 %0, %1, %2":"=v"(r):"v"(a),"v"(b));return r;}
typedef float f32x4_t __attribute__((ext_vector_type(4))); typedef float f32x2_t __attribute__((ext_vector_type(2))); typedef __bf16 bf16x2_t __attribute__((ext_vector_type(2)));
__device__ __forceinline__ unsigned cvtpk_s(float lo,float hi){f32x2_t v={lo,hi};bf16x2_t b=__builtin_convertvector(v,bf16x2_t);return __builtin_bit_cast(unsigned,b);}
#define WAIT_BAR(N) asm volatile("s_waitcnt vmcnt(" #N ") lgkmcnt(0)\n\ts_barrier":::"memory")

__device__ __forceinline__ void qkt(f32x16&p0,f32x16&p1,const char*Kslot,const bf16x8*qr,int r32,int hi){
  const char*kb=Kslot+hi*1024+r32*16;
  #pragma unroll
  for(int d0=0;d0<4;++d0){
    const bf16x8 b0=*reinterpret_cast<const bf16x8*>(kb+d0*2048);
    const bf16x8 b1=*reinterpret_cast<const bf16x8*>(kb+d0*2048+512);
    if(d0==0){p0=__builtin_amdgcn_mfma_f32_32x32x16_bf16(b0,qr[0],f32x16{},0,0,0);p1=__builtin_amdgcn_mfma_f32_32x32x16_bf16(b1,qr[0],f32x16{},0,0,0);}
    else{p0=__builtin_amdgcn_mfma_f32_32x32x16_bf16(b0,qr[d0],p0,0,0,0);p1=__builtin_amdgcn_mfma_f32_32x32x16_bf16(b1,qr[d0],p1,0,0,0);}}
}
typedef __attribute__((address_space(3))) const char* lds_cptr;
typedef short v4i16_t __attribute__((ext_vector_type(4)));
__device__ __forceinline__ void kload8(bf16x8*kf,lds_cptr kp){
  kf[0]=*(const __attribute__((address_space(3))) bf16x8*)(kp);      kf[1]=*(const __attribute__((address_space(3))) bf16x8*)(kp+512);
  kf[2]=*(const __attribute__((address_space(3))) bf16x8*)(kp+2048); kf[3]=*(const __attribute__((address_space(3))) bf16x8*)(kp+2560);
  kf[4]=*(const __attribute__((address_space(3))) bf16x8*)(kp+4096); kf[5]=*(const __attribute__((address_space(3))) bf16x8*)(kp+4608);
  kf[6]=*(const __attribute__((address_space(3))) bf16x8*)(kp+6144); kf[7]=*(const __attribute__((address_space(3))) bf16x8*)(kp+6656);
}
__device__ __forceinline__ void kload2(bf16x8*kf,lds_cptr kp,int j){ kf[2*j]=*(const __attribute__((address_space(3))) bf16x8*)(kp+j*2048); kf[2*j+1]=*(const __attribute__((address_space(3))) bf16x8*)(kp+j*2048+512); }
__device__ __forceinline__ s16x4 vtr(lds_cptr p){ return __builtin_bit_cast(s16x4,__builtin_amdgcn_ds_read_tr16_b64_v4i16((__attribute__((address_space(3))) v4i16_t*)p)); }
__device__ __forceinline__ float rowmax(const f32x16&p0,const f32x16&p1){
  float a=max3f(p0[0],p0[1],p1[0]),b=max3f(p0[2],p0[3],p1[1]);a=max3f(a,p1[2],p1[3]);
  #pragma unroll
  for(int r=4;r<16;r+=4){a=max3f(a,p0[r],p0[r+1]);b=max3f(b,p0[r+2],p0[r+3]);a=max3f(a,p1[r],p1[r+1]);b=max3f(b,p1[r+2],p1[r+3]);}
  const float m=max2f(a,b);
  auto rr=__builtin_amdgcn_permlane32_swap(__float_as_uint(m),__float_as_uint(m),false,false);
  return max2f(__uint_as_float(rr[0]),__uint_as_float(rr[1]));
}
__device__ __forceinline__ void pv(f32x16*o,int vb,bf16x8 pa0,bf16x8 pa1,bf16x8 pa2,bf16x8 pa3){
  #pragma unroll
  for(int d0=0;d0<2;++d0){s16x4 lo[4],hi[4];
    #pragma unroll
    for(int ks=0;ks<4;++ks){
      asm volatile("ds_read_b64_tr_b16 %0,%1 offset:%c2":"=&v"(lo[ks]):"v"(vb),"i"(d0*4096+ks*1024):"memory");
      asm volatile("ds_read_b64_tr_b16 %0,%1 offset:%c2":"=&v"(hi[ks]):"v"(vb),"i"(d0*4096+ks*1024+512):"memory");}
    asm volatile("s_waitcnt lgkmcnt(0)":::"memory");SBAR();
    #define PK(k) (bf16x8){lo[k][0],lo[k][1],lo[k][2],lo[k][3],hi[k][0],hi[k][1],hi[k][2],hi[k][3]}
    o[d0]=__builtin_amdgcn_mfma_f32_32x32x16_bf16(pa0,PK(0),o[d0],0,0,0);
    o[d0]=__builtin_amdgcn_mfma_f32_32x32x16_bf16(pa1,PK(1),o[d0],0,0,0);
    o[d0]=__builtin_amdgcn_mfma_f32_32x32x16_bf16(pa2,PK(2),o[d0],0,0,0);
    o[d0]=__builtin_amdgcn_mfma_f32_32x32x16_bf16(pa3,PK(3),o[d0],0,0,0);
    #undef PK
  }
}

#ifndef ATTN_STORE16
#define ATTN_STORE16(p,v) (*(u32x4*)(p)=(v))
#endif
template<int THRL> __device__ __forceinline__ void attn_unit(int b,int h,int qb,const bf16*Q,const bf16*__restrict__ K,const bf16*__restrict__ V,bf16*O,const float*kmsum,const float*rel_bias,const unsigned char*t5b,char*shm){
  const int tid=threadIdx.x,lane=tid&63,r32=lane&31,hi=lane>>5; const int wid=__builtin_amdgcn_readfirstlane(tid>>6);
  const long rowbase=(long)b*SEQ; const int q0=qb*QB;
  const bf16*Qw=Q+(rowbase+q0+wid*QBLK)*DM+h*D;
  const bf16*Kh=K+rowbase*DM+h*D,*Vh=V+rowbase*DM+h*D;
  typedef __attribute__((address_space(3))) char* lds_wptr; const lds_wptr shm3=(lds_wptr)shm;
  const unsigned lds0=(unsigned)(uintptr_t)shm;
  float*wsf=(float*)(shm+LDS_WS)+wid*64;
  const bf16*ksrc=Kh+(long)lane*DM+wid*8;
  const bf16*vsrc=Vh+(long)(16*(wid&3)+(lane>>2))*DM+(wid>>2)*32+(lane&3)*8;
  const unsigned kdst=lds0+LDS_K+wid*1024, vdst=lds0+LDS_V+wid*1024;
  #define TMAP(t) (((t)<4)?(4*qb+(t)):((t)-4))
  #define DMA_K(t,slot) glds16(ksrc+(long)TMAP(t)*KVBLK*DM,(unsigned)__builtin_amdgcn_readfirstlane(kdst+(slot)))
  #define DMA_V(t,slot) glds16(vsrc+(long)TMAP(t)*KVBLK*DM,(unsigned)__builtin_amdgcn_readfirstlane(vdst+(slot)))
  const int vb0=(int)(lds0+LDS_V)+((lane>>4)&1)*32+(lane&3)*8+(4*hi+((lane&15)>>2))*64;
  const char*Kbase=shm+LDS_K; bf16x8 kf[8];
  const lds_cptr kp0=shm3+LDS_K+hi*1024+r32*16; const lds_cptr vp0=shm3+LDS_V+((lane>>4)&1)*32+(lane&3)*8+(4*hi+((lane&15)>>2))*64;
  const int NT=(q0+QB)/KVBLK;
  {
    if(tid<256){ const int jb_=tid>>4,d4_=(tid&15)*4; *(__attribute__((address_space(3))) f32x4_t*)(shm3+LDS_KM+tid*16)=*(const f32x4_t*)(kmsum+((long)(b*(SEQ/QB)+jb_)*DM+h*D+d4_)); }
    for(int k_=tid;k_<767;k_+=NW*64){ const int rel_=511-k_; float v_=0.f; if(rel_<0)v_=-INFINITY; else if(rel_<113)v_=(rel_bias[(int)t5b[rel_]*NHEAD+h]-rel_bias[31*NHEAD+h])*1.4426950408889634f;
      ((__attribute__((address_space(3))) float*)(shm3+LDS_BT))[k_]=v_; } }
  DMA_K(0,0);DMA_V(0,0);DMA_K(1,SLOTB);
  bf16x8 qr[4];
  #pragma unroll
  for(int d0=0;d0<4;++d0)qr[d0]=*reinterpret_cast<const bf16x8*>(&Qw[(long)r32*DM+d0*16+hi*8]);
  float mhat=0.f,l_reg=0.f;f32x16 o[2];o[0]=f32x16{};o[1]=f32x16{};
  const int qrel=wid*QBLK+r32;
  #define CMASK(P0,P1,t) do{ const int t_=(t); if(t_<4){ if(32*wid-64*t_-63<113) maskbias(P0,P1,qrel-64*t_,hi,BT); } \
    else if(((t_-4)>>2)==qb-1){ const int ko_=256-64*((t_-4)&3); if(32*wid+ko_-63<113) maskbias(P0,P1,qrel+ko_,hi,BT); } }while(0)
  bool resc=false;
  #define START(P0,P1) do{ const float rm=rowmax(P0,P1); resc=false; \
    { const float dl=rm; mhat=fadd_s(mhat,dl); \
      _Pragma("unroll") for(int r=0;r<16;++r){P0[r]=fsub_s(P0[r],dl);P1[r]=fsub_s(P1[r],dl);} \
      } \
    _Pragma("unroll") for(int r=0;r<16;++r)P0[r]=__builtin_amdgcn_exp2f(P0[r]); }while(0)
  #define RESC() do{ if(resc){ asm volatile("s_waitcnt lgkmcnt(0)":::"memory"); \
      _Pragma("unroll") for(int d_=0;d_<2;++d_) _Pragma("unroll") for(int r=0;r<16;++r)o[d_][r]*=wsf[crow(r,hi)]; } }while(0)
  f32x16 pA0,pA1,pB0,pB1;
  int sl_prev=0,sl_cur=0,sl_next=SLOTB;
  #define ROT() do{sl_prev=sl_cur;sl_cur=sl_next;sl_next=(sl_next==(NSLOT-1)*SLOTB)?0:sl_next+SLOTB;}while(0)
  DMA_K(2,2*SLOTB);
  WAIT_BAR(3);
  unsigned selmask;
  { const __attribute__((address_space(3))) float*KM=(const __attribute__((address_space(3))) float*)(shm3+LDS_KM);
    float v0=-INFINITY,v1=-INFINITY,v2=-INFINITY;int i0=0,i1=0,i2=0;
    #define QF(d0,j) __builtin_bit_cast(float,(unsigned)(unsigned short)qr[d0][j]<<16)
    #pragma unroll 1
    for(int jb=0;jb<qb;++jb){ float g=0.f;
      #pragma unroll
      for(int d0=0;d0<4;++d0){ const f32x4_t ka=*(const __attribute__((address_space(3))) f32x4_t*)(KM+jb*64+16*d0+8*hi), kb2=*(const __attribute__((address_space(3))) f32x4_t*)(KM+jb*64+16*d0+8*hi+4);
        g+=QF(d0,0)*ka[0]+QF(d0,1)*ka[1]+QF(d0,2)*ka[2]+QF(d0,3)*ka[3]+QF(d0,4)*kb2[0]+QF(d0,5)*kb2[1]+QF(d0,6)*kb2[2]+QF(d0,7)*kb2[3]; }
    #undef QF
      g+=__shfl_xor(g,32);
      if(g>v0){v2=v1;i2=i1;v1=v0;i1=i0;v0=g;i0=jb;} else if(g>v1){v2=v1;i2=i1;v1=g;i1=jb;} else if(g>v2){v2=g;i2=jb;} }
    selmask=(qb>=3)?((1u<<i0)|(1u<<i1)|(1u<<i2)):((1u<<qb)-1u); }
  const __attribute__((address_space(3))) float*BT=(const __attribute__((address_space(3))) float*)(shm3+LDS_BT);
  qkt(pA0,pA1,Kbase,qr,r32,hi);asm volatile("s_nop 15\n\ts_nop 7":"+v"(pA0),"+v"(pA1));CMASK(pA0,pA1,0);
  START(pA0,pA1);
  _Pragma("unroll") for(int r=0;r<16;++r)pA1[r]=__builtin_amdgcn_exp2f(pA1[r]);
  WAIT_BAR(0);
  DMA_K(3,0);DMA_V(1,SLOTB);
  ROT();
  kload8(kf,kp0+sl_cur);
  WAIT_BAR(2);
  s16x4 vlo[8],vhi[8]; u32x4 pw0,pw1,pw2,pw3;
  #define PKW(P,B) cvtpk_s(P[B],P[B+1])
  #define PAF(k) __builtin_bit_cast(bf16x8,pw##k)
  #define VFR(i) (bf16x8){vlo[i][0],vlo[i][1],vlo[i][2],vlo[i][3],vhi[i][0],vhi[i][1],vhi[i][2],vhi[i][3]}
  #define PIN(x) asm volatile("":"+v"(x))
  #define MX3(a,b,c) __builtin_fmaxf(__builtin_fmaxf((a),(b)),(c))
  #define GAPA(MF,A0,A1,A2,A3,W0,W1,PW) do{ MF; sacc+=A0; sacc+=A1; sacc+=A2; sacc+=A3; PIN(sacc); W0; W1; PIN(PW); SBAR(); }while(0)
  #define EX(v) __builtin_amdgcn_exp2f(v)
  #define GAPB(MF,X,B) do{ MF; X[B]=EX(X[B]); X[B+1]=EX(X[B+1]); X[B+2]=EX(X[B+2]); X[B+3]=EX(X[B+3]); PIN(X); SBAR(); }while(0)
  #define VRD(i) do{ vlo[i]=vtr(vp_+(((i)>>2)*4096+((i)&3)*1024)); vhi[i]=vtr(vp_+(((i)>>2)*4096+((i)&3)*1024+512)); }while(0)
  #define KRD(G,j) do{ if(G){ kload2(kf,kp0+sl_next,j); SBAR(); } }while(0)
  #define STEP(C0,C1,P0,P1,t,GK,GV,GL) do{ SBAR(); \
    const lds_cptr vp_=vp0+sl_prev; \
    VRD(0); SBAR(); float sacc=(P0[0]+P0[1]); \
    GAPA(C0=__builtin_amdgcn_mfma_f32_32x32x16_bf16(kf[0],qr[0],f32x16{},0,0,0), P0[2],P0[3],P0[4],P0[5],     pw0[0]=PKW(P0,0), pw0[1]=PKW(P0,2), pw0); \
    VRD(4); SBAR(); GAPA(C1=__builtin_amdgcn_mfma_f32_32x32x16_bf16(kf[1],qr[0],f32x16{},0,0,0), P0[6],P0[7],P0[8],P0[9],     pw0[2]=PKW(P0,4), pw0[3]=PKW(P0,6), pw0); \
    VRD(1); SBAR(); GAPA(C0=__builtin_amdgcn_mfma_f32_32x32x16_bf16(kf[2],qr[1],C0,0,0,0),   P0[10],P0[11],P0[12],P0[13], pw1[0]=PKW(P0,8), pw1[1]=PKW(P0,10), pw1); \
    VRD(5); SBAR(); GAPA(C1=__builtin_amdgcn_mfma_f32_32x32x16_bf16(kf[3],qr[1],C1,0,0,0),   P0[14],P0[15],P1[0],P1[1],   pw1[2]=PKW(P0,12),pw1[3]=PKW(P0,14), pw1); \
    VRD(2); SBAR(); GAPA(C0=__builtin_amdgcn_mfma_f32_32x32x16_bf16(kf[4],qr[2],C0,0,0,0),   P1[2],P1[3],P1[4],P1[5],     pw2[0]=PKW(P1,0), pw2[1]=PKW(P1,2), pw2); \
    VRD(6); SBAR(); GAPA(C1=__builtin_amdgcn_mfma_f32_32x32x16_bf16(kf[5],qr[2],C1,0,0,0),   P1[6],P1[7],P1[8],P1[9],     pw2[2]=PKW(P1,4), pw2[3]=PKW(P1,6), pw2); \
    VRD(3); SBAR(); GAPA(C0=__builtin_amdgcn_mfma_f32_32x32x16_bf16(kf[6],qr[3],C0,0,0,0),   P1[10],P1[11],P1[12],P1[13], pw3[0]=PKW(P1,8), pw3[1]=PKW(P1,10), pw3); \
    VRD(7); SBAR(); GAPA(C1=__builtin_amdgcn_mfma_f32_32x32x16_bf16(kf[7],qr[3],C1,0,0,0),   P1[14],P1[15],0.f,0.f,       pw3[2]=PKW(P1,12),pw3[3]=PKW(P1,14), pw3); \
    l_reg+=sacc; \
    if(GK){DMA_K((t)+3,sl_cur);} if(GV){DMA_V((t)+1,sl_next);} \
    { const int tq_=(t); const bool sel_=(tq_<4)||((selmask>>((tq_-4)>>2))&1u); const float nm_=sel_?-mhat:-INFINITY; \
      _Pragma("unroll") for(int r=0;r<16;++r){C0[r]+=nm_;C1[r]+=nm_;} } \
    CMASK(C0,C1,t); \
    { float a=MX3(C0[0],C0[1],C1[0]),b=MX3(C0[2],C0[3],C1[1]); a=MX3(a,C1[2],C1[3]); \
      _Pragma("unroll") for(int r=4;r<16;r+=4){a=MX3(a,C0[r],C0[r+1]);b=MX3(b,C0[r+2],C0[r+3]);a=MX3(a,C1[r],C1[r+1]);b=MX3(b,C1[r+2],C1[r+3]);} \
      float rm=__builtin_fmaxf(a,b); { auto rr=__builtin_amdgcn_permlane32_swap(__float_as_uint(rm),__float_as_uint(rm),false,false); rm=__builtin_fmaxf(__uint_as_float(rr[0]),__uint_as_float(rr[1])); } \
      resc=false; \
      if(__builtin_expect(__any(rm>(float)THRL),0)){ const float dl=__builtin_fmaxf(rm,0.f); mhat+=dl; \
        _Pragma("unroll") for(int r=0;r<16;++r){C0[r]-=dl;C1[r]-=dl;} \
        const float f=__builtin_amdgcn_exp2f(-dl); l_reg*=f; if(hi==0)wsf[r32]=f; resc=true; } \
      } \
    SBAR(); \
    GAPB(o[0]=__builtin_amdgcn_mfma_f32_32x32x16_bf16(PAF(0),VFR(0),o[0],0,0,0), C0,0); \
    GAPB(o[1]=__builtin_amdgcn_mfma_f32_32x32x16_bf16(PAF(0),VFR(4),o[1],0,0,0), C0,4); \
    KRD(GL,0); GAPB(o[0]=__builtin_amdgcn_mfma_f32_32x32x16_bf16(PAF(1),VFR(1),o[0],0,0,0), C0,8); \
    KRD(GL,1); GAPB(o[1]=__builtin_amdgcn_mfma_f32_32x32x16_bf16(PAF(1),VFR(5),o[1],0,0,0), C0,12); \
    KRD(GL,2); GAPB(o[0]=__builtin_amdgcn_mfma_f32_32x32x16_bf16(PAF(2),VFR(2),o[0],0,0,0), C1,0); \
    KRD(GL,3); GAPB(o[1]=__builtin_amdgcn_mfma_f32_32x32x16_bf16(PAF(2),VFR(6),o[1],0,0,0), C1,4); \
    GAPB(o[0]=__builtin_amdgcn_mfma_f32_32x32x16_bf16(PAF(3),VFR(3),o[0],0,0,0), C1,8); \
    GAPB(o[1]=__builtin_amdgcn_mfma_f32_32x32x16_bf16(PAF(3),VFR(7),o[1],0,0,0), C1,12); \
    }while(0)
  int t=1;
  for(;t+5<NT;t+=2){
    STEP(pB0,pB1,pA0,pA1,t,true,true,true);     WAIT_BAR(2); RESC(); ROT();
    STEP(pA0,pA1,pB0,pB1,t+1,true,true,true);   WAIT_BAR(2); RESC(); ROT();
  }
  #define ENDW(tt) do{ if((tt)+3<NT){WAIT_BAR(2);} else if((tt)+2<NT){WAIT_BAR(1);} else {WAIT_BAR(0);} }while(0)
  for(;t+1<NT;t+=2){
    STEP(pB0,pB1,pA0,pA1,t,(t+3<NT),(t+1<NT),(t+1<NT));       ENDW(t);   RESC(); ROT();
    STEP(pA0,pA1,pB0,pB1,t+1,(t+4<NT),(t+2<NT),(t+2<NT));     ENDW(t+1); RESC(); ROT();
  }
  STEP(pB0,pB1,pA0,pA1,NT-1,false,false,false); RESC();
  { float sacc=pB0[0]+pB0[1]; _Pragma("unroll") for(int r=2;r<16;++r)sacc+=pB0[r]; _Pragma("unroll") for(int r=0;r<16;++r)sacc+=pB1[r]; l_reg+=sacc;
    pw0=(u32x4){PKW(pB0,0),PKW(pB0,2),PKW(pB0,4),PKW(pB0,6)};pw1=(u32x4){PKW(pB0,8),PKW(pB0,10),PKW(pB0,12),PKW(pB0,14)};pw2=(u32x4){PKW(pB1,0),PKW(pB1,2),PKW(pB1,4),PKW(pB1,6)};pw3=(u32x4){PKW(pB1,8),PKW(pB1,10),PKW(pB1,12),PKW(pB1,14)};
    SBAR(); pv(o,vb0+sl_cur,PAF(0),PAF(1),PAF(2),PAF(3)); }
  #undef PKW
  #undef PAF
  #undef VFR
  #undef PIN
  #undef MX3
  #undef GAPA
  #undef GAPB
  #undef EX
  #undef VRD
  #undef KRD
  #undef STEP
  #undef ENDW
  {auto rr=__builtin_amdgcn_permlane32_swap(__float_as_uint(l_reg),__float_as_uint(l_reg),false,false);l_reg=__uint_as_float(rr[0])+__uint_as_float(rr[1]);}
  if(hi==0)wsf[32+r32]=l_reg;asm volatile("s_waitcnt lgkmcnt(0)":::"memory");
  float rli[16];
  #pragma unroll
  for(int r=0;r<16;++r)rli[r]=__builtin_amdgcn_rcpf(wsf[32+crow(r,hi)]);
  bf16*Ow=O+(rowbase+q0+wid*QBLK)*DM+h*D;
  { bf16*stg=(bf16*)(shm+LDS_OST)+wid*2048;
    #pragma unroll
    for(int r=0;r<16;++r){const int orow=crow(r,hi);
      #pragma unroll
      for(int d0=0;d0<2;++d0)stg[orow*64+d0*32+r32]=__float2bfloat16(o[d0][r]*rli[r]);}
    asm volatile("s_waitcnt lgkmcnt(0)":::"memory");
    #pragma unroll
    for(int i=0;i<4;++i){const int row=i*8+(lane>>3),ch=lane&7; const u32x4 v=*(const u32x4*)(stg+row*64+ch*8); ATTN_STORE16(Ow+(long)row*DM+ch*8,v);} }
  asm volatile("s_waitcnt lgkmcnt(0)\n\ts_barrier":::"memory");
  #undef DMA_K
  #undef DMA_V
  #undef TMAP
  #undef CMASK
  #undef START
  #undef RESC
  #undef ROT
}
constexpr int ATTN_LDS_BYTES=LDS_BYTES;
struct AttnTensors { const bf16* Q; const bf16* K; const bf16* V; bf16* O; const float* kmsum; const float* rel_bias; const unsigned char* t5b; };
struct AttnUnit { int bh; int qb; };
struct StaticOrder {
  int vcu,G;
  __device__ __forceinline__ explicit StaticOrder(int grid,int vcu_):vcu(vcu_),G(grid){}
  __device__ __forceinline__ bool next(int i,AttnUnit&u)const{ const int w=i*G+vcu; if(w>=512)return false; const int s=w&7; u.bh=(w&255)>>3; u.qb=(w<256)?s:15-s; return true; }
  __device__ __forceinline__ void a_ready(const AttnUnit&)const{}
  __device__ __forceinline__ void done(const AttnUnit&)const{}
};
template<class Sched,int THRL=8> __device__ __forceinline__ void attn_phase(char*lds,const AttnTensors&T,const Sched&S){
  AttnUnit u;
  for(int i=0;S.next(i,u);++i){ S.a_ready(u); attn_unit<THRL>(u.bh/NHEAD,u.bh%NHEAD,u.qb,T.Q,T.K,T.V,T.O,T.kmsum,T.rel_bias,T.t5b,lds); S.done(u); }
}
#undef SBAR
#undef WAIT_BAR
}

#define GAS __attribute__((address_space(1)))
#define LAS __attribute__((address_space(3)))
typedef unsigned short bf16;
typedef unsigned v4u __attribute__((ext_vector_type(4)));
typedef float f32x4 __attribute__((ext_vector_type(4)));
typedef short bf16x8 __attribute__((ext_vector_type(8)));
typedef GAS unsigned gu32;
typedef GAS unsigned long long gu64;
#define RLX_AGENT __ATOMIC_RELAXED, __HIP_MEMORY_SCOPE_AGENT
#define LDS_WAIT() asm volatile("s_waitcnt lgkmcnt(0)" ::: "memory")
#define VM_WAIT() asm volatile("s_waitcnt vmcnt(0)" ::: "memory")
__device__ __forceinline__ unsigned long long rt() { return __builtin_amdgcn_s_memrealtime(); }
__device__ __forceinline__ unsigned f2bf(float f) { unsigned u = __builtin_bit_cast(unsigned, f); return (u + 0x7fffu + ((u >> 16) & 1u)) >> 16; }
typedef float pk_f32x2 __attribute__((ext_vector_type(2))); typedef __bf16 pk_bf16x2 __attribute__((ext_vector_type(2)));
__device__ __forceinline__ unsigned pk2(float lo, float hi) { pk_f32x2 v = {lo, hi}; return __builtin_bit_cast(unsigned, __builtin_convertvector(v, pk_bf16x2)); }


#define XB_TMO      128
#define XB_XCNT(j)  (256  + 64 * (j))
#define XB_XSUB(j)  (1280 + 64 * (j))
#define XB_XGEN(j)  (2304 + 64 * (j))
#define XB_TOP      3328
#define XB_TOPGEN   3392
#define XCD_BAR_WORDS 3456
#define XB_SPIN_CAP (1u << 18)

__device__ __forceinline__ unsigned xb_ld(unsigned* p)              { return __hip_atomic_load(p, __ATOMIC_RELAXED, __HIP_MEMORY_SCOPE_AGENT); }
__device__ __forceinline__ unsigned xb_add(unsigned* p, unsigned v) { return __hip_atomic_fetch_add(p, v, __ATOMIC_RELAXED, __HIP_MEMORY_SCOPE_AGENT); }
__device__ __forceinline__ unsigned xb_xcc_id() { return (unsigned)__builtin_amdgcn_s_getreg((3 << 11) | 20) & 0xFu; }
#define XB_SPIN(cond, bar) do { unsigned _sp = 0; while (cond) { __builtin_amdgcn_s_sleep(1); \
    if ((++_sp & 255u) == 0u) { if (xb_ld(&(bar)[XB_TMO])) break; if (_sp > XB_SPIN_CAP) { atomicAdd(&(bar)[XB_TMO], 1u); break; } } } } while (0)

struct XcdBarrier {
    unsigned* bar; unsigned x;
    volatile LAS unsigned* st;
};

__device__ __forceinline__ XcdBarrier xcd_barrier_post(unsigned* bar, volatile LAS unsigned* st) {
    XcdBarrier b; b.bar = bar; b.x = xb_xcc_id(); b.st = st;
    if (threadIdx.x == 0) (void)xb_add(&bar[XB_XCNT(b.x)], 1u);
    return b;
}
__device__ __forceinline__ void xcd_barrier_complete(unsigned* bar, unsigned x, unsigned& nloc, unsigned& nx) {
    const unsigned G = gridDim.x * gridDim.y * gridDim.z;
    unsigned sum, cnt, mine, sp = 0u;
    for (;;) {
        sum = 0u; cnt = 0u; mine = 0u;
#pragma unroll
        for (unsigned j = 0; j < 16; ++j) { const unsigned c = xb_ld(&bar[XB_XCNT(j)]); sum += c; cnt += (c > 0u) ? 1u : 0u; mine = (j == x) ? c : mine; }
        if (sum == G) break;
        __builtin_amdgcn_s_sleep(1);
        if ((++sp & 255u) == 0u) { if (xb_ld(&bar[XB_TMO])) break; if (sp > XB_SPIN_CAP) { atomicAdd(&bar[XB_TMO], 1u); break; } }
    }
    nloc = mine > 0u ? mine : 1u; nx = cnt > 0u ? cnt : 1u;
}

__device__ __forceinline__ void xcd_barrier(const XcdBarrier& b) {
    asm volatile("s_waitcnt vmcnt(0)" ::: "memory");
    __syncthreads();
    if (threadIdx.x == 0) {
        unsigned* bar = b.bar;
        __builtin_amdgcn_s_waitcnt(0);
        unsigned nloc = b.st[0], nx = b.st[1];
        if (nloc == 0u) { xcd_barrier_complete(bar, b.x, nloc, nx); b.st[0] = nloc; b.st[1] = nx; }
        const unsigned old = xb_add(&bar[XB_XSUB(b.x)], 1u);
        const unsigned gen = old / nloc;
        if (old + 1u == (gen + 1u) * nloc) {
            __builtin_amdgcn_fence(__ATOMIC_RELEASE, "agent");
            asm volatile("s_waitcnt vmcnt(0)" ::: "memory");
            const unsigned og = xb_add(&bar[XB_TOP], 1u);
            const unsigned tg = og / nx;
            if (og + 1u == (tg + 1u) * nx) xb_add(&bar[XB_TOPGEN], 1u);
            else XB_SPIN(xb_ld(&bar[XB_TOPGEN]) == tg, bar);
            __builtin_amdgcn_fence(__ATOMIC_ACQUIRE, "agent");
            xb_add(&bar[XB_XGEN(b.x)], 1u);
            asm volatile("s_waitcnt vmcnt(0)" ::: "memory");
        } else {
            XB_SPIN(xb_ld(&bar[XB_XGEN(b.x)]) == gen, bar);
            __builtin_amdgcn_fence(__ATOMIC_ACQUIRE, "agent");
            asm volatile("s_waitcnt vmcnt(0)" ::: "memory");
        }
    }
    __syncthreads();
}

constexpr int NWAVES = 8, NTHR = NWAVES * 64;
constexpr int D = 1024, NB = 4, S = 4096, M = NB * S;
constexpr int DL = 512, DA = 512, NH = 8, HD = 64, BLK = 256, NBLK = S / BLK;
constexpr int NPROJ = 2560, NMOD = 6;
constexpr int NG = 4, EPG = 8, NE = 32, DE = 256;
constexpr float LN_EPS = 1e-5f;
constexpr float ALPHA = 1.189207115002721f;
constexpr float LOG2E = 1.4426950408889634f;
constexpr float QSCALE = 0.125f * LOG2E;

constexpr size_t MiB = 1u << 20, KiB = 1u << 10;
constexpr size_t WS_CTL = 0, CTL_ZERO_BYTES = 1 * MiB;
constexpr int CW_TMO = 0, CW_CODE = 1, CW_BAR = 4096;
constexpr size_t WS_KMSUM = 256 * KiB;
constexpr size_t WS_ECNT = 512 * KiB;
constexpr size_t WS_MOD = 768 * KiB;
constexpr size_t WS_WIN = 1 * MiB;
constexpr size_t WS_WO = 6 * MiB;
constexpr size_t WS_W13 = 8 * MiB;
constexpr size_t WS_W2 = 40 * MiB;
constexpr size_t WS_U = 56 * MiB;
constexpr size_t WS_XL = 88 * MiB, WS_YL = 104 * MiB, WS_Q = 120 * MiB, WS_K = 136 * MiB, WS_V = 152 * MiB;
constexpr size_t WS_HL = 168 * MiB, WS_CA = 184 * MiB, WS_AO = 200 * MiB;
constexpr size_t WS_MIX = 88 * MiB;
constexpr size_t WS_X1 = 168 * MiB;
constexpr size_t WS_YS = 88 * MiB;
constexpr size_t WS_HDN = 232 * MiB;
constexpr size_t WS_LIST = 253 * MiB;
constexpr size_t WS_SUMM = 255 * MiB;
constexpr size_t WS_GW = 255 * MiB + 256 * KiB;
constexpr size_t WS_RI = 255 * MiB + 512 * KiB, WS_RW = 255 * MiB + 640 * KiB;
constexpr size_t WS_WR = 252 * MiB + 512 * KiB;
constexpr size_t WS_DUMP = 255 * MiB + 768 * KiB;
constexpr size_t WS_END = 256 * MiB;

constexpr int RING_OFF = 0, RING_BYTES = 131072;
constexpr int LDSCTL_OFF = RING_BYTES, MISC_OFF = LDSCTL_OFF + 320;
constexpr int TOKTAB_OFF = LDSCTL_OFF + 1024, TOKTAB_UNITS = 8, MOEOFF_OFF = TOKTAB_OFF + TOKTAB_UNITS * 1024;
constexpr int LDS_BYTES = 147456;
static_assert(MOEOFF_OFF + 512 <= LDS_BYTES, "LDS map");

__device__ __constant__ unsigned char T5_BUCKET[128] = {
    0, 1, 2, 3, 4, 5, 6, 7, 8, 9, 10, 11, 12, 13, 14, 15, 16, 16, 16, 17, 17, 18, 18, 18, 19, 19, 19, 20, 20, 20, 20, 21, 21, 21, 21, 22, 22, 22, 22, 22,
    23, 23, 23, 23, 23, 23, 24, 24, 24, 24, 24, 24, 25, 25, 25, 25, 25, 25, 25, 26, 26, 26, 26, 26, 26, 26, 26, 27, 27, 27, 27, 27, 27, 27, 27, 27, 27,
    28, 28, 28, 28, 28, 28, 28, 28, 28, 28, 29, 29, 29, 29, 29, 29, 29, 29, 29, 29, 29, 29, 30, 30, 30, 30, 30, 30, 30, 30, 30, 30, 30, 30, 30, 30,
    31, 31, 31, 31, 31, 31, 31, 31, 31, 31, 31, 31, 31, 31, 31};

struct Frame {
    LAS unsigned char* lds;
    volatile LAS unsigned* MISC;
    gu32* ctl;
    int tid, lane, wave, vcu, G;
};
__device__ __forceinline__ float wave_sum(float v) {
#pragma unroll
    for (int o = 1; o < 64; o <<= 1) v += __shfl_xor(v, o);
    return v;
}
__device__ __forceinline__ float bf2f(unsigned short h) { return __builtin_bit_cast(float, (unsigned)h << 16); }
__device__ __forceinline__ float bflo(unsigned w) { return __builtin_bit_cast(float, w << 16); }
__device__ __forceinline__ float bfhi(unsigned w) { return __builtin_bit_cast(float, w & 0xffff0000u); }
__device__ __forceinline__ float fsigmoid(float x) { return 1.f / (1.f + __expf(-x)); }
__device__ __forceinline__ float fsilu(float x) { return x * fsigmoid(x); }
__device__ __forceinline__ float fgelu_tanh(float x) { const float z = 0.7978845608028654f * (x + 0.044715f * x * x * x); return x / (1.f + __expf(-2.f * z)); }

__device__ __forceinline__ void p0_transpose_item(const float* W, int N, int k0, int n0, bf16* WT, int ldk, int dst_row0, const float* kgain, LAS float* scr, int lane) {
#pragma unroll 8
    for (int i = 0; i < 32; ++i) { const int kk = 2 * i + (lane >> 5); float v = W[(size_t)(k0 + kk) * N + n0 + (lane & 31)]; if (kgain) v *= kgain[k0 + kk]; scr[kk * 33 + (lane & 31)] = v; }
    LDS_WAIT(); asm volatile("" ::: "memory");
    const int c = lane & 7;
#pragma unroll
    for (int j = 0; j < 4; ++j) { const int n = (lane >> 3) + 8 * j; const LAS float* s = scr + (8 * c) * 33 + n;
        v4u o; o.x = pk2(s[0 * 33], s[1 * 33]); o.y = pk2(s[2 * 33], s[3 * 33]); o.z = pk2(s[4 * 33], s[5 * 33]); o.w = pk2(s[6 * 33], s[7 * 33]);
        *(GAS v4u*)(WT + (size_t)(dst_row0 + n) * ldk + k0 + 8 * c) = o; }
    LDS_WAIT(); asm volatile("" ::: "memory");
}

struct Ptrs {
    const float *x, *c, *w_ada, *b_ada, *w_in, *conv_w, *conv_b, *w_ga, *b_ga, *w_gx, *b_gx, *lam, *rel_bias, *g_l, *g_a, *w_out, *ln1_g, *ln1_b, *w_rg, *b_rg, *w_re, *b_re, *w1, *w3, *w2, *ln2_g, *ln2_b;
    float* out; unsigned char* ws;
};
__device__ __forceinline__ void p0_prologue(Frame& F, const Ptrs& P) {
    float* mod = (float*)(P.ws + WS_MOD);
    if (blockIdx.x < (NMOD * D) / 32) {
        LAS float* sc = (LAS float*)(F.lds + RING_OFF);
        LAS float* part = (LAS float*)(F.lds + RING_OFF + 16384);
        for (int i = F.tid; i < NB * D; i += NTHR) sc[i] = fsilu(P.c[i]);
        __syncthreads();
        const int n0 = 32 * blockIdx.x, col = F.tid & 31, ks = F.tid >> 5, k0 = ks * 64;
        float a0 = 0.f, a1 = 0.f, a2 = 0.f, a3 = 0.f;
#pragma unroll 16
        for (int kk = 0; kk < 64; ++kk) { const float w = P.w_ada[(size_t)(k0 + kk) * (NMOD * D) + n0 + col];
            a0 += sc[k0 + kk] * w; a1 += sc[D + k0 + kk] * w; a2 += sc[2 * D + k0 + kk] * w; a3 += sc[3 * D + k0 + kk] * w; }
        part[(ks * 32 + col) * 4 + 0] = a0; part[(ks * 32 + col) * 4 + 1] = a1; part[(ks * 32 + col) * 4 + 2] = a2; part[(ks * 32 + col) * 4 + 3] = a3;
        __syncthreads();
        if (F.tid < 128) { const int cc = F.tid & 31, b = F.tid >> 5; float s = 0.f;
#pragma unroll
            for (int k = 0; k < 16; ++k) s += part[(k * 32 + cc) * 4 + b];
            mod[b * NMOD * D + n0 + cc] = s + P.b_ada[n0 + cc]; }
        __syncthreads();
    }
    LAS float* scr = (LAS float*)(F.lds + RING_OFF + F.wave * 16384);
    const int gw = F.vcu * NWAVES + F.wave, NGW = F.G * NWAVES;
    constexpr int I_IN = 16 * 80, I_OUT = 16 * 32, I_W1 = NE * 16 * 8, I_W2 = NE * 4 * 32, NITEMS = I_IN + I_OUT + 2 * I_W1 + I_W2;
    bf16* WinT = (bf16*)(P.ws + WS_WIN); bf16* WoT = (bf16*)(P.ws + WS_WO); bf16* W13T = (bf16*)(P.ws + WS_W13); bf16* W2T = (bf16*)(P.ws + WS_W2);
    for (int it = gw; it < NITEMS; it += NGW) {
        int r = it;
        if (r < I_IN) { const int kb = r / 80, nb = r % 80; p0_transpose_item(P.w_in, NPROJ, 64 * kb, 32 * nb, WinT, D, 32 * nb, nullptr, scr, F.lane); continue; } r -= I_IN;
        if (r < I_OUT) { const int kb = r / 32, nb = r % 32; p0_transpose_item(P.w_out, D, 64 * kb, 32 * nb, WoT, D, 32 * nb, (64 * kb < DL) ? P.g_l : (P.g_a - DL), scr, F.lane); continue; } r -= I_OUT;
        if (r < I_W1) { const int e = r / 128, q = r % 128, kb = q / 8, n0 = 32 * (q % 8);
            p0_transpose_item(P.w1 + (size_t)e * D * DE, DE, 64 * kb, n0, W13T + (size_t)e * 512 * D, D, (n0 / 128) * 256 + (n0 % 128), nullptr, scr, F.lane); continue; } r -= I_W1;
        if (r < I_W1) { const int e = r / 128, q = r % 128, kb = q / 8, n0 = 32 * (q % 8);
            p0_transpose_item(P.w3 + (size_t)e * D * DE, DE, 64 * kb, n0, W13T + (size_t)e * 512 * D, D, (n0 / 128) * 256 + 128 + (n0 % 128), nullptr, scr, F.lane); continue; } r -= I_W1;
        { const int e = r / 128, q = r % 128, kb = q / 32, n0 = 32 * (q % 32);
            p0_transpose_item(P.w2 + (size_t)e * DE * D, D, 64 * kb, n0, W2T + (size_t)e * D * DE, DE, n0, nullptr, scr, F.lane); }
    }
    { float* WR = (float*)(P.ws + WS_WR);
      for (int f = F.vcu * NTHR + F.tid; f < D * 48; f += F.G * NTHR) { const int k = f / 48, col = f % 48; WR[f] = col < NG ? P.w_rg[k * NG + col] : (col < NG + NE ? P.w_re[k * NE + col - NG] : 0.f); } }
    { bf16* GW = (bf16*)(P.ws + WS_GW);
      for (int f = F.vcu * NTHR + F.tid; f < 8 * 2 * 2 * 4 * 64; f += F.G * NTHR) {
          const int ln = f & 63, s = (f >> 6) & 3, T = (f >> 8) & 1, g = (f >> 9) & 1, n = f >> 10;
          const int rho = ln & 31, h = ln >> 5, hi = (rho >> 2) & 1, reg = (rho & 3) + 4 * (rho >> 3), chan = 16 * (2 * T + (reg >> 3)) + 8 * hi + (reg & 7);
          const float* W = (g ? P.w_gx : P.w_ga) + (size_t)n * 64 * 64 + chan; const int i0 = 16 * s + 8 * h;
          v4u o; o.x = pk2(W[(i0 + 0) * 64], W[(i0 + 1) * 64]); o.y = pk2(W[(i0 + 2) * 64], W[(i0 + 3) * 64]); o.z = pk2(W[(i0 + 4) * 64], W[(i0 + 5) * 64]); o.w = pk2(W[(i0 + 6) * 64], W[(i0 + 7) * 64]);
          *(GAS v4u*)(GW + (size_t)f * 8) = o; } }
}
__device__ __forceinline__ void p1_modulate(Frame& F, const Ptrs& P) {
    const int gw = F.vcu * NWAVES + F.wave, NGW = F.G * NWAVES;
    const float* mod = (const float*)(P.ws + WS_MOD); bf16* U = (bf16*)(P.ws + WS_U);
    for (int m = gw; m < M; m += NGW) {
        const GAS f32x4* xr = (const GAS f32x4*)(P.x + (size_t)m * D) + F.lane;
        f32x4 v[4]; float s = 0.f;
#pragma unroll
        for (int j = 0; j < 4; ++j) { v[j] = xr[64 * j]; s += (v[j].x + v[j].y) + (v[j].z + v[j].w); }
        const float mean = wave_sum(s) * (1.f / D); float s2 = 0.f;
#pragma unroll
        for (int j = 0; j < 4; ++j) { v[j] = v[j] - mean; s2 += (v[j].x * v[j].x + v[j].y * v[j].y) + (v[j].z * v[j].z + v[j].w * v[j].w); }
        const float rstd = 1.f / sqrtf(wave_sum(s2) * (1.f / D) + LN_EPS);
        const f32x4* sh = (const f32x4*)(mod + (size_t)(m / S) * NMOD * D) + F.lane; const f32x4* sc = sh + D / 4;
        GAS unsigned long long* o8 = (GAS unsigned long long*)(U + (size_t)m * D) + F.lane;
#pragma unroll
        for (int j = 0; j < 4; ++j) { const f32x4 a = v[j] * rstd * (sc[64 * j] + 1.f) + sh[64 * j];
            o8[64 * j] = (unsigned long long)pk2(a.x, a.y) | ((unsigned long long)pk2(a.z, a.w) << 32); }
    }
}
__device__ __forceinline__ void lru_unit(Frame& F, const Ptrs& P, int b, int c, int n) {
    typedef float f32x16 __attribute__((ext_vector_type(16)));
    LAS float* cst = (LAS float*)(F.lds + RING_OFF);
    LAS float* tot = cst + 192;
    LAS float* pre = tot + 1024;
    const bf16* XL = (const bf16*)(P.ws + WS_XL); const bf16* GW = (const bf16*)(P.ws + WS_GW);
    bf16* HL = (bf16*)(P.ws + WS_HL); bf16* CA = (bf16*)(P.ws + WS_CA); float* SUMM = (float*)(P.ws + WS_SUMM);
    const int r = F.lane & 31, hi = F.lane >> 5, w = F.wave;
    if (F.tid < 64) { const int ch = 64 * n + F.tid; cst[F.tid] = P.b_ga[ch]; cst[64 + F.tid] = P.b_gx[ch]; cst[128 + F.tid] = 8.0f * log1pf(__expf(-P.lam[ch])); }
    const int srow = c * BLK + 32 * w + r; const size_t grow = (size_t)b * S + srow;
    float xc[4][8]; bf16x8 bfr[4];
#pragma unroll
    for (int s = 0; s < 4; ++s) { const int cb = 64 * n + 16 * s + 8 * hi;
        { const f32x4 b0 = *(const f32x4*)(P.conv_b + cb), b1 = *(const f32x4*)(P.conv_b + cb + 4);
          xc[s][0] = b0[0]; xc[s][1] = b0[1]; xc[s][2] = b0[2]; xc[s][3] = b0[3]; xc[s][4] = b1[0]; xc[s][5] = b1[1]; xc[s][6] = b1[2]; xc[s][7] = b1[3]; }
#pragma unroll
        for (int k = 0; k < 4; ++k) { const bool inb = srow - 3 + k >= 0;
            v4u xv = *(const GAS v4u*)(XL + (inb ? grow - 3 + k : grow) * DL + cb); if (!inb) xv = (v4u){0u, 0u, 0u, 0u};
            const f32x4 w0 = *(const f32x4*)(P.conv_w + k * DL + cb), w1 = *(const f32x4*)(P.conv_w + k * DL + cb + 4);
            xc[s][0] += w0[0] * bflo(xv[0]); xc[s][1] += w0[1] * bfhi(xv[0]); xc[s][2] += w0[2] * bflo(xv[1]); xc[s][3] += w0[3] * bfhi(xv[1]);
            xc[s][4] += w1[0] * bflo(xv[2]); xc[s][5] += w1[1] * bfhi(xv[2]); xc[s][6] += w1[2] * bflo(xv[3]); xc[s][7] += w1[3] * bfhi(xv[3]); }
        v4u pk; pk.x = pk2(xc[s][0], xc[s][1]); pk.y = pk2(xc[s][2], xc[s][3]); pk.z = pk2(xc[s][4], xc[s][5]); pk.w = pk2(xc[s][6], xc[s][7]);
        bfr[s] = __builtin_bit_cast(bf16x8, pk); }
    f32x16 acc[2][2];
#pragma unroll
    for (int g = 0; g < 2; ++g)
#pragma unroll
        for (int T = 0; T < 2; ++T) { acc[g][T] = (f32x16){0.f, 0.f, 0.f, 0.f, 0.f, 0.f, 0.f, 0.f, 0.f, 0.f, 0.f, 0.f, 0.f, 0.f, 0.f, 0.f};
#pragma unroll
            for (int s = 0; s < 4; ++s) { const bf16x8 af = __builtin_bit_cast(bf16x8, *(const GAS v4u*)(GW + ((size_t)((((n * 2 + g) * 2 + T) * 4 + s) * 64 + F.lane)) * 8));
                acc[g][T] = __builtin_amdgcn_mfma_f32_32x32x16_bf16(af, bfr[s], acc[g][T], 0, 0, 0); } }
    __syncthreads();
    float av[32], hv[32];
#pragma unroll
    for (int T = 0; T < 2; ++T)
#pragma unroll
        for (int rg = 0; rg < 16; ++rg) { const int i = 16 * T + rg, chl = 16 * (i >> 3) + 8 * hi + (i & 7);
            const float ra = acc[0][T][rg] + cst[chl], rx = acc[1][T][rg] + cst[64 + chl];
            const float rr = __builtin_amdgcn_rcpf(1.f + __expf(-ra)), ig = __builtin_amdgcn_rcpf(1.f + __expf(-rx));
            const float a = __expf(-rr * cst[128 + chl]), mult = __builtin_amdgcn_sqrtf(fmaxf(1.f - a * a, 0.f));
            av[i] = a; hv[i] = mult * ig * xc[i >> 3][i & 7]; }
    __builtin_amdgcn_sched_barrier(0); asm volatile("s_nop 1" ::: "memory");
#define LRU_STEP(CTRL) do { _Pragma("unroll") for (int i = 0; i < 32; ++i) \
        asm volatile("v_fmac_f32_dpp %0, %0, %1 " CTRL " bank_mask:0xf\n\tv_mul_f32_dpp %1, %1, %1 " CTRL " bank_mask:0xf" : "+v"(hv[i]), "+v"(av[i])); } while (0)
    LRU_STEP("row_shr:1 row_mask:0xf"); LRU_STEP("row_shr:2 row_mask:0xf"); LRU_STEP("row_shr:4 row_mask:0xf"); LRU_STEP("row_shr:8 row_mask:0xf"); LRU_STEP("row_bcast:15 row_mask:0xa");
#undef LRU_STEP
    asm volatile("s_nop 1" ::: "memory");
    if (r == 31) {
#pragma unroll
        for (int i = 0; i < 32; ++i) { const int chl = 16 * (i >> 3) + 8 * hi + (i & 7); tot[(w * 64 + chl) * 2] = av[i]; tot[(w * 64 + chl) * 2 + 1] = hv[i]; } }
    __syncthreads();
    if (F.tid < 64) { float cin = 1.f, hin = 0.f;
#pragma unroll
        for (int ww = 0; ww < 8; ++ww) { pre[(ww * 64 + F.tid) * 2] = cin; pre[(ww * 64 + F.tid) * 2 + 1] = hin; const float pa = tot[(ww * 64 + F.tid) * 2], hh = tot[(ww * 64 + F.tid) * 2 + 1]; hin = pa * hin + hh; cin *= pa; }
        float* sp = SUMM + ((size_t)(b * NBLK + c) * DL + 64 * n + F.tid) * 2; sp[0] = cin; sp[1] = hin; }
    __syncthreads();
#pragma unroll
    for (int s = 0; s < 4; ++s) { float hl[8], ca[8];
#pragma unroll
        for (int jj = 0; jj < 8; ++jj) { const int i = 8 * s + jj, chl = 16 * s + 8 * hi + jj; const float cin = pre[(w * 64 + chl) * 2], hin = pre[(w * 64 + chl) * 2 + 1];
            hl[jj] = hv[i] + av[i] * hin; ca[jj] = av[i] * cin; }
        v4u oh, oc; oh.x = pk2(hl[0], hl[1]); oh.y = pk2(hl[2], hl[3]); oh.z = pk2(hl[4], hl[5]); oh.w = pk2(hl[6], hl[7]);
        oc.x = pk2(ca[0], ca[1]); oc.y = pk2(ca[2], ca[3]); oc.z = pk2(ca[4], ca[5]); oc.w = pk2(ca[6], ca[7]);
        *(GAS v4u*)(HL + grow * DL + 64 * n + 16 * s + 8 * hi) = oh; *(GAS v4u*)(CA + grow * DL + 64 * n + 16 * s + 8 * hi) = oc; }
    __syncthreads();
}
__device__ __forceinline__ void p3_lru(Frame& F, const Ptrs& P) {
    for (int u = F.vcu; u < NB * NBLK * 8; u += F.G) lru_unit(F, P, u >> 7, (u >> 3) & 15, u & 7);
}
__device__ __forceinline__ void p4_merge(Frame& F, const Ptrs& P) {
    const bf16* HL = (const bf16*)(P.ws + WS_HL); const bf16* CA = (const bf16*)(P.ws + WS_CA); const bf16* YL = (const bf16*)(P.ws + WS_YL); const bf16* AO = (const bf16*)(P.ws + WS_AO);
    const float* SUMM = (const float*)(P.ws + WS_SUMM); bf16* MG = (bf16*)(P.ws + WS_U);
    LAS float* hin = (LAS float*)(F.lds + RING_OFF);
    for (int u = F.vcu; u < M / 64; u += F.G) {
        const int r0 = 64 * u, b = r0 / S, ck = (r0 % S) / BLK;
        { float h = 0.f; const float* sp = SUMM + ((size_t)b * NBLK * DL + F.tid) * 2;
            for (int c = 0; c < ck; ++c) { const float pa = sp[(size_t)c * DL * 2], hh = sp[(size_t)c * DL * 2 + 1]; h = pa * h + hh; }
            hin[F.tid] = h; }
        __syncthreads();
        float hn[8]; { const f32x4 hi0 = *(const LAS f32x4*)(hin + 8 * F.lane), hi1 = *(const LAS f32x4*)(hin + 8 * F.lane + 4);
            hn[0] = hi0[0]; hn[1] = hi0[1]; hn[2] = hi0[2]; hn[3] = hi0[3]; hn[4] = hi1[0]; hn[5] = hi1[1]; hn[6] = hi1[2]; hn[7] = hi1[3]; }
        for (int rr = 0; rr < 8; ++rr) { const size_t row = (size_t)r0 + F.wave * 8 + rr;
            const v4u hl = *(const GAS v4u*)(HL + row * DL + 8 * F.lane), ca = *(const GAS v4u*)(CA + row * DL + 8 * F.lane), yl = *(const GAS v4u*)(YL + row * DL + 8 * F.lane), ao = *(const GAS v4u*)(AO + row * DA + 8 * F.lane);
            float l[8], a[8]; float sl = 0.f, sa = 0.f;
#pragma unroll
            for (int i = 0; i < 4; ++i) { const float hlo = bflo(hl[i]) + bflo(ca[i]) * hn[2 * i], hhi = bfhi(hl[i]) + bfhi(ca[i]) * hn[2 * i + 1];
                l[2 * i] = hlo * fgelu_tanh(bflo(yl[i])); l[2 * i + 1] = hhi * fgelu_tanh(bfhi(yl[i])); a[2 * i] = bflo(ao[i]); a[2 * i + 1] = bfhi(ao[i]);
                sl += l[2 * i] * l[2 * i] + l[2 * i + 1] * l[2 * i + 1]; sa += a[2 * i] * a[2 * i] + a[2 * i + 1] * a[2 * i + 1]; }
            const float rl = 1.f / sqrtf(wave_sum(sl) * (1.f / DL) + LN_EPS), ra = 1.f / sqrtf(wave_sum(sa) * (1.f / DA) + LN_EPS);
            v4u ol, oa;
#pragma unroll
            for (int i = 0; i < 4; ++i) { ol[i] = pk2(l[2 * i] * rl, l[2 * i + 1] * rl); oa[i] = pk2(a[2 * i] * ra, a[2 * i + 1] * ra); }
            *(GAS v4u*)(MG + row * D + 8 * F.lane) = ol; *(GAS v4u*)(MG + row * D + DL + 8 * F.lane) = oa; }
        __syncthreads();
    }
}
__device__ __forceinline__ void p6_post(Frame& F, const Ptrs& P, bool publish) {
    typedef float f32x4v __attribute__((ext_vector_type(4)));
    constexpr int TS = 1026;
    LAS float* T = (LAS float*)(F.lds + RING_OFF);
    LAS float* Pt = T + 16 * TS;
    LAS float* LG = Pt + 8 * 16 * 48;
    const float* mod = (const float*)(P.ws + WS_MOD); const float* MIX = (const float*)(P.ws + WS_MIX); float* X1 = (float*)(P.ws + WS_X1); bf16* U2 = (bf16*)(P.ws + WS_U);
    const float* WR = (const float*)(P.ws + WS_WR);
    int* RI = (int*)(P.ws + WS_RI); float* RW = (float*)(P.ws + WS_RW); unsigned* ecnt = (unsigned*)(P.ws + WS_ECNT); unsigned* list = (unsigned*)(P.ws + WS_LIST);
    for (int u = F.vcu; u < M / 16; u += F.G) {
#pragma unroll 1
        for (int rr = 0; rr < 2; ++rr) { const int lr = 2 * F.wave + rr, m = 16 * u + lr;
            const f32x4* md = (const f32x4*)(mod + (size_t)(m / S) * NMOD * D) + F.lane;
            const GAS f32x4* xr = (const GAS f32x4*)(P.x + (size_t)m * D) + F.lane; const GAS f32x4* mr = (const GAS f32x4*)(MIX + (size_t)m * D) + F.lane;
            f32x4 v[4]; float s = 0.f;
#pragma unroll
            for (int j = 0; j < 4; ++j) { v[j] = xr[64 * j] * ALPHA + md[2 * (D / 4) + 64 * j] * mr[64 * j]; s += (v[j].x + v[j].y) + (v[j].z + v[j].w); }
            float mean = wave_sum(s) * (1.f / D), s2 = 0.f;
#pragma unroll
            for (int j = 0; j < 4; ++j) { v[j] = v[j] - mean; s2 += (v[j].x * v[j].x + v[j].y * v[j].y) + (v[j].z * v[j].z + v[j].w * v[j].w); }
            float rstd = 1.f / sqrtf(wave_sum(s2) * (1.f / D) + LN_EPS); s = 0.f;
            GAS f32x4* x1r = (GAS f32x4*)(X1 + (size_t)m * D) + F.lane;
#pragma unroll
            for (int j = 0; j < 4; ++j) { v[j] = v[j] * rstd * ((const f32x4*)P.ln1_g)[F.lane + 64 * j] + ((const f32x4*)P.ln1_b)[F.lane + 64 * j]; x1r[64 * j] = v[j]; s += (v[j].x + v[j].y) + (v[j].z + v[j].w); }
            mean = wave_sum(s) * (1.f / D); s2 = 0.f;
#pragma unroll
            for (int j = 0; j < 4; ++j) { v[j] = v[j] - mean; s2 += (v[j].x * v[j].x + v[j].y * v[j].y) + (v[j].z * v[j].z + v[j].w * v[j].w); }
            rstd = 1.f / sqrtf(wave_sum(s2) * (1.f / D) + LN_EPS);
            GAS unsigned long long* o8 = (GAS unsigned long long*)(U2 + (size_t)m * D) + F.lane;
#pragma unroll
            for (int j = 0; j < 4; ++j) { v[j] = v[j] * rstd * (md[4 * (D / 4) + 64 * j] + 1.f) + md[3 * (D / 4) + 64 * j];
                o8[64 * j] = (unsigned long long)pk2(v[j].x, v[j].y) | ((unsigned long long)pk2(v[j].z, v[j].w) << 32);
                LAS float* tp = T + lr * TS + 4 * F.lane + 256 * j; tp[0] = v[j].x; tp[1] = v[j].y; tp[2] = v[j].z; tp[3] = v[j].w; } }
        __syncthreads();
        { f32x4v acc[3]; acc[0] = (f32x4v){0.f, 0.f, 0.f, 0.f}; acc[1] = acc[0]; acc[2] = acc[0];
            const int ar = F.lane & 15, ak = F.lane >> 4; const LAS float* ta = T + ar * TS + 128 * F.wave + ak; const float* wb = WR + (size_t)(128 * F.wave + ak) * 48 + ar;
#pragma unroll 8
            for (int ks = 0; ks < 32; ++ks) { const float a = ta[4 * ks];
#pragma unroll
                for (int ct = 0; ct < 3; ++ct) acc[ct] = __builtin_amdgcn_mfma_f32_16x16x4f32(a, wb[(size_t)ks * 4 * 48 + 16 * ct], acc[ct], 0, 0, 0); }
#pragma unroll
            for (int ct = 0; ct < 3; ++ct)
#pragma unroll
                for (int rg = 0; rg < 4; ++rg) Pt[(F.wave * 16 + ak * 4 + rg) * 48 + 16 * ct + ar] = acc[ct][rg]; }
        __syncthreads();
        for (int o = F.tid; o < 16 * 36; o += NTHR) { const int row = o / 36, col = o % 36; float sm = 0.f;
#pragma unroll
            for (int w = 0; w < 8; ++w) sm += Pt[(w * 16 + row) * 48 + col];
            LG[row * 36 + col] = sm + (col < NG ? P.b_rg[col] : P.b_re[col - NG]); }
        __syncthreads();
        if (F.tid < 16) { const int m = 16 * u + F.tid; const LAS float* lg = LG + F.tid * 36;
            int gi = 0; float gmax = lg[0];
#pragma unroll
            for (int g = 1; g < NG; ++g) if (lg[g] > gmax) { gi = g; gmax = lg[g]; }
            float gs = 0.f;
#pragma unroll
            for (int g = 0; g < NG; ++g) gs += __expf(lg[g] - gmax);
            const float gtop = 1.f / gs; const LAS float* ev = lg + NG + gi * EPG;
            int e0 = 0; float v0 = ev[0];
#pragma unroll
            for (int e = 1; e < EPG; ++e) { const float t = ev[e]; if (t > v0) { e0 = e; v0 = t; } }
            int e1 = -1; float v1 = 0.f;
#pragma unroll
            for (int e = 0; e < EPG; ++e) { const float t = ev[e]; if (e != e0 && (e1 < 0 || t > v1)) { e1 = e; v1 = t; } }
            const float p1 = __expf(v1 - v0), w0 = 1.f / (1.f + p1), w1 = p1 / (1.f + p1);
            const int ge0 = gi * EPG + e0, ge1 = gi * EPG + e1;
            RI[m * 2 + 0] = ge0; RI[m * 2 + 1] = ge1; RW[m * 2 + 0] = gtop * w0; RW[m * 2 + 1] = gtop * w1;
            if (publish) { const unsigned p0 = atomicAdd(ecnt + 64 * ge0, 1u), p1i = atomicAdd(ecnt + 64 * ge1, 1u);
                list[(size_t)ge0 * M + p0] = (unsigned)m * 2u; list[(size_t)ge1 * M + p1i] = (unsigned)m * 2u + 1u; } }
        __syncthreads();
    }
}
__device__ __forceinline__ void moe_setup(Frame& F, const Ptrs& P, int nct) {
    LAS unsigned* toff = (LAS unsigned*)(F.lds + MOEOFF_OFF); LAS unsigned* cnts = toff + 40; LAS unsigned* toktab = (LAS unsigned*)(F.lds + TOKTAB_OFF);
    const unsigned* ecnt = (const unsigned*)(P.ws + WS_ECNT); const unsigned* list = (const unsigned*)(P.ws + WS_LIST);
    if (F.tid < NE) cnts[F.tid] = ecnt[64 * F.tid];
    __syncthreads();
    if (F.tid == 0) { unsigned a = 0; for (int e = 0; e < NE; ++e) { toff[e] = a; a += (cnts[e] + 255u) >> 8; } toff[NE] = a; }
    __syncthreads();
    const int total = (int)toff[NE] * nct;
    for (int i = 0; i < TOKTAB_UNITS; ++i) { const int L = i * F.G + F.vcu; if (L >= total) break;
        const int rt = L / nct; int e = 0; while ((int)toff[e + 1] <= rt) ++e;
        if (F.tid < 256) { const unsigned pos = 256u * (unsigned)(rt - (int)toff[e]) + (unsigned)F.tid; toktab[i * 256 + F.tid] = pos < cnts[e] ? list[(size_t)e * M + pos] : pg8::TOK_NONE; } }
    __syncthreads();
}
__device__ __forceinline__ void p9_final(Frame& F, const Ptrs& P) {
    const int gw = F.vcu * NWAVES + F.wave, NGW = F.G * NWAVES;
    const float* mod = (const float*)(P.ws + WS_MOD); const float* X1 = (const float*)(P.ws + WS_X1); const bf16* YS = (const bf16*)(P.ws + WS_YS);
    for (int m = gw; m < M; m += NGW) {
        const f32x4* md = (const f32x4*)(mod + (size_t)(m / S) * NMOD * D) + F.lane;
        const GAS f32x4* xr = (const GAS f32x4*)(X1 + (size_t)m * D) + F.lane;
        const GAS unsigned long long* y0 = (const GAS unsigned long long*)(YS + (size_t)m * 2 * D) + F.lane; const GAS unsigned long long* y1 = y0 + D / 4;
        f32x4 v[4]; float s = 0.f;
#pragma unroll
        for (int j = 0; j < 4; ++j) { const unsigned long long a = y0[64 * j], b = y1[64 * j];
            const f32x4 f = (f32x4){bflo((unsigned)a) + bflo((unsigned)b), bfhi((unsigned)a) + bfhi((unsigned)b), bflo((unsigned)(a >> 32)) + bflo((unsigned)(b >> 32)), bfhi((unsigned)(a >> 32)) + bfhi((unsigned)(b >> 32))};
            v[j] = xr[64 * j] * ALPHA + md[5 * (D / 4) + 64 * j] * f; s += (v[j].x + v[j].y) + (v[j].z + v[j].w); }
        const float mean = wave_sum(s) * (1.f / D); float s2 = 0.f;
#pragma unroll
        for (int j = 0; j < 4; ++j) { v[j] = v[j] - mean; s2 += (v[j].x * v[j].x + v[j].y * v[j].y) + (v[j].z * v[j].z + v[j].w * v[j].w); }
        const float rstd = 1.f / sqrtf(wave_sum(s2) * (1.f / D) + LN_EPS);
        GAS f32x4* orow = (GAS f32x4*)(P.out + (size_t)m * D) + F.lane;
#pragma unroll
        for (int j = 0; j < 4; ++j) orow[64 * j] = v[j] * rstd * ((const f32x4*)P.ln2_g)[F.lane + 64 * j] + ((const f32x4*)P.ln2_b)[F.lane + 64 * j];
    }
}

constexpr int N_PHASES = 10;
#ifndef PROBE_MASK
#define PROBE_MASK 0
#endif
#define NREP(k) (((PROBE_MASK) >> (k)) & 1 ? 2 : 1)
struct Args { Ptrs p; int ph_lo, ph_hi, li, pad; };
__global__ void __launch_bounds__(NTHR, 2) mk_fwd(Args args) {
    extern __shared__ __attribute__((aligned(16))) unsigned char lds[];
    Frame F;
    F.lds = (LAS unsigned char*)lds;
    F.MISC = (volatile LAS unsigned*)(F.lds + MISC_OFF);
    F.tid = threadIdx.x; F.lane = F.tid & 63; F.wave = __builtin_amdgcn_readfirstlane(F.tid >> 6);
    F.G = gridDim.x; { const int bx = blockIdx.x; F.vcu = (F.G % 8 == 0) ? (bx % 8) * (F.G / 8) + bx / 8 : bx; }
    const Ptrs& P = args.p;
    F.ctl = (gu32*)(P.ws + WS_CTL);
    for (int u = F.tid; u < (LDS_BYTES - LDSCTL_OFF) / 4; u += NTHR) ((LAS unsigned*)(F.lds + LDSCTL_OFF))[u] = 0u;
    __syncthreads();
    const int lo = args.ph_lo, hi = args.ph_hi;
    XcdBarrier bar; bar.bar = (unsigned*)(F.ctl + CW_BAR) + args.li * XCD_BAR_WORDS; bar.x = 0; bar.st = nullptr;
    if (hi - lo > 1) bar = xcd_barrier_post((unsigned*)(F.ctl + CW_BAR) + args.li * XCD_BAR_WORDS, F.MISC + 8);
#define IN(k) (lo <= (k) && (k) < hi)
#define BOTH(k) (IN(k) && IN((k) + 1))
#define SEAM(k) do { if (BOTH(k)) xcd_barrier(bar); } while (0)
#define TWICE(k, ...) do { if (NREP(k) > 1) { __VA_ARGS__ } __VA_ARGS__ } while (0)
    if (IN(0)) { TWICE(0, { p0_prologue(F, P); __syncthreads(); }); SEAM(0); }
    if (IN(1)) { TWICE(1, { p1_modulate(F, P); }); SEAM(1); }
    if (IN(2)) {
        TWICE(2, {
        pg8::Gemm g{(const pg8::bf16_t*)(P.ws + WS_U), (const pg8::bf16_t*)(P.ws + WS_WIN), M, NPROJ, D}; pg8::StaticOrder So; So.init(M, NPROJ, F.G, (int)blockIdx.x);
        pg8::EpiProj E{(pg8::bf16_t*)(P.ws + WS_XL), (size_t)(WS_YL - WS_XL) / 2, (float*)(P.ws + WS_KMSUM), QSCALE};
        pg8::gemm_phase<pg8::EpiProj, pg8::StaticOrder, PG8_ALIGN, PG8_SP2>(F.lds + RING_OFF, g, So, E); });
        SEAM(2);
    }
    if (IN(3)) {
        static_assert(attn_body::LDS_BYTES <= RING_BYTES && attn_body::DM == DA, "attention body geometry vs frame");
        TWICE(10, { p3_lru(F, P); });
        TWICE(11, {
        const attn_body::AttnTensors AT{(const attn_body::bf16*)(P.ws + WS_Q), (const attn_body::bf16*)(P.ws + WS_K), (const attn_body::bf16*)(P.ws + WS_V), (attn_body::bf16*)(P.ws + WS_AO),
                                        (const float*)(P.ws + WS_KMSUM), P.rel_bias, T5_BUCKET};
        const attn_body::StaticOrder So((int)F.G, F.vcu);
        attn_body::attn_phase<attn_body::StaticOrder>((char*)lds + RING_OFF, AT, So); });
        SEAM(3);
    }
    if (IN(4)) { TWICE(4, { p4_merge(F, P); }); SEAM(4); }
    if (IN(5)) {
        TWICE(5, {
        pg8::Gemm g{(const pg8::bf16_t*)(P.ws + WS_U), (const pg8::bf16_t*)(P.ws + WS_WO), M, D, D}; pg8::StaticOrder So; So.init(M, D, F.G, (int)blockIdx.x);
        pg8::EpiF32 E{(float*)(P.ws + WS_MIX), D};
        pg8::gemm_phase<pg8::EpiF32, pg8::StaticOrder, PG8_ALIGN, PG8_SP2>(F.lds + RING_OFF, g, So, E); });
        SEAM(5);
    }
    if (IN(6)) { if (NREP(6) > 1) p6_post(F, P, false); p6_post(F, P, true); SEAM(6); }
    if (IN(7)) {
        TWICE(7, {
        moe_setup(F, P, 2);
        const LAS unsigned* toktab = (const LAS unsigned*)(F.lds + TOKTAB_OFF);
        pg8::Gemm g{(const pg8::bf16_t*)(P.ws + WS_U), (const pg8::bf16_t*)(P.ws + WS_W13), 0, 0, D}; const pg8::MoeOrder So{(const LAS unsigned*)(F.lds + MOEOFF_OFF), 2, F.G, F.vcu};
        pg8::EpiMoeUp E{(pg8::bf16_t*)(P.ws + WS_HDN), (const float*)(P.ws + WS_RW), toktab};
        pg8::gemm_phase_g<pg8::EpiMoeUp, pg8::MoeOrder, true>(F.lds + RING_OFF, g, So, E, toktab); });
        SEAM(7);
    }
    if (IN(8)) {
        TWICE(8, {
        moe_setup(F, P, 4);
        const LAS unsigned* toktab = (const LAS unsigned*)(F.lds + TOKTAB_OFF);
        pg8::Gemm g{(const pg8::bf16_t*)(P.ws + WS_HDN), (const pg8::bf16_t*)(P.ws + WS_W2), 0, 0, DE}; const pg8::MoeOrder So{(const LAS unsigned*)(F.lds + MOEOFF_OFF), 4, F.G, F.vcu};
        pg8::EpiMoeDown E{(pg8::bf16_t*)(P.ws + WS_YS), (pg8::bf16_t*)(P.ws + WS_DUMP), toktab};
        pg8::gemm_phase_g<pg8::EpiMoeDown, pg8::MoeOrder, false>(F.lds + RING_OFF, g, So, E, toktab); });
        SEAM(8);
    }
    if (IN(9)) { TWICE(9, { p9_final(F, P); }); }
#undef TWICE
#undef IN
#undef BOTH
#undef SEAM
}

extern "C" void kernel_launch(void* const* d_in, const int* in_sizes, int n_in, void* d_out, int out_size, void* d_ws, size_t ws_size, hipStream_t stream) {
    static int grid = 0;
    if (grid == 0) {
        if (n_in != 27 || in_sizes[0] != M * D || out_size != M * D || ws_size < WS_END) { fprintf(stderr, "kernel_launch: unexpected shapes / workspace (n_in %d, ws %zu)\n", n_in, ws_size); grid = -1; return; }
        int dev = 0, cus = 0, per_cu = 0;
        if (hipGetDevice(&dev) != hipSuccess || hipDeviceGetAttribute(&cus, hipDeviceAttributeMultiprocessorCount, dev) != hipSuccess) { grid = -1; return; }
        if (hipFuncSetAttribute((const void*)mk_fwd, hipFuncAttributeMaxDynamicSharedMemorySize, LDS_BYTES) != hipSuccess) { fprintf(stderr, "kernel_launch: hipFuncSetAttribute failed\n"); grid = -1; return; }
        if (hipOccupancyMaxActiveBlocksPerMultiprocessor(&per_cu, (const void*)mk_fwd, NTHR, LDS_BYTES) != hipSuccess || per_cu < 1) fprintf(stderr, "kernel_launch: occupancy query reports %d\n", per_cu);
        (void)hipGetLastError();
        grid = cus;
    }
    if (grid < 0) return;
    unsigned char* ws = (unsigned char*)d_ws;
    (void)hipMemsetAsync(ws + WS_CTL, 0, CTL_ZERO_BYTES, stream);
    Args a{};
    const float** pp = (const float**)&a.p;
    for (int i = 0; i < 27; ++i) pp[i] = (const float*)d_in[i];
    a.p.out = (float*)d_out; a.p.ws = ws;
    auto run = [&](int lo, int hi, int li) { a.ph_lo = lo; a.ph_hi = hi; a.li = li; hipLaunchKernelGGL(mk_fwd, dim3(grid), dim3(NTHR), LDS_BYTES, stream, a); };
    run(0, N_PHASES, 0);
}
```

```cpp
#include <hip/hip_runtime.h>
#include <cstdio>
#include <cstdint>

namespace pg8 {
#define PG8_LAS __attribute__((address_space(3)))
typedef unsigned short bf16_t;
typedef short bf16x8 __attribute__((ext_vector_type(8)));
typedef float f32x4 __attribute__((ext_vector_type(4)));
typedef unsigned u32x4 __attribute__((ext_vector_type(4)));
constexpr int BM = 256, BK = 64, HALF = 128, HTB = HALF * BK * 2  , STAGE_BYTES = 8 * HTB, NXCD = 8, WGM = 8;

__host__ __device__ __forceinline__ int lds_byte(int r, int c) { const int st = (r >> 4) * 2 + (c >> 5), rr = r & 15, cc = c & 31, ob = rr * 64 + cc * 2; return st * 1024 + (ob ^ (((ob >> 9) & 1) << 5)); }
__host__ __device__ __forceinline__ void stage_rc(int b, int& R, int& C) { const int st = b / 1024, sb = b % 1024, swz = sb ^ (((sb >> 9) & 1) << 5); R = (st >> 1) * 16 + swz / 64; C = (st & 1) * 32 + (swz % 64) / 2; }
__host__ __device__ __forceinline__ int perm32(int rho) { const int n = rho >> 4, i = rho & 15; return 8 * (i >> 2) + 4 * n + (i & 3); }

struct Unit { int pm, pn; };
struct Gemm { const bf16_t* A; const bf16_t* Bt; int M, N, K; };

struct StaticOrder {
    int nM, nN, nwg, G, c;
    __host__ __device__ void init(int M, int N, int G_, int c_) { nM = M / BM; nN = N / BM; nwg = nM * nN; G = G_; c = c_; }
    __host__ __device__ bool next(int i, Unit& u) const {
        const long L = (long)i * G + c; if (L >= nwg) return false;
        int wgid = (int)L; { const int q = nwg / NXCD, r = nwg % NXCD, xcd = wgid % NXCD, off = wgid / NXCD; wgid = (xcd < r ? xcd * (q + 1) : r * (q + 1) + (xcd - r) * q) + off; }
        const int nig = WGM * nN, gid = wgid / nig, fm = gid * WGM, gsz = (nM - fm) < WGM ? (nM - fm) : WGM;
        u.pm = fm + ((wgid % nig) % gsz); u.pn = (wgid % nig) / gsz; return true;
    }
    __device__ __forceinline__ void a_ready(const Unit&) const {}
    __device__ __forceinline__ void done(const Unit&) const {}
};

__device__ __forceinline__ unsigned cvt_pk_bf16(float lo, float hi) { unsigned r; asm volatile("v_cvt_pk_bf16_f32 %0, %1, %2" : "=v"(r) : "v"(lo), "v"(hi)); return r; }
typedef float f32x2 __attribute__((ext_vector_type(2)));
__device__ __forceinline__ f32x2 gelu_pk(f32x2 v) {
    const f32x2 av = __builtin_elementwise_abs(v), d = av * 0.2316418882f + 1.0f;
    f32x2 t; t.x = __builtin_amdgcn_rcpf(d.x); t.y = __builtin_amdgcn_rcpf(d.y);
    f32x2 q = t * 0.5307027145f + (-0.7265760135f); q = q * t + 0.7107068705f; q = q * t + (-0.142248368f); q = q * t + 0.127414796f; q = q * t;
    const f32x2 s = (v * v) * (-0.72134752044f);
    f32x2 e; e.x = __builtin_amdgcn_exp2f(s.x); e.y = __builtin_amdgcn_exp2f(s.y);
    const f32x2 m = v * (q * e), r = v - m;
    f32x2 o; o.x = v.x < 0.f ? m.x : r.x; o.y = v.y < 0.f ? m.y : r.y; return o;
}

template <int ACT  > struct EpiBf16 {
    static constexpr bool PERM = true, AFTER_DRAIN = false; static_assert(ACT == 0 || ACT == 1, "EpiBf16: ACT is 0 (none) or 1 (gelu_pk)");
    bf16_t* O; int ldc; const float* bias; int split_cols; size_t split_stride; float scale0;
    __device__ __forceinline__ void operator()(const f32x4 (&acc)[2][2][4][2], const Unit& u, int wr, int wc, int fr, int fq) const {
        const int row0 = u.pm * BM + wr * 64 + fr; int colt = u.pn * BM; bf16_t* base = O;
        float sc = 1.f; if (split_cols) { const int t = colt / split_cols; base += (size_t)t * split_stride; colt -= t * split_cols; if (t == 0) sc = scale0; }
        const int col0 = colt + wc * 32 + 8 * fq, bcol0 = u.pn * BM + wc * 32 + 8 * fq;
        f32x4 bv[2][2];
#pragma unroll
        for (int bj = 0; bj < 2; ++bj)
#pragma unroll
            for (int n = 0; n < 2; ++n) bv[bj][n] = bias ? *(const f32x4*)(bias + bcol0 + bj * HALF + 4 * n) : (f32x4){0.f, 0.f, 0.f, 0.f};
#pragma unroll
        for (int ai = 0; ai < 2; ++ai)
#pragma unroll
            for (int m = 0; m < 4; ++m) { bf16_t* rowp = base + (size_t)(row0 + ai * HALF + m * 16) * ldc + col0;
#pragma unroll
                for (int bj = 0; bj < 2; ++bj) { f32x4 v0 = acc[ai][bj][m][0] + bv[bj][0], v1 = acc[ai][bj][m][1] + bv[bj][1];
                    if (ACT == 1) { f32x2 a = gelu_pk((f32x2){v0[0], v0[1]}), b = gelu_pk((f32x2){v0[2], v0[3]}), c = gelu_pk((f32x2){v1[0], v1[1]}), d = gelu_pk((f32x2){v1[2], v1[3]});
                        v0 = (f32x4){a.x, a.y, b.x, b.y}; v1 = (f32x4){c.x, c.y, d.x, d.y}; }
                    v0 = v0 * sc; v1 = v1 * sc; u32x4 w; w.x = cvt_pk_bf16(v0[0], v0[1]); w.y = cvt_pk_bf16(v0[2], v0[3]); w.z = cvt_pk_bf16(v1[0], v1[1]); w.w = cvt_pk_bf16(v1[2], v1[3]);
                    *(u32x4*)(rowp + bj * HALF) = w; } }
    }
};

struct PanelStats {
    unsigned* xbuf;
    unsigned* cnt;
    unsigned* tmo;
    int ntn; float eps;
    unsigned code;
    __device__ __forceinline__ bool run(const f32x4 (&v)[2][2][4][2], const Unit& u, int wr, int wc, int fr, int fq, PG8_LAS unsigned char* lds, int wid, int lane) const {
        typedef float f32x2v __attribute__((ext_vector_type(2)));
        PG8_LAS f32x2v* P = (PG8_LAS f32x2v*)lds;
        PG8_LAS f32x2v* S = (PG8_LAS f32x2v*)(lds + 8192);
        PG8_LAS unsigned* flag = (PG8_LAS unsigned*)(lds + 8192 + 2048);
#pragma unroll
        for (int ai = 0; ai < 2; ++ai)
#pragma unroll
            for (int m = 0; m < 4; ++m) {
                float s = 0.f;
#pragma unroll
                for (int bj = 0; bj < 2; ++bj)
#pragma unroll
                    for (int n = 0; n < 2; ++n) { const f32x4 x = v[ai][bj][m][n]; s += (x[0] + x[1]) + (x[2] + x[3]); }
                s += __shfl_xor(s, 16); s += __shfl_xor(s, 32);
                const float mw = s * (1.0f / 64.0f); float q = 0.f;
#pragma unroll
                for (int bj = 0; bj < 2; ++bj)
#pragma unroll
                    for (int n = 0; n < 2; ++n) { const f32x4 d = v[ai][bj][m][n] - mw; q += (d[0] * d[0] + d[1] * d[1]) + (d[2] * d[2] + d[3] * d[3]); }
                q += __shfl_xor(q, 16); q += __shfl_xor(q, 32);
                if (fq == 0) P[(ai * HALF + wr * 64 + m * 16 + fr) * 4 + wc] = (f32x2v){mw, q};
            }
        asm volatile("s_waitcnt lgkmcnt(0)" ::: "memory"); __builtin_amdgcn_s_barrier(); asm volatile("" ::: "memory");
#if defined(BROKEN_EXCHANGE_NO_WAIT)
#warning BROKEN CONTROL BUILD: the row-statistics exchange does not wait; results are wrong by design
        if (blockIdx.x >= 64) { const long long t0_ = clock64(); while (clock64() - t0_ < 60000) __builtin_amdgcn_s_sleep(8); }
#endif
        const int row = wid * 32 + (lane & 31);
        if (lane < 32) {
            const f32x2v a = P[row * 4 + 0], b = P[row * 4 + 1], c = P[row * 4 + 2], d = P[row * 4 + 3];
            const float mt = (a.x + b.x + c.x + d.x) * 0.25f;
            const float da = a.x - mt, db = b.x - mt, dc = c.x - mt, dd = d.x - mt;
            const float m2 = (a.y + b.y) + (c.y + d.y) + 64.0f * ((da * da + db * db) + (dc * dc + dd * dd));
            unsigned long long* slot = (unsigned long long*)xbuf + ((size_t)(u.pm * BM + row) * 4 + u.pn);
            __hip_atomic_store(slot, ((unsigned long long)__float_as_uint(m2) << 32) | __float_as_uint(mt), __ATOMIC_RELAXED, __HIP_MEMORY_SCOPE_AGENT);
        }
        asm volatile("s_waitcnt vmcnt(0)" ::: "memory");
        if (lane == 0) __hip_atomic_fetch_add(cnt + 64 * u.pm, 1u, __ATOMIC_RELAXED, __HIP_MEMORY_SCOPE_AGENT);
        if (wid == 0) {
            bool dead = false; const unsigned long long t0 = __builtin_amdgcn_s_memrealtime(); const unsigned want = 8u * (unsigned)ntn;
            for (;;) {
#if defined(BROKEN_EXCHANGE_NO_WAIT)
                break;
#endif
                if ((unsigned)__builtin_amdgcn_readfirstlane(__hip_atomic_load(cnt + 64 * u.pm, __ATOMIC_RELAXED, __HIP_MEMORY_SCOPE_AGENT)) >= want) break;
                if (__builtin_amdgcn_s_memrealtime() - t0 > 2000000ull) {
                    if (lane == 0) { unsigned expect = 0u; __hip_atomic_compare_exchange_strong(tmo + 1, &expect, code | (unsigned)(u.pm & 0xff), __ATOMIC_RELAXED, __ATOMIC_RELAXED, __HIP_MEMORY_SCOPE_AGENT);
                                     __hip_atomic_store(tmo, 1u, __ATOMIC_RELAXED, __HIP_MEMORY_SCOPE_AGENT); }
                    dead = true; break; }
                __builtin_amdgcn_s_sleep(2);
            }
            __builtin_amdgcn_fence(__ATOMIC_ACQUIRE, "agent");
            if (lane == 0) flag[0] = dead ? 1u : 0u;
        }
        asm volatile("s_waitcnt vmcnt(0) lgkmcnt(0)" ::: "memory"); __builtin_amdgcn_s_barrier(); asm volatile("" ::: "memory");
        const bool bad = flag[0] != 0u;
        if (lane < 32) {
            const unsigned long long* slot = (const unsigned long long*)xbuf + (size_t)(u.pm * BM + row) * 4; float mt[4], m2[4]; float ms = 0.f;
#pragma unroll
            for (int t = 0; t < 4; ++t) { if (t < ntn) { const unsigned long long w = __hip_atomic_load(slot + t, __ATOMIC_RELAXED, __HIP_MEMORY_SCOPE_AGENT); mt[t] = __uint_as_float((unsigned)w); m2[t] = __uint_as_float((unsigned)(w >> 32)); } else { mt[t] = 0.f; m2[t] = 0.f; } ms += mt[t]; }
            const float mean = ms / (float)ntn; float q = 0.f;
#pragma unroll
            for (int t = 0; t < 4; ++t) if (t < ntn) { const float dm = mt[t] - mean; q += m2[t] + 256.0f * dm * dm; }
            S[row] = (f32x2v){mean, 1.0f / sqrtf(q / (256.0f * (float)ntn) + eps)};
        }
        asm volatile("s_waitcnt lgkmcnt(0)" ::: "memory"); __builtin_amdgcn_s_barrier(); asm volatile("" ::: "memory");
        return bad;
    }
};
struct EpiLnRes {
    static constexpr bool PERM = false, AFTER_DRAIN = true;
    const float* base; float* out; int ldc; const float* bias; PanelStats st; unsigned poison;
    __device__ __forceinline__ void fused(f32x4 (&acc)[2][2][4][2], const Unit& u, int wr, int wc, int fr, int fq, PG8_LAS unsigned char* lds, int wid, int lane) const {
        typedef float f32x2v __attribute__((ext_vector_type(2)));
        const PG8_LAS f32x2v* S = (const PG8_LAS f32x2v*)(lds + 8192);
        const int col0 = u.pn * BM + wc * 32 + 4 * fq;
#pragma unroll
        for (int bj = 0; bj < 2; ++bj)
#pragma unroll
            for (int n = 0; n < 2; ++n) { const f32x4 bv = bias ? *(const f32x4*)(bias + col0 + bj * HALF + n * 16) : (f32x4){0.f, 0.f, 0.f, 0.f};
#pragma unroll
                for (int ai = 0; ai < 2; ++ai)
#pragma unroll
                    for (int m = 0; m < 4; ++m) acc[ai][bj][m][n] += bv; }
        f32x4 pre[4][2][2];
#pragma unroll
        for (int m = 0; m < 4; ++m) { const size_t off = (size_t)(u.pm * BM + wr * 64 + m * 16 + fr) * ldc + col0;
#pragma unroll
            for (int bj = 0; bj < 2; ++bj)
#pragma unroll
                for (int n = 0; n < 2; ++n) pre[m][bj][n] = *(const f32x4*)(base + off + bj * HALF + n * 16); }
        const bool bad = st.run(acc, u, wr, wc, fr, fq, lds, wid, lane) || poison != 0u;
        const float qnan = __builtin_nanf("");
#pragma unroll
        for (int ai = 0; ai < 2; ++ai)
#pragma unroll
            for (int m = 0; m < 4; ++m) { const int r = ai * HALF + wr * 64 + m * 16 + fr; const f32x2v sr = S[r]; const size_t off = (size_t)(u.pm * BM + r) * ldc + col0;
#pragma unroll
                for (int bj = 0; bj < 2; ++bj)
#pragma unroll
                    for (int n = 0; n < 2; ++n) { const f32x4 bs = ai == 0 ? pre[m][bj][n] : *(const f32x4*)(base + off + bj * HALF + n * 16); f32x4 o = bs + (acc[ai][bj][m][n] - sr.x) * sr.y;
                        if (bad) o = (f32x4){qnan, qnan, qnan, qnan}; *(f32x4*)(out + off + bj * HALF + n * 16) = o; }
                if (m & 1) asm volatile("" ::: "memory"); }
    }
};
struct EpiLnResLn {
    static constexpr bool PERM = false, AFTER_DRAIN = true;
    const float* base; float* out; bf16_t* xn; int ldc; const float* bias; PanelStats st1, st2; unsigned poison;
    __device__ __forceinline__ void fused(f32x4 (&acc)[2][2][4][2], const Unit& u, int wr, int wc, int fr, int fq, PG8_LAS unsigned char* lds, int wid, int lane) const {
        typedef float f32x2v __attribute__((ext_vector_type(2))); typedef unsigned u32x2v __attribute__((ext_vector_type(2)));
        const PG8_LAS f32x2v* S = (const PG8_LAS f32x2v*)(lds + 8192);
        const int col0 = u.pn * BM + wc * 32 + 4 * fq;
#pragma unroll
        for (int bj = 0; bj < 2; ++bj)
#pragma unroll
            for (int n = 0; n < 2; ++n) { const f32x4 bv = bias ? *(const f32x4*)(bias + col0 + bj * HALF + n * 16) : (f32x4){0.f, 0.f, 0.f, 0.f};
#pragma unroll
                for (int ai = 0; ai < 2; ++ai)
#pragma unroll
                    for (int m = 0; m < 4; ++m) acc[ai][bj][m][n] += bv; }
        bool bad = st1.run(acc, u, wr, wc, fr, fq, lds, wid, lane) || poison != 0u;
        const float qnan = __builtin_nanf("");
#pragma unroll
        for (int ai = 0; ai < 2; ++ai)
#pragma unroll
            for (int m = 0; m < 4; ++m) { const int r = ai * HALF + wr * 64 + m * 16 + fr; const f32x2v sr = S[r]; const size_t off = (size_t)(u.pm * BM + r) * ldc + col0;
#pragma unroll
                for (int bj = 0; bj < 2; ++bj)
#pragma unroll
                    for (int n = 0; n < 2; ++n) { const f32x4 bs = *(const f32x4*)(base + off + bj * HALF + n * 16); acc[ai][bj][m][n] = bs + (acc[ai][bj][m][n] - sr.x) * sr.y; }
                asm volatile("" : "+v"(acc[ai][0][m][0]), "+v"(acc[ai][0][m][1]), "+v"(acc[ai][1][m][0]), "+v"(acc[ai][1][m][1]));
                if (m & 1) asm volatile("" ::: "memory"); }
        const bool bad1 = bad;
        bad = st2.run(acc, u, wr, wc, fr, fq, lds, wid, lane) || bad;
#pragma unroll
        for (int ai = 0; ai < 2; ++ai)
#pragma unroll
            for (int m = 0; m < 4; ++m) { const int r = ai * HALF + wr * 64 + m * 16 + fr; const f32x2v sr = S[r]; const size_t off = (size_t)(u.pm * BM + r) * ldc + col0;
#pragma unroll
                for (int bj = 0; bj < 2; ++bj)
#pragma unroll
                    for (int n = 0; n < 2; ++n) { const f32x4 x1 = acc[ai][bj][m][n]; *(f32x4*)(out + off + bj * HALF + n * 16) = bad1 ? (f32x4){qnan, qnan, qnan, qnan} : x1;
                        const f32x4 o = (x1 - sr.x) * sr.y; u32x2v w; w.x = cvt_pk_bf16(o[0], o[1]); w.y = cvt_pk_bf16(o[2], o[3]);
                        if (bad) { w.x = 0x7fc07fc0u; w.y = 0x7fc07fc0u; } *(u32x2v*)(xn + off + bj * HALF + n * 16) = w; }
                asm volatile("" ::: "memory"); }
    }
};

template <class Epi, class Sched, bool ALIGN_EPI = false, bool SP2 = false>
__device__ __forceinline__ void gemm_phase(PG8_LAS unsigned char* lds, const Gemm g, const Sched& S, const Epi& E) {
    const int tid = threadIdx.x, wid = __builtin_amdgcn_readfirstlane(tid >> 6), lane = tid & 63, wr = wid >> 2, wc = wid & 3, fr = lane & 15, fq = lane >> 4;
    const int K = g.K, nt = K / BK;
    unsigned voffA[2], voffB[2];
#pragma unroll
    for (int i = 0; i < 2; ++i) { int R, C; stage_rc(tid * 16 + i * 8192, R, C); const int Rb = Epi::PERM ? ((R & ~31) + perm32(R & 31)) : R;
        voffA[i] = (unsigned)(R * K + C) * 2u; voffB[i] = (unsigned)(Rb * K + C) * 2u; }
    const size_t kstep = (size_t)(BK * 2);
    const size_t hstep = (size_t)HALF * K * 2;
    const size_t tstep = 2 * hstep;
    const unsigned ldsw = (unsigned)wid * 1024u;
    const int aoff = lds_byte(wr * 64 + fr, fq * 8), boff = lds_byte(wc * 32 + fr, fq * 8);
#define PG8_SA(b, h) (((b) * 2 + (h)) * HTB)
#define PG8_SB(b, h) ((4 + (b) * 2 + (h)) * HTB)
#define PG8_STAGE(bufoff, gbase, voff) do { _Pragma("unroll") for (int _i = 0; _i < 2; ++_i) \
        __builtin_amdgcn_global_load_lds((const unsigned*)((const char*)(gbase) + (voff)[_i]), (PG8_LAS unsigned*)(lds + (bufoff) + ldsw + _i * 8192), 16, 0, 0); } while (0)
#define PG8_LDA(dst, b, h) do { _Pragma("unroll") for (int m = 0; m < 4; ++m) _Pragma("unroll") for (int k = 0; k < 2; ++k) dst[m][k] = *(const PG8_LAS bf16x8*)(lds + PG8_SA(b, h) + aoff + m * 2048 + k * 1024); } while (0)
#define PG8_LDB(dst, b, h) do { _Pragma("unroll") for (int n = 0; n < 2; ++n) _Pragma("unroll") for (int k = 0; k < 2; ++k) dst[n][k] = *(const PG8_LAS bf16x8*)(lds + PG8_SB(b, h) + boff + n * 2048 + k * 1024); } while (0)
#define PG8_MMA(ai, bj, At, Bt) do { __builtin_amdgcn_s_setprio(1); _Pragma("unroll") for (int m = 0; m < 4; ++m) _Pragma("unroll") for (int n = 0; n < 2; ++n) _Pragma("unroll") for (int k = 0; k < 2; ++k) \
        acc[ai][bj][m][n] = __builtin_amdgcn_mfma_f32_16x16x32_bf16(Bt[n][k], At[m][k], acc[ai][bj][m][n], 0, 0, 0); __builtin_amdgcn_s_setprio(0); } while (0)
#define PG8_WAIT_V(n) asm volatile("s_waitcnt vmcnt(" #n ")" ::: "memory")
#define PG8_WAIT_L(n) asm volatile("s_waitcnt lgkmcnt(" #n ")" ::: "memory")
#define PG8_BAR __builtin_amdgcn_s_barrier()
#define PG8_SCHED __builtin_amdgcn_sched_barrier(0)
    Unit cur, nxt; int ui = 0;
    if (!S.next(0, cur)) return;
    f32x4 acc[2][2][4][2];
#pragma unroll
    for (int a = 0; a < 2; ++a)
#pragma unroll
        for (int b = 0; b < 2; ++b)
#pragma unroll
            for (int m = 0; m < 4; ++m)
#pragma unroll
                for (int n = 0; n < 2; ++n) acc[a][b][m][n] = (f32x4){0.f, 0.f, 0.f, 0.f};
    bf16x8 At[4][2], B0[2][2], B1[2][2];
    const char* cA = (const char*)g.A + (size_t)cur.pm * tstep; const char* cB = (const char*)g.Bt + (size_t)cur.pn * tstep;
    S.a_ready(cur);
    if constexpr (SP2) {
        PG8_STAGE(PG8_SB(0, 0), cB, voffB); PG8_STAGE(PG8_SB(0, 1), cB + hstep, voffB); PG8_STAGE(PG8_SA(0, 0), cA, voffA); PG8_STAGE(PG8_SA(0, 1), cA + hstep, voffA);
        if (wr == 1) PG8_BAR;
        PG8_WAIT_V(2); PG8_BAR;
        PG8_STAGE(PG8_SB(1, 0), cB + kstep, voffB); PG8_STAGE(PG8_SA(1, 0), cA + kstep, voffA); PG8_STAGE(PG8_SB(1, 1), cB + hstep + kstep, voffB);
        PG8_WAIT_V(6); PG8_BAR;
    } else {
        PG8_STAGE(PG8_SB(0, 0), cB, voffB); PG8_STAGE(PG8_SA(0, 0), cA, voffA); PG8_STAGE(PG8_SB(0, 1), cB + hstep, voffB); PG8_STAGE(PG8_SA(0, 1), cA + hstep, voffA);
        if (wr == 1) PG8_BAR;
        PG8_WAIT_V(4); PG8_BAR;
        PG8_STAGE(PG8_SB(1, 0), cB + kstep, voffB); PG8_STAGE(PG8_SA(1, 0), cA + kstep, voffA); PG8_STAGE(PG8_SB(1, 1), cB + hstep + kstep, voffB);
        PG8_WAIT_V(6); PG8_BAR;
    }
    for (;;) {
        const bool has_next = S.next(ui + 1, nxt);
        const char* nA = has_next ? (const char*)g.A + (size_t)nxt.pm * tstep : cA; const char* nB = has_next ? (const char*)g.Bt + (size_t)nxt.pn * tstep : cB;
        for (int t = 0; t < nt; t += 2) {
            const bool last = (t == nt - 2);
            const char* a1 = cA + (size_t)(t + 1) * kstep;
            const char* a2 = last ? nA : cA + (size_t)(t + 2) * kstep; const char* b2 = last ? nB : cB + (size_t)(t + 2) * kstep;
            const char* a3 = a2 + kstep; const char* b3 = b2 + kstep;
            if (last && has_next) S.a_ready(nxt);
            if constexpr (SP2) {
            PG8_LDB(B0, 0, 0); PG8_LDB(B1, 0, 1); PG8_SCHED; PG8_LDA(At, 0, 0); PG8_STAGE(PG8_SA(1, 1), a1 + hstep, voffA);
            PG8_WAIT_V(8); PG8_WAIT_L(0); PG8_BAR; PG8_MMA(0, 0, At, B0); PG8_MMA(0, 1, At, B1); PG8_BAR; PG8_SCHED;
            PG8_LDA(At, 0, 1); PG8_STAGE(PG8_SB(0, 0), b2, voffB); PG8_STAGE(PG8_SB(0, 1), b2 + hstep, voffB); PG8_STAGE(PG8_SA(0, 0), a2, voffA);
            PG8_WAIT_V(8); PG8_WAIT_L(0); PG8_BAR; PG8_MMA(1, 0, At, B0); PG8_MMA(1, 1, At, B1); PG8_BAR; PG8_SCHED;
            PG8_LDB(B0, 1, 0); PG8_LDB(B1, 1, 1); PG8_SCHED; PG8_LDA(At, 1, 0); PG8_STAGE(PG8_SA(0, 1), a2 + hstep, voffA);
            PG8_WAIT_V(8); PG8_WAIT_L(0); PG8_BAR; PG8_MMA(0, 0, At, B0); PG8_MMA(0, 1, At, B1); PG8_BAR; PG8_SCHED;
            PG8_LDA(At, 1, 1); PG8_STAGE(PG8_SB(1, 0), b3, voffB); PG8_STAGE(PG8_SB(1, 1), b3 + hstep, voffB); PG8_STAGE(PG8_SA(1, 0), a3, voffA);
            PG8_WAIT_V(8); PG8_WAIT_L(0); PG8_BAR; PG8_MMA(1, 0, At, B0); PG8_MMA(1, 1, At, B1); PG8_BAR; PG8_SCHED;
            } else {
            PG8_LDB(B0, 0, 0); PG8_SCHED; PG8_LDA(At, 0, 0); PG8_STAGE(PG8_SA(1, 1), a1 + hstep, voffA);
            PG8_WAIT_L(8); PG8_BAR; PG8_WAIT_L(0); PG8_MMA(0, 0, At, B0); PG8_BAR; PG8_SCHED;
            PG8_LDB(B1, 0, 1); PG8_STAGE(PG8_SB(0, 0), b2, voffB);
            PG8_BAR; PG8_WAIT_L(0); PG8_MMA(0, 1, At, B1); PG8_BAR;
            PG8_LDA(At, 0, 1); PG8_STAGE(PG8_SA(0, 0), a2, voffA);
            PG8_BAR; PG8_WAIT_L(0); PG8_MMA(1, 0, At, B0); PG8_BAR; PG8_SCHED;
            PG8_STAGE(PG8_SB(0, 1), b2 + hstep, voffB);
            PG8_WAIT_V(6); PG8_BAR; PG8_MMA(1, 1, At, B1); PG8_BAR;
            PG8_LDB(B0, 1, 0); PG8_SCHED; PG8_LDA(At, 1, 0); PG8_STAGE(PG8_SA(0, 1), a2 + hstep, voffA);
            PG8_WAIT_L(8); PG8_BAR; PG8_WAIT_L(0); PG8_MMA(0, 0, At, B0); PG8_BAR; PG8_SCHED;
            PG8_LDB(B1, 1, 1); PG8_STAGE(PG8_SB(1, 0), b3, voffB);
            PG8_BAR; PG8_WAIT_L(0); PG8_MMA(0, 1, At, B1); PG8_BAR;
            PG8_LDA(At, 1, 1); PG8_STAGE(PG8_SA(1, 0), a3, voffA);
            PG8_BAR; PG8_WAIT_L(0); PG8_MMA(1, 0, At, B0); PG8_BAR; PG8_SCHED;
            PG8_STAGE(PG8_SB(1, 1), b3 + hstep, voffB);
            PG8_WAIT_V(6); PG8_BAR; PG8_MMA(1, 1, At, B1); PG8_BAR;
            }
        }
        if constexpr (ALIGN_EPI) { if (wr == 0) PG8_BAR; }
        if constexpr (!Epi::AFTER_DRAIN) { E(acc, cur, wr, wc, fr, fq); S.done(cur); }
        if (!has_next) break;
#pragma unroll
        for (int a = 0; a < 2; ++a)
#pragma unroll
            for (int b = 0; b < 2; ++b)
#pragma unroll
                for (int m = 0; m < 4; ++m)
#pragma unroll
                    for (int n = 0; n < 2; ++n) acc[a][b][m][n] = (f32x4){0.f, 0.f, 0.f, 0.f};
        cur = nxt; cA = nA; cB = nB; ++ui;
        if constexpr (ALIGN_EPI) { if (wr == 1) PG8_BAR; }
    }
    PG8_WAIT_V(0);
    if constexpr (!ALIGN_EPI) { if (wr == 0) PG8_BAR; }
    PG8_BAR;
    if constexpr (Epi::AFTER_DRAIN) { E.fused(acc, cur, wr, wc, fr, fq, lds, wid, lane); S.done(cur); }
#undef PG8_SA
#undef PG8_SB
#undef PG8_STAGE
#undef PG8_LDA
#undef PG8_LDB
#undef PG8_MMA
#undef PG8_WAIT_V
#undef PG8_WAIT_L
#undef PG8_BAR
#undef PG8_SCHED
}
}

#ifndef PG8_SP2
#define PG8_SP2 true
#endif
#ifndef PG8_ALIGN
#define PG8_ALIGN true
#endif

namespace pg8 {
struct EpiProj {
    static constexpr bool PERM = true, AFTER_DRAIN = false;
    bf16_t* O; size_t stride; float* kmsum; float qscale;
    __device__ __forceinline__ void operator()(const f32x4 (&acc)[2][2][4][2], const Unit& u, int wr, int wc, int fr, int fq) const {
        const int t = u.pn >> 1, colt = (u.pn & 1) * BM;
        const int row0 = u.pm * BM + wr * 64 + fr, col0 = colt + wc * 32 + 8 * fq;
        bf16_t* base = O + (size_t)t * stride; const float sc = (t == 2) ? qscale : 1.f;
#pragma unroll
        for (int ai = 0; ai < 2; ++ai)
#pragma unroll
            for (int m = 0; m < 4; ++m) { bf16_t* rowp = base + (size_t)(row0 + ai * HALF + m * 16) * 512 + col0;
#pragma unroll
                for (int bj = 0; bj < 2; ++bj) { const f32x4 v0 = acc[ai][bj][m][0] * sc, v1 = acc[ai][bj][m][1] * sc;
                    u32x4 w; w.x = cvt_pk_bf16(v0[0], v0[1]); w.y = cvt_pk_bf16(v0[2], v0[3]); w.z = cvt_pk_bf16(v1[0], v1[1]); w.w = cvt_pk_bf16(v1[2], v1[3]);
                    *(u32x4*)(rowp + bj * HALF) = w; } }
        if (t == 3) {
#pragma unroll
            for (int bj = 0; bj < 2; ++bj)
#pragma unroll
                for (int n = 0; n < 2; ++n) { f32x4 s = (f32x4){0.f, 0.f, 0.f, 0.f};
#pragma unroll
                    for (int ai = 0; ai < 2; ++ai)
#pragma unroll
                        for (int m = 0; m < 4; ++m) s += acc[ai][bj][m][n];
#pragma unroll
                    for (int o = 1; o < 16; o <<= 1) { s[0] += __shfl_xor(s[0], o); s[1] += __shfl_xor(s[1], o); s[2] += __shfl_xor(s[2], o); s[3] += __shfl_xor(s[3], o); }
                    if (fr == 0) { float* kp = kmsum + (size_t)u.pm * 512 + col0 + bj * HALF + 4 * n;
                        atomicAdd(kp + 0, s[0]); atomicAdd(kp + 1, s[1]); atomicAdd(kp + 2, s[2]); atomicAdd(kp + 3, s[3]); } }
        }
    }
};
struct EpiBf16Plain {
    static constexpr bool PERM = true, AFTER_DRAIN = false;
    bf16_t* C; int ldc;
    __device__ __forceinline__ void operator()(const f32x4 (&acc)[2][2][4][2], const Unit& u, int wr, int wc, int fr, int fq) const {
        const int row0 = u.pm * BM + wr * 64 + fr, col0 = u.pn * BM + wc * 32 + 8 * fq;
#pragma unroll
        for (int ai = 0; ai < 2; ++ai)
#pragma unroll
            for (int m = 0; m < 4; ++m) { bf16_t* rowp = C + (size_t)(row0 + ai * HALF + m * 16) * ldc + col0;
#pragma unroll
                for (int bj = 0; bj < 2; ++bj) { const f32x4 v0 = acc[ai][bj][m][0], v1 = acc[ai][bj][m][1];
                    u32x4 w; w.x = cvt_pk_bf16(v0[0], v0[1]); w.y = cvt_pk_bf16(v0[2], v0[3]); w.z = cvt_pk_bf16(v1[0], v1[1]); w.w = cvt_pk_bf16(v1[2], v1[3]);
                    *(u32x4*)(rowp + bj * HALF) = w; } }
    }
};
struct EpiF32 {
    static constexpr bool PERM = false, AFTER_DRAIN = false;
    float* C; int ldc;
    __device__ __forceinline__ void operator()(const f32x4 (&acc)[2][2][4][2], const Unit& u, int wr, int wc, int fr, int fq) const {
        const int row0 = u.pm * BM + wr * 64 + fr, col0 = u.pn * BM + wc * 32 + 4 * fq;
#pragma unroll
        for (int ai = 0; ai < 2; ++ai)
#pragma unroll
            for (int m = 0; m < 4; ++m) { float* rowp = C + (size_t)(row0 + ai * HALF + m * 16) * ldc + col0;
#pragma unroll
                for (int bj = 0; bj < 2; ++bj)
#pragma unroll
                    for (int n = 0; n < 2; ++n) *(f32x4*)(rowp + bj * HALF + n * 16) = acc[ai][bj][m][n]; }
    }
};
}

namespace pg8 {
constexpr unsigned TOK_NONE = 0xffffffffu;
template <class Epi, class Sched, bool GATHER, bool ALIGN_EPI = true>
__device__ __forceinline__ void gemm_phase_g(PG8_LAS unsigned char* lds, const Gemm g, const Sched& S, const Epi& E, const PG8_LAS unsigned* toktab) {
    const int tid = threadIdx.x, wid = __builtin_amdgcn_readfirstlane(tid >> 6), lane = tid & 63, wr = wid >> 2, wc = wid & 3, fr = lane & 15, fq = lane >> 4;
    const int K = g.K, nt = K / BK;
    unsigned voffB[2]; int RA[2]; unsigned CA2[2];
#pragma unroll
    for (int i = 0; i < 2; ++i) { int R, C; stage_rc(tid * 16 + i * 8192, R, C); const int Rb = Epi::PERM ? ((R & ~31) + perm32(R & 31)) : R;
        RA[i] = R; CA2[i] = (unsigned)C * 2u; voffB[i] = (unsigned)(Rb * K + C) * 2u; }
    const size_t kstep = (size_t)(BK * 2), hstep = (size_t)HALF * K * 2, tstep = 2 * hstep;
    const unsigned ldsw = (unsigned)wid * 1024u;
    const int aoff = lds_byte(wr * 64 + fr, fq * 8), boff = lds_byte(wc * 32 + fr, fq * 8);
#define PG8_SA(b, h) (((b) * 2 + (h)) * HTB)
#define PG8_SB(b, h) ((4 + (b) * 2 + (h)) * HTB)
#define PG8_STAGE(bufoff, gbase, voff) do { _Pragma("unroll") for (int _i = 0; _i < 2; ++_i) \
        __builtin_amdgcn_global_load_lds((const unsigned*)((const char*)(gbase) + (voff)[_i]), (PG8_LAS unsigned*)(lds + (bufoff) + ldsw + _i * 8192), 16, 0, 0); } while (0)
#define PG8_LDA(dst, b, h) do { _Pragma("unroll") for (int m = 0; m < 4; ++m) _Pragma("unroll") for (int k = 0; k < 2; ++k) dst[m][k] = *(const PG8_LAS bf16x8*)(lds + PG8_SA(b, h) + aoff + m * 2048 + k * 1024); } while (0)
#define PG8_LDB(dst, b, h) do { _Pragma("unroll") for (int n = 0; n < 2; ++n) _Pragma("unroll") for (int k = 0; k < 2; ++k) dst[n][k] = *(const PG8_LAS bf16x8*)(lds + PG8_SB(b, h) + boff + n * 2048 + k * 1024); } while (0)
#define PG8_MMA(ai, bj, At, Bt) do { __builtin_amdgcn_s_setprio(1); _Pragma("unroll") for (int m = 0; m < 4; ++m) _Pragma("unroll") for (int n = 0; n < 2; ++n) _Pragma("unroll") for (int k = 0; k < 2; ++k) \
        acc[ai][bj][m][n] = __builtin_amdgcn_mfma_f32_16x16x32_bf16(Bt[n][k], At[m][k], acc[ai][bj][m][n], 0, 0, 0); __builtin_amdgcn_s_setprio(0); } while (0)
#define PG8_WAIT_V(n) asm volatile("s_waitcnt vmcnt(" #n ")" ::: "memory")
#define PG8_WAIT_L(n) asm volatile("s_waitcnt lgkmcnt(" #n ")" ::: "memory")
#define PG8_BAR __builtin_amdgcn_s_barrier()
#define PG8_SCHED __builtin_amdgcn_sched_barrier(0)
#define PG8_MKOFF(VO, UI, U) do { _Pragma("unroll") for (int _h = 0; _h < 2; ++_h) _Pragma("unroll") for (int _i = 0; _i < 2; ++_i) { \
        unsigned _row; if (GATHER) { const unsigned _t = toktab[(UI) * 256 + _h * HALF + RA[_i]]; _row = (_t == TOK_NONE) ? 0u : (_t >> 1); } else _row = (unsigned)((U).pm * BM + _h * HALF + RA[_i]); \
        VO[_h][_i] = _row * (unsigned)(K * 2) + CA2[_i]; } } while (0)
    Unit cur, nxt; int ui = 0;
    if (!S.next(0, cur)) return;
    f32x4 acc[2][2][4][2];
#pragma unroll
    for (int a = 0; a < 2; ++a)
#pragma unroll
        for (int b = 0; b < 2; ++b)
#pragma unroll
            for (int m = 0; m < 4; ++m)
#pragma unroll
                for (int n = 0; n < 2; ++n) acc[a][b][m][n] = (f32x4){0.f, 0.f, 0.f, 0.f};
    bf16x8 At[4][2], B0[2][2], B1[2][2];
    const char* Ab = (const char*)g.A; const char* cB = (const char*)g.Bt + (size_t)cur.pn * tstep;
    unsigned vc[2][2], vn[2][2];
    PG8_MKOFF(vc, 0, cur);
    PG8_STAGE(PG8_SB(0, 0), cB, voffB); PG8_STAGE(PG8_SB(0, 1), cB + hstep, voffB); PG8_STAGE(PG8_SA(0, 0), Ab, vc[0]); PG8_STAGE(PG8_SA(0, 1), Ab, vc[1]);
    if (wr == 1) PG8_BAR;
    PG8_WAIT_V(2); PG8_BAR;
    PG8_STAGE(PG8_SB(1, 0), cB + kstep, voffB); PG8_STAGE(PG8_SA(1, 0), Ab + kstep, vc[0]); PG8_STAGE(PG8_SB(1, 1), cB + hstep + kstep, voffB);
    PG8_WAIT_V(6); PG8_BAR;
    for (;;) {
        const bool has_next = S.next(ui + 1, nxt);
        const char* nB = has_next ? (const char*)g.Bt + (size_t)nxt.pn * tstep : cB;
        if (has_next) { PG8_MKOFF(vn, ui + 1, nxt); } else { vn[0][0] = vc[0][0]; vn[0][1] = vc[0][1]; vn[1][0] = vc[1][0]; vn[1][1] = vc[1][1]; }
#pragma unroll 1
        for (int t = 0; t < nt; t += 2) {
            const bool last = (t == nt - 2);
            const char* a1 = Ab + (size_t)(t + 1) * kstep;
            const char* a2 = last ? Ab : Ab + (size_t)(t + 2) * kstep; const char* b2 = last ? nB : cB + (size_t)(t + 2) * kstep;
            const char* a3 = a2 + kstep; const char* b3 = b2 + kstep;
            unsigned v2[2][2];
#pragma unroll
            for (int h = 0; h < 2; ++h)
#pragma unroll
                for (int i = 0; i < 2; ++i) v2[h][i] = last ? vn[h][i] : vc[h][i];
            PG8_LDB(B0, 0, 0); PG8_LDB(B1, 0, 1); PG8_SCHED; PG8_LDA(At, 0, 0); PG8_STAGE(PG8_SA(1, 1), a1, vc[1]);
            PG8_WAIT_V(8); PG8_WAIT_L(0); PG8_BAR; PG8_MMA(0, 0, At, B0); PG8_MMA(0, 1, At, B1); PG8_BAR; PG8_SCHED;
            PG8_LDA(At, 0, 1); PG8_STAGE(PG8_SB(0, 0), b2, voffB); PG8_STAGE(PG8_SB(0, 1), b2 + hstep, voffB); PG8_STAGE(PG8_SA(0, 0), a2, v2[0]);
            PG8_WAIT_V(8); PG8_WAIT_L(0); PG8_BAR; PG8_MMA(1, 0, At, B0); PG8_MMA(1, 1, At, B1); PG8_BAR; PG8_SCHED;
            PG8_LDB(B0, 1, 0); PG8_LDB(B1, 1, 1); PG8_SCHED; PG8_LDA(At, 1, 0); PG8_STAGE(PG8_SA(0, 1), a2, v2[1]);
            PG8_WAIT_V(8); PG8_WAIT_L(0); PG8_BAR; PG8_MMA(0, 0, At, B0); PG8_MMA(0, 1, At, B1); PG8_BAR; PG8_SCHED;
            PG8_LDA(At, 1, 1); PG8_STAGE(PG8_SB(1, 0), b3, voffB); PG8_STAGE(PG8_SB(1, 1), b3 + hstep, voffB); PG8_STAGE(PG8_SA(1, 0), a3, v2[0]);
            PG8_WAIT_V(8); PG8_WAIT_L(0); PG8_BAR; PG8_MMA(1, 0, At, B0); PG8_MMA(1, 1, At, B1); PG8_BAR; PG8_SCHED;
        }
        if constexpr (ALIGN_EPI) { if (wr == 0) PG8_BAR; }
        E(acc, cur, ui, wr, wc, fr, fq);
        if (!has_next) break;
#pragma unroll
        for (int a = 0; a < 2; ++a)
#pragma unroll
            for (int b = 0; b < 2; ++b)
#pragma unroll
                for (int m = 0; m < 4; ++m)
#pragma unroll
                    for (int n = 0; n < 2; ++n) acc[a][b][m][n] = (f32x4){0.f, 0.f, 0.f, 0.f};
        cur = nxt; cB = nB; ++ui;
#pragma unroll
        for (int h = 0; h < 2; ++h)
#pragma unroll
            for (int i = 0; i < 2; ++i) vc[h][i] = vn[h][i];
        if constexpr (ALIGN_EPI) { if (wr == 1) PG8_BAR; }
    }
    PG8_WAIT_V(0);
    if constexpr (!ALIGN_EPI) { if (wr == 0) PG8_BAR; }
    PG8_BAR;
#undef PG8_SA
#undef PG8_SB
#undef PG8_STAGE
#undef PG8_LDA
#undef PG8_LDB
#undef PG8_MMA
#undef PG8_WAIT_V
#undef PG8_WAIT_L
#undef PG8_BAR
#undef PG8_SCHED
#undef PG8_MKOFF
}
struct MoeOrder {
    const PG8_LAS unsigned* toff; int nct, G, c;
    __device__ __forceinline__ bool next(int i, Unit& u) const {
        const int L = i * G + c; const int total = (int)toff[32] * nct; if (L >= total) return false;
        const int rt = L / nct, ct = L % nct; int e = 0; while ((int)toff[e + 1] <= rt) ++e;
        u.pm = rt; u.pn = e * nct + ct; return true;
    }
};
struct EpiMoeUp {
    static constexpr bool PERM = true, AFTER_DRAIN = false;
    bf16_t* H; const float* RW; const PG8_LAS unsigned* toktab;
    __device__ __forceinline__ void operator()(const f32x4 (&acc)[2][2][4][2], const Unit& u, int ui, int wr, int wc, int fr, int fq) const {
        const int col0 = (u.pn & 1) * HALF + wc * 32 + 8 * fq;
#pragma unroll
        for (int ai = 0; ai < 2; ++ai)
#pragma unroll
            for (int m = 0; m < 4; ++m) { const int r = ai * HALF + wr * 64 + m * 16 + fr; const unsigned tk = toktab[ui * 256 + r]; const float w = (tk != TOK_NONE) ? RW[tk] : 0.f;
                float h[8];
#pragma unroll
                for (int n = 0; n < 2; ++n)
#pragma unroll
                    for (int j = 0; j < 4; ++j) { const float a = acc[ai][0][m][n][j], b = acc[ai][1][m][n][j]; h[4 * n + j] = a / (1.f + __expf(-a)) * b * w; }
                u32x4 o; o.x = cvt_pk_bf16(h[0], h[1]); o.y = cvt_pk_bf16(h[2], h[3]); o.z = cvt_pk_bf16(h[4], h[5]); o.w = cvt_pk_bf16(h[6], h[7]);
                *(u32x4*)(H + (size_t)(u.pm * BM + r) * 256 + col0) = o; }
    }
};
struct EpiMoeDown {
    static constexpr bool PERM = true, AFTER_DRAIN = false;
    bf16_t* YS; bf16_t* dump; const PG8_LAS unsigned* toktab;
    __device__ __forceinline__ void operator()(const f32x4 (&acc)[2][2][4][2], const Unit& u, int ui, int wr, int wc, int fr, int fq) const {
        const int col0 = (u.pn & 3) * BM + wc * 32 + 8 * fq;
#pragma unroll
        for (int ai = 0; ai < 2; ++ai)
#pragma unroll
            for (int m = 0; m < 4; ++m) { const int r = ai * HALF + wr * 64 + m * 16 + fr; const unsigned tk = toktab[ui * 256 + r];
                bf16_t* rowp = ((tk != TOK_NONE) ? YS + (size_t)tk * 1024 : dump) + col0;
#pragma unroll
                for (int bj = 0; bj < 2; ++bj) { const f32x4 v0 = acc[ai][bj][m][0], v1 = acc[ai][bj][m][1];
                    u32x4 o; o.x = cvt_pk_bf16(v0[0], v0[1]); o.y = cvt_pk_bf16(v0[2], v0[3]); o.z = cvt_pk_bf16(v1[0], v1[1]); o.w = cvt_pk_bf16(v1[2], v1[3]);
                    *(u32x4*)(rowp + bj * HALF) = o; }
                asm volatile("" ::: "memory"); }
    }
};
}

#include <hip/hip_bf16.h>
#include <cmath>
namespace attn_body {
using bf16=__hip_bfloat16;
using bf16x8=__attribute__((ext_vector_type(8)))short;
using s16x4=__attribute__((ext_vector_type(4)))short;
using f32x16=__attribute__((ext_vector_type(16)))float;
using u32x4=__attribute__((ext_vector_type(4)))unsigned;
constexpr int BATCH=4,NHEAD=8,SEQ=4096,D=64,DM=NHEAD*D;
constexpr int NW=8,QBLK=32,QB=QBLK*NW,KVBLK=64,NQB=SEQ/QB;
constexpr int ATTN_PITCH=DM, ATTN_UNIT_ROWS=QB;
__device__ __forceinline__ int crow(int r,int hi){return (r&3)+8*(r>>2)+4*hi;}
#define SBAR() __builtin_amdgcn_sched_barrier(0)
__device__ __forceinline__ void maskbias(f32x16&p0,f32x16&p1,int relbase,int hi,const __attribute__((address_space(3))) float*RT){
  const __attribute__((address_space(3))) float*p=RT+(511-relbase+4*hi);
  #pragma unroll
  for(int r=0;r<16;++r){ p0[r]+=p[(r&3)+8*(r>>2)]; p1[r]+=p[32+(r&3)+8*(r>>2)]; if((r&3)==3)__builtin_amdgcn_sched_barrier(0); }
}

constexpr int NSLOT=3, SLOTB=8192;
constexpr int LDS_K=0, LDS_V=NSLOT*SLOTB, LDS_WS=2*NSLOT*SLOTB, LDS_OST=LDS_WS+NW*64*4, LDS_KM=LDS_OST+NW*4096, LDS_BT=LDS_KM+4096, LDS_BYTES=LDS_BT+3072;
constexpr float C2=0.125f*1.4426950408889634f;
__device__ __forceinline__ void glds16(const void*gsrc,unsigned lds_dst){unsigned keep;
  asm volatile("s_mov_b32 %0, m0\n\ts_mov_b32 m0, %2\n\ts_nop 0\n\tglobal_load_lds_dwordx4 %1, off\n\ts_mov_b32 m0, %0":"=&s"(keep):"v"(gsrc),"s"(lds_dst):"memory");}
__device__ __forceinline__ float max3f(float a,float b,float c){float r;asm("v_max3_f32 %0, %1, %2, %3":"=v"(r):"v"(a),"v"(b),"v"(c));return r;}
__device__ __forceinline__ float max2f(float a,float b){float r;asm("v_max_f32_e32 %0, %1, %2":"=v"(r):"v"(a),"v"(b));return r;}
__device__ __forceinline__ float fadd_s(float a,float b){float r;asm("v_add_f32_e32 %0, %1, %2":"=v"(r):"v"(a),"v"(b));return r;}
__device__ __forceinline__ float fsub_s(float a,float b){float r;asm("v_sub_f32_e32 %0, %1, %2":"=v"(r):"v"(a),"v"(b));return r;}
typedef float f32x4_t __attribute__((ext_vector_type(4))); typedef float f32x2_t __attribute__((ext_vector_type(2))); typedef __bf16 bf16x2_t __attribute__((ext_vector_type(2)));
__device__ __forceinline__ unsigned cvtpk_s(float lo,float hi){f32x2_t v={lo,hi};bf16x2_t b=__builtin_convertvector(v,bf16x2_t);return __builtin_bit_cast(unsigned,b);}
#define WAIT_BAR(N) asm volatile("s_waitcnt vmcnt(" #N ") lgkmcnt(0)\n\ts_barrier":::"memory")

__device__ __forceinline__ void qkt(f32x16&p0,f32x16&p1,const char*Kslot,const bf16x8*qr,int r32,int hi){
  const char*kb=Kslot+hi*1024+r32*16;
  #pragma unroll
  for(int d0=0;d0<4;++d0){
    const bf16x8 b0=*reinterpret_cast<const bf16x8*>(kb+d0*2048);
    const bf16x8 b1=*reinterpret_cast<const bf16x8*>(kb+d0*2048+512);
    if(d0==0){p0=__builtin_amdgcn_mfma_f32_32x32x16_bf16(b0,qr[0],f32x16{},0,0,0);p1=__builtin_amdgcn_mfma_f32_32x32x16_bf16(b1,qr[0],f32x16{},0,0,0);}
    else{p0=__builtin_amdgcn_mfma_f32_32x32x16_bf16(b0,qr[d0],p0,0,0,0);p1=__builtin_amdgcn_mfma_f32_32x32x16_bf16(b1,qr[d0],p1,0,0,0);}}
}
typedef __attribute__((address_space(3))) const char* lds_cptr;
typedef short v4i16_t __attribute__((ext_vector_type(4)));
__device__ __forceinline__ void kload8(bf16x8*kf,lds_cptr kp){
  kf[0]=*(const __attribute__((address_space(3))) bf16x8*)(kp);      kf[1]=*(const __attribute__((address_space(3))) bf16x8*)(kp+512);
  kf[2]=*(const __attribute__((address_space(3))) bf16x8*)(kp+2048); kf[3]=*(const __attribute__((address_space(3))) bf16x8*)(kp+2560);
  kf[4]=*(const __attribute__((address_space(3))) bf16x8*)(kp+4096); kf[5]=*(const __attribute__((address_space(3))) bf16x8*)(kp+4608);
  kf[6]=*(const __attribute__((address_space(3))) bf16x8*)(kp+6144); kf[7]=*(const __attribute__((address_space(3))) bf16x8*)(kp+6656);
}
__device__ __forceinline__ void kload2(bf16x8*kf,lds_cptr kp,int j){ kf[2*j]=*(const __attribute__((address_space(3))) bf16x8*)(kp+j*2048); kf[2*j+1]=*(const __attribute__((address_space(3))) bf16x8*)(kp+j*2048+512); }
__device__ __forceinline__ s16x4 vtr(lds_cptr p){ return __builtin_bit_cast(s16x4,__builtin_amdgcn_ds_read_tr16_b64_v4i16((__attribute__((address_space(3))) v4i16_t*)p)); }
__device__ __forceinline__ float rowmax(const f32x16&p0,const f32x16&p1){
  float a=max3f(p0[0],p0[1],p1[0]),b=max3f(p0[2],p0[3],p1[1]);a=max3f(a,p1[2],p1[3]);
  #pragma unroll
  for(int r=4;r<16;r+=4){a=max3f(a,p0[r],p0[r+1]);b=max3f(b,p0[r+2],p0[r+3]);a=max3f(a,p1[r],p1[r+1]);b=max3f(b,p1[r+2],p1[r+3]);}
  const float m=max2f(a,b);
  auto rr=__builtin_amdgcn_permlane32_swap(__float_as_uint(m),__float_as_uint(m),false,false);
  return max2f(__uint_as_float(rr[0]),__uint_as_float(rr[1]));
}
__device__ __forceinline__ void pv(f32x16*o,int vb,bf16x8 pa0,bf16x8 pa1,bf16x8 pa2,bf16x8 pa3){
  #pragma unroll
  for(int d0=0;d0<2;++d0){s16x4 lo[4],hi[4];
    #pragma unroll
    for(int ks=0;ks<4;++ks){
      asm volatile("ds_read_b64_tr_b16 %0,%1 offset:%c2":"=&v"(lo[ks]):"v"(vb),"i"(d0*4096+ks*1024):"memory");
      asm volatile("ds_read_b64_tr_b16 %0,%1 offset:%c2":"=&v"(hi[ks]):"v"(vb),"i"(d0*4096+ks*1024+512):"memory");}
    asm volatile("s_waitcnt lgkmcnt(0)":::"memory");SBAR();
    #define PK(k) (bf16x8){lo[k][0],lo[k][1],lo[k][2],lo[k][3],hi[k][0],hi[k][1],hi[k][2],hi[k][3]}
    o[d0]=__builtin_amdgcn_mfma_f32_32x32x16_bf16(pa0,PK(0),o[d0],0,0,0);
    o[d0]=__builtin_amdgcn_mfma_f32_32x32x16_bf16(pa1,PK(1),o[d0],0,0,0);
    o[d0]=__builtin_amdgcn_mfma_f32_32x32x16_bf16(pa2,PK(2),o[d0],0,0,0);
    o[d0]=__builtin_amdgcn_mfma_f32_32x32x16_bf16(pa3,PK(3),o[d0],0,0,0);
    #undef PK
  }
}

#ifndef ATTN_STORE16
#define ATTN_STORE16(p,v) (*(u32x4*)(p)=(v))
#endif
template<int THRL> __device__ __forceinline__ void attn_unit(int b,int h,int qb,const bf16*Q,const bf16*__restrict__ K,const bf16*__restrict__ V,bf16*O,const float*kmsum,const float*rel_bias,const unsigned char*t5b,char*shm){
  const int tid=threadIdx.x,lane=tid&63,r32=lane&31,hi=lane>>5; const int wid=__builtin_amdgcn_readfirstlane(tid>>6);
  const long rowbase=(long)b*SEQ; const int q0=qb*QB;
  const bf16*Qw=Q+(rowbase+q0+wid*QBLK)*DM+h*D;
  const bf16*Kh=K+rowbase*DM+h*D,*Vh=V+rowbase*DM+h*D;
  typedef __attribute__((address_space(3))) char* lds_wptr; const lds_wptr shm3=(lds_wptr)shm;
  const unsigned lds0=(unsigned)(uintptr_t)shm;
  float*wsf=(float*)(shm+LDS_WS)+wid*64;
  const bf16*ksrc=Kh+(long)lane*DM+wid*8;
  const bf16*vsrc=Vh+(long)(16*(wid&3)+(lane>>2))*DM+(wid>>2)*32+(lane&3)*8;
  const unsigned kdst=lds0+LDS_K+wid*1024, vdst=lds0+LDS_V+wid*1024;
  #define TMAP(t) (((t)<4)?(4*qb+(t)):((t)-4))
  #define DMA_K(t,slot) glds16(ksrc+(long)TMAP(t)*KVBLK*DM,(unsigned)__builtin_amdgcn_readfirstlane(kdst+(slot)))
  #define DMA_V(t,slot) glds16(vsrc+(long)TMAP(t)*KVBLK*DM,(unsigned)__builtin_amdgcn_readfirstlane(vdst+(slot)))
  const int vb0=(int)(lds0+LDS_V)+((lane>>4)&1)*32+(lane&3)*8+(4*hi+((lane&15)>>2))*64;
  const char*Kbase=shm+LDS_K; bf16x8 kf[8];
  const lds_cptr kp0=shm3+LDS_K+hi*1024+r32*16; const lds_cptr vp0=shm3+LDS_V+((lane>>4)&1)*32+(lane&3)*8+(4*hi+((lane&15)>>2))*64;
  const int NT=(q0+QB)/KVBLK;
  {
    if(tid<256){ const int jb_=tid>>4,d4_=(tid&15)*4; *(__attribute__((address_space(3))) f32x4_t*)(shm3+LDS_KM+tid*16)=*(const f32x4_t*)(kmsum+((long)(b*(SEQ/QB)+jb_)*DM+h*D+d4_)); }
    for(int k_=tid;k_<767;k_+=NW*64){ const int rel_=511-k_; float v_=0.f; if(rel_<0)v_=-INFINITY; else if(rel_<113)v_=(rel_bias[(int)t5b[rel_]*NHEAD+h]-rel_bias[31*NHEAD+h])*1.4426950408889634f;
      ((__attribute__((address_space(3))) float*)(shm3+LDS_BT))[k_]=v_; } }
  DMA_K(0,0);DMA_V(0,0);DMA_K(1,SLOTB);
  bf16x8 qr[4];
  #pragma unroll
  for(int d0=0;d0<4;++d0)qr[d0]=*reinterpret_cast<const bf16x8*>(&Qw[(long)r32*DM+d0*16+hi*8]);
  float mhat=0.f,l_reg=0.f;f32x16 o[2];o[0]=f32x16{};o[1]=f32x16{};
  const int qrel=wid*QBLK+r32;
  #define CMASK(P0,P1,t) do{ const int t_=(t); if(t_<4){ if(32*wid-64*t_-63<113) maskbias(P0,P1,qrel-64*t_,hi,BT); } \
    else if(((t_-4)>>2)==qb-1){ const int ko_=256-64*((t_-4)&3); if(32*wid+ko_-63<113) maskbias(P0,P1,qrel+ko_,hi,BT); } }while(0)
  bool resc=false;
  #define START(P0,P1) do{ const float rm=rowmax(P0,P1); resc=false; \
    { const float dl=rm; mhat=fadd_s(mhat,dl); \
      _Pragma("unroll") for(int r=0;r<16;++r){P0[r]=fsub_s(P0[r],dl);P1[r]=fsub_s(P1[r],dl);} \
      } \
    _Pragma("unroll") for(int r=0;r<16;++r)P0[r]=__builtin_amdgcn_exp2f(P0[r]); }while(0)
  #define RESC() do{ if(resc){ asm volatile("s_waitcnt lgkmcnt(0)":::"memory"); \
      _Pragma("unroll") for(int d_=0;d_<2;++d_) _Pragma("unroll") for(int r=0;r<16;++r)o[d_][r]*=wsf[crow(r,hi)]; } }while(0)
  f32x16 pA0,pA1,pB0,pB1;
  int sl_prev=0,sl_cur=0,sl_next=SLOTB;
  #define ROT() do{sl_prev=sl_cur;sl_cur=sl_next;sl_next=(sl_next==(NSLOT-1)*SLOTB)?0:sl_next+SLOTB;}while(0)
  DMA_K(2,2*SLOTB);
  WAIT_BAR(3);
  unsigned selmask;
  { const __attribute__((address_space(3))) float*KM=(const __attribute__((address_space(3))) float*)(shm3+LDS_KM);
    float v0=-INFINITY,v1=-INFINITY,v2=-INFINITY;int i0=0,i1=0,i2=0;
    #define QF(d0,j) __builtin_bit_cast(float,(unsigned)(unsigned short)qr[d0][j]<<16)
    #pragma unroll 1
    for(int jb=0;jb<qb;++jb){ float g=0.f;
      #pragma unroll
      for(int d0=0;d0<4;++d0){ const f32x4_t ka=*(const __attribute__((address_space(3))) f32x4_t*)(KM+jb*64+16*d0+8*hi), kb2=*(const __attribute__((address_space(3))) f32x4_t*)(KM+jb*64+16*d0+8*hi+4);
        g+=QF(d0,0)*ka[0]+QF(d0,1)*ka[1]+QF(d0,2)*ka[2]+QF(d0,3)*ka[3]+QF(d0,4)*kb2[0]+QF(d0,5)*kb2[1]+QF(d0,6)*kb2[2]+QF(d0,7)*kb2[3]; }
    #undef QF
      g+=__shfl_xor(g,32);
      if(g>v0){v2=v1;i2=i1;v1=v0;i1=i0;v0=g;i0=jb;} else if(g>v1){v2=v1;i2=i1;v1=g;i1=jb;} else if(g>v2){v2=g;i2=jb;} }
    selmask=(qb>=3)?((1u<<i0)|(1u<<i1)|(1u<<i2)):((1u<<qb)-1u); }
  const __attribute__((address_space(3))) float*BT=(const __attribute__((address_space(3))) float*)(shm3+LDS_BT);
  qkt(pA0,pA1,Kbase,qr,r32,hi);asm volatile("s_nop 15\n\ts_nop 7":"+v"(pA0),"+v"(pA1));CMASK(pA0,pA1,0);
  START(pA0,pA1);
  _Pragma("unroll") for(int r=0;r<16;++r)pA1[r]=__builtin_amdgcn_exp2f(pA1[r]);
  WAIT_BAR(0);
  DMA_K(3,0);DMA_V(1,SLOTB);
  ROT();
  kload8(kf,kp0+sl_cur);
  WAIT_BAR(2);
  s16x4 vlo[8],vhi[8]; u32x4 pw0,pw1,pw2,pw3;
  #define PKW(P,B) cvtpk_s(P[B],P[B+1])
  #define PAF(k) __builtin_bit_cast(bf16x8,pw##k)
  #define VFR(i) (bf16x8){vlo[i][0],vlo[i][1],vlo[i][2],vlo[i][3],vhi[i][0],vhi[i][1],vhi[i][2],vhi[i][3]}
  #define PIN(x) asm volatile("":"+v"(x))
  #define MX3(a,b,c) __builtin_fmaxf(__builtin_fmaxf((a),(b)),(c))
  #define GAPA(MF,A0,A1,A2,A3,W0,W1,PW) do{ MF; sacc+=A0; sacc+=A1; sacc+=A2; sacc+=A3; PIN(sacc); W0; W1; PIN(PW); SBAR(); }while(0)
  #define EX(v) __builtin_amdgcn_exp2f(v)
  #define GAPB(MF,X,B) do{ MF; X[B]=EX(X[B]); X[B+1]=EX(X[B+1]); X[B+2]=EX(X[B+2]); X[B+3]=EX(X[B+3]); PIN(X); SBAR(); }while(0)
  #define VRD(i) do{ vlo[i]=vtr(vp_+(((i)>>2)*4096+((i)&3)*1024)); vhi[i]=vtr(vp_+(((i)>>2)*4096+((i)&3)*1024+512)); }while(0)
  #define KRD(G,j) do{ if(G){ kload2(kf,kp0+sl_next,j); SBAR(); } }while(0)
  #define STEP(C0,C1,P0,P1,t,GK,GV,GL) do{ SBAR(); \
    const lds_cptr vp_=vp0+sl_prev; \
    VRD(0); SBAR(); float sacc=(P0[0]+P0[1]); \
    GAPA(C0=__builtin_amdgcn_mfma_f32_32x32x16_bf16(kf[0],qr[0],f32x16{},0,0,0), P0[2],P0[3],P0[4],P0[5],     pw0[0]=PKW(P0,0), pw0[1]=PKW(P0,2), pw0); \
    VRD(4); SBAR(); GAPA(C1=__builtin_amdgcn_mfma_f32_32x32x16_bf16(kf[1],qr[0],f32x16{},0,0,0), P0[6],P0[7],P0[8],P0[9],     pw0[2]=PKW(P0,4), pw0[3]=PKW(P0,6), pw0); \
    VRD(1); SBAR(); GAPA(C0=__builtin_amdgcn_mfma_f32_32x32x16_bf16(kf[2],qr[1],C0,0,0,0),   P0[10],P0[11],P0[12],P0[13], pw1[0]=PKW(P0,8), pw1[1]=PKW(P0,10), pw1); \
    VRD(5); SBAR(); GAPA(C1=__builtin_amdgcn_mfma_f32_32x32x16_bf16(kf[3],qr[1],C1,0,0,0),   P0[14],P0[15],P1[0],P1[1],   pw1[2]=PKW(P0,12),pw1[3]=PKW(P0,14), pw1); \
    VRD(2); SBAR(); GAPA(C0=__builtin_amdgcn_mfma_f32_32x32x16_bf16(kf[4],qr[2],C0,0,0,0),   P1[2],P1[3],P1[4],P1[5],     pw2[0]=PKW(P1,0), pw2[1]=PKW(P1,2), pw2); \
    VRD(6); SBAR(); GAPA(C1=__builtin_amdgcn_mfma_f32_32x32x16_bf16(kf[5],qr[2],C1,0,0,0),   P1[6],P1[7],P1[8],P1[9],     pw2[2]=PKW(P1,4), pw2[3]=PKW(P1,6), pw2); \
    VRD(3); SBAR(); GAPA(C0=__builtin_amdgcn_mfma_f32_32x32x16_bf16(kf[6],qr[3],C0,0,0,0),   P1[10],P1[11],P1[12],P1[13], pw3[0]=PKW(P1,8), pw3[1]=PKW(P1,10), pw3); \
    VRD(7); SBAR(); GAPA(C1=__builtin_amdgcn_mfma_f32_32x32x16_bf16(kf[7],qr[3],C1,0,0,0),   P1[14],P1[15],0.f,0.f,       pw3[2]=PKW(P1,12),pw3[3]=PKW(P1,14), pw3); \
    l_reg+=sacc; \
    if(GK){DMA_K((t)+3,sl_cur);} if(GV){DMA_V((t)+1,sl_next);} \
    { const int tq_=(t); const bool sel_=(tq_<4)||((selmask>>((tq_-4)>>2))&1u); const float nm_=sel_?-mhat:-INFINITY; \
      _Pragma("unroll") for(int r=0;r<16;++r){C0[r]+=nm_;C1[r]+=nm_;} } \
    CMASK(C0,C1,t); \
    { float a=MX3(C0[0],C0[1],C1[0]),b=MX3(C0[2],C0[3],C1[1]); a=MX3(a,C1[2],C1[3]); \
      _Pragma("unroll") for(int r=4;r<16;r+=4){a=MX3(a,C0[r],C0[r+1]);b=MX3(b,C0[r+2],C0[r+3]);a=MX3(a,C1[r],C1[r+1]);b=MX3(b,C1[r+2],C1[r+3]);} \
      float rm=__builtin_fmaxf(a,b); { auto rr=__builtin_amdgcn_permlane32_swap(__float_as_uint(rm),__float_as_uint(rm),false,false); rm=__builtin_fmaxf(__uint_as_float(rr[0]),__uint_as_float(rr[1])); } \
      resc=false; \
      if(__builtin_expect(__any(rm>(float)THRL),0)){ const float dl=__builtin_fmaxf(rm,0.f); mhat+=dl; \
        _Pragma("unroll") for(int r=0;r<16;++r){C0[r]-=dl;C1[r]-=dl;} \
        const float f=__builtin_amdgcn_exp2f(-dl); l_reg*=f; if(hi==0)wsf[r32]=f; resc=true; } \
      } \
    SBAR(); \
    GAPB(o[0]=__builtin_amdgcn_mfma_f32_32x32x16_bf16(PAF(0),VFR(0),o[0],0,0,0), C0,0); \
    GAPB(o[1]=__builtin_amdgcn_mfma_f32_32x32x16_bf16(PAF(0),VFR(4),o[1],0,0,0), C0,4); \
    KRD(GL,0); GAPB(o[0]=__builtin_amdgcn_mfma_f32_32x32x16_bf16(PAF(1),VFR(1),o[0],0,0,0), C0,8); \
    KRD(GL,1); GAPB(o[1]=__builtin_amdgcn_mfma_f32_32x32x16_bf16(PAF(1),VFR(5),o[1],0,0,0), C0,12); \
    KRD(GL,2); GAPB(o[0]=__builtin_amdgcn_mfma_f32_32x32x16_bf16(PAF(2),VFR(2),o[0],0,0,0), C1,0); \
    KRD(GL,3); GAPB(o[1]=__builtin_amdgcn_mfma_f32_32x32x16_bf16(PAF(2),VFR(6),o[1],0,0,0), C1,4); \
    GAPB(o[0]=__builtin_amdgcn_mfma_f32_32x32x16_bf16(PAF(3),VFR(3),o[0],0,0,0), C1,8); \
    GAPB(o[1]=__builtin_amdgcn_mfma_f32_32x32x16_bf16(PAF(3),VFR(7),o[1],0,0,0), C1,12); \
    }while(0)
  int t=1;
  for(;t+5<NT;t+=2){
    STEP(pB0,pB1,pA0,pA1,t,true,true,true);     WAIT_BAR(2); RESC(); ROT();
    STEP(pA0,pA1,pB0,pB1,t+1,true,true,true);   WAIT_BAR(2); RESC(); ROT();
  }
  #define ENDW(tt) do{ if((tt)+3<NT){WAIT_BAR(2);} else if((tt)+2<NT){WAIT_BAR(1);} else {WAIT_BAR(0);} }while(0)
  for(;t+1<NT;t+=2){
    STEP(pB0,pB1,pA0,pA1,t,(t+3<NT),(t+1<NT),(t+1<NT));       ENDW(t);   RESC(); ROT();
    STEP(pA0,pA1,pB0,pB1,t+1,(t+4<NT),(t+2<NT),(t+2<NT));     ENDW(t+1); RESC(); ROT();
  }
  STEP(pB0,pB1,pA0,pA1,NT-1,false,false,false); RESC();
  { float sacc=pB0[0]+pB0[1]; _Pragma("unroll") for(int r=2;r<16;++r)sacc+=pB0[r]; _Pragma("unroll") for(int r=0;r<16;++r)sacc+=pB1[r]; l_reg+=sacc;
    pw0=(u32x4){PKW(pB0,0),PKW(pB0,2),PKW(pB0,4),PKW(pB0,6)};pw1=(u32x4){PKW(pB0,8),PKW(pB0,10),PKW(pB0,12),PKW(pB0,14)};pw2=(u32x4){PKW(pB1,0),PKW(pB1,2),PKW(pB1,4),PKW(pB1,6)};pw3=(u32x4){PKW(pB1,8),PKW(pB1,10),PKW(pB1,12),PKW(pB1,14)};
    SBAR(); pv(o,vb0+sl_cur,PAF(0),PAF(1),PAF(2),PAF(3)); }
  #undef PKW
  #undef PAF
  #undef VFR
  #undef PIN
  #undef MX3
  #undef GAPA
  #undef GAPB
  #undef EX
  #undef VRD
  #undef KRD
  #undef STEP
  #undef ENDW
  {auto rr=__builtin_amdgcn_permlane32_swap(__float_as_uint(l_reg),__float_as_uint(l_reg),false,false);l_reg=__uint_as_float(rr[0])+__uint_as_float(rr[1]);}
  if(hi==0)wsf[32+r32]=l_reg;asm volatile("s_waitcnt lgkmcnt(0)":::"memory");
  float rli[16];
  #pragma unroll
  for(int r=0;r<16;++r)rli[r]=__builtin_amdgcn_rcpf(wsf[32+crow(r,hi)]);
  bf16*Ow=O+(rowbase+q0+wid*QBLK)*DM+h*D;
  { bf16*stg=(bf16*)(shm+LDS_OST)+wid*2048;
    #pragma unroll
    for(int r=0;r<16;++r){const int orow=crow(r,hi);
      #pragma unroll
      for(int d0=0;d0<2;++d0)stg[orow*64+d0*32+r32]=__float2bfloat16(o[d0][r]*rli[r]);}
    asm volatile("s_waitcnt lgkmcnt(0)":::"memory");
    #pragma unroll
    for(int i=0;i<4;++i){const int row=i*8+(lane>>3),ch=lane&7; const u32x4 v=*(const u32x4*)(stg+row*64+ch*8); ATTN_STORE16(Ow+(long)row*DM+ch*8,v);} }
  asm volatile("s_waitcnt lgkmcnt(0)\n\ts_barrier":::"memory");
  #undef DMA_K
  #undef DMA_V
  #undef TMAP
  #undef CMASK
  #undef START
  #undef RESC
  #undef ROT
}
constexpr int ATTN_LDS_BYTES=LDS_BYTES;
struct AttnTensors { const bf16* Q; const bf16* K; const bf16* V; bf16* O; const float* kmsum; const float* rel_bias; const unsigned char* t5b; };
struct AttnUnit { int bh; int qb; };
struct StaticOrder {
  int vcu,G;
  __device__ __forceinline__ explicit StaticOrder(int grid,int vcu_):vcu(vcu_),G(grid){}
  __device__ __forceinline__ bool next(int i,AttnUnit&u)const{ const int w=i*G+vcu; if(w>=512)return false; const int s=w&7; u.bh=(w&255)>>3; u.qb=(w<256)?s:15-s; return true; }
  __device__ __forceinline__ void a_ready(const AttnUnit&)const{}
  __device__ __forceinline__ void done(const AttnUnit&)const{}
};
template<class Sched,int THRL=8> __device__ __forceinline__ void attn_phase(char*lds,const AttnTensors&T,const Sched&S){
  AttnUnit u;
  for(int i=0;S.next(i,u);++i){ S.a_ready(u); attn_unit<THRL>(u.bh/NHEAD,u.bh%NHEAD,u.qb,T.Q,T.K,T.V,T.O,T.kmsum,T.rel_bias,T.t5b,lds); S.done(u); }
}
#undef SBAR
#undef WAIT_BAR
}

#define GAS __attribute__((address_space(1)))
#define LAS __attribute__((address_space(3)))
typedef unsigned short bf16;
typedef unsigned v4u __attribute__((ext_vector_type(4)));
typedef float f32x4 __attribute__((ext_vector_type(4)));
typedef short bf16x8 __attribute__((ext_vector_type(8)));
typedef GAS unsigned gu32;
typedef GAS unsigned long long gu64;
#define RLX_AGENT __ATOMIC_RELAXED, __HIP_MEMORY_SCOPE_AGENT
#define LDS_WAIT() asm volatile("s_waitcnt lgkmcnt(0)" ::: "memory")
#define VM_WAIT() asm volatile("s_waitcnt vmcnt(0)" ::: "memory")
__device__ __forceinline__ unsigned long long rt() { return __builtin_amdgcn_s_memrealtime(); }
__device__ __forceinline__ unsigned f2bf(float f) { unsigned u = __builtin_bit_cast(unsigned, f); return (u + 0x7fffu + ((u >> 16) & 1u)) >> 16; }
typedef float pk_f32x2 __attribute__((ext_vector_type(2))); typedef __bf16 pk_bf16x2 __attribute__((ext_vector_type(2)));
__device__ __forceinline__ unsigned pk2(float lo, float hi) { pk_f32x2 v = {lo, hi}; return __builtin_bit_cast(unsigned, __builtin_convertvector(v, pk_bf16x2)); }


#define XB_TMO      128
#define XB_XCNT(j)  (256  + 64 * (j))
#define XB_XSUB(j)  (1280 + 64 * (j))
#define XB_XGEN(j)  (2304 + 64 * (j))
#define XB_TOP      3328
#define XB_TOPGEN   3392
#define XCD_BAR_WORDS 3456
#define XB_SPIN_CAP (1u << 18)

__device__ __forceinline__ unsigned xb_ld(unsigned* p)              { return __hip_atomic_load(p, __ATOMIC_RELAXED, __HIP_MEMORY_SCOPE_AGENT); }
__device__ __forceinline__ unsigned xb_add(unsigned* p, unsigned v) { return __hip_atomic_fetch_add(p, v, __ATOMIC_RELAXED, __HIP_MEMORY_SCOPE_AGENT); }
__device__ __forceinline__ unsigned xb_xcc_id() { return (unsigned)__builtin_amdgcn_s_getreg((3 << 11) | 20) & 0xFu; }
#define XB_SPIN(cond, bar) do { unsigned _sp = 0; while (cond) { __builtin_amdgcn_s_sleep(1); \
    if ((++_sp & 255u) == 0u) { if (xb_ld(&(bar)[XB_TMO])) break; if (_sp > XB_SPIN_CAP) { atomicAdd(&(bar)[XB_TMO], 1u); break; } } } } while (0)

struct XcdBarrier {
    unsigned* bar; unsigned x;
    volatile LAS unsigned* st;
};

__device__ __forceinline__ XcdBarrier xcd_barrier_post(unsigned* bar, volatile LAS unsigned* st) {
    XcdBarrier b; b.bar = bar; b.x = xb_xcc_id(); b.st = st;
    if (threadIdx.x == 0) (void)xb_add(&bar[XB_XCNT(b.x)], 1u);
    return b;
}
__device__ __forceinline__ void xcd_barrier_complete(unsigned* bar, unsigned x, unsigned& nloc, unsigned& nx) {
    const unsigned G = gridDim.x * gridDim.y * gridDim.z;
    unsigned sum, cnt, mine, sp = 0u;
    for (;;) {
        sum = 0u; cnt = 0u; mine = 0u;
#pragma unroll
        for (unsigned j = 0; j < 16; ++j) { const unsigned c = xb_ld(&bar[XB_XCNT(j)]); sum += c; cnt += (c > 0u) ? 1u : 0u; mine = (j == x) ? c : mine; }
        if (sum == G) break;
        __builtin_amdgcn_s_sleep(1);
        if ((++sp & 255u) == 0u) { if (xb_ld(&bar[XB_TMO])) break; if (sp > XB_SPIN_CAP) { atomicAdd(&bar[XB_TMO], 1u); break; } }
    }
    nloc = mine > 0u ? mine : 1u; nx = cnt > 0u ? cnt : 1u;
}

__device__ __forceinline__ void xcd_barrier(const XcdBarrier& b) {
    asm volatile("s_waitcnt vmcnt(0)" ::: "memory");
    __syncthreads();
    if (threadIdx.x == 0) {
        unsigned* bar = b.bar;
        __builtin_amdgcn_s_waitcnt(0);
        unsigned nloc = b.st[0], nx = b.st[1];
        if (nloc == 0u) { xcd_barrier_complete(bar, b.x, nloc, nx); b.st[0] = nloc; b.st[1] = nx; }
        const unsigned old = xb_add(&bar[XB_XSUB(b.x)], 1u);
        const unsigned gen = old / nloc;
        if (old + 1u == (gen + 1u) * nloc) {
            __builtin_amdgcn_fence(__ATOMIC_RELEASE, "agent");
            asm volatile("s_waitcnt vmcnt(0)" ::: "memory");
            const unsigned og = xb_add(&bar[XB_TOP], 1u);
            const unsigned tg = og / nx;
            if (og + 1u == (tg + 1u) * nx) xb_add(&bar[XB_TOPGEN], 1u);
            else XB_SPIN(xb_ld(&bar[XB_TOPGEN]) == tg, bar);
            __builtin_amdgcn_fence(__ATOMIC_ACQUIRE, "agent");
            xb_add(&bar[XB_XGEN(b.x)], 1u);
            asm volatile("s_waitcnt vmcnt(0)" ::: "memory");
        } else {
            XB_SPIN(xb_ld(&bar[XB_XGEN(b.x)]) == gen, bar);
            __builtin_amdgcn_fence(__ATOMIC_ACQUIRE, "agent");
            asm volatile("s_waitcnt vmcnt(0)" ::: "memory");
        }
    }
    __syncthreads();
}

constexpr int NWAVES = 8, NTHR = NWAVES * 64;
constexpr int D = 1024, NB = 4, S = 4096, M = NB * S;
constexpr int DL = 512, DA = 512, NH = 8, HD = 64, BLK = 256, NBLK = S / BLK;
constexpr int NPROJ = 2560, NMOD = 6;
constexpr int NG = 4, EPG = 8, NE = 32, DE = 256;
constexpr float LN_EPS = 1e-5f;
constexpr float ALPHA = 1.189207115002721f;
constexpr float LOG2E = 1.4426950408889634f;
constexpr float QSCALE = 0.125f * LOG2E;

constexpr size_t MiB = 1u << 20, KiB = 1u << 10;
constexpr size_t WS_CTL = 0, CTL_ZERO_BYTES = 1 * MiB;
constexpr int CW_TMO = 0, CW_CODE = 1, CW_BAR = 4096;
constexpr size_t WS_KMSUM = 256 * KiB;
constexpr size_t WS_ECNT = 512 * KiB;
constexpr size_t WS_MOD = 768 * KiB;
constexpr size_t WS_WIN = 1 * MiB;
constexpr size_t WS_WO = 6 * MiB;
constexpr size_t WS_W13 = 8 * MiB;
constexpr size_t WS_W2 = 40 * MiB;
constexpr size_t WS_U = 56 * MiB;
constexpr size_t WS_XL = 88 * MiB, WS_YL = 104 * MiB, WS_Q = 120 * MiB, WS_K = 136 * MiB, WS_V = 152 * MiB;
constexpr size_t WS_HL = 168 * MiB, WS_CA = 184 * MiB, WS_AO = 200 * MiB;
constexpr size_t WS_MIX = 88 * MiB;
constexpr size_t WS_X1 = 168 * MiB;
constexpr size_t WS_YS = 88 * MiB;
constexpr size_t WS_HDN = 232 * MiB;
constexpr size_t WS_LIST = 253 * MiB;
constexpr size_t WS_SUMM = 255 * MiB;
constexpr size_t WS_GW = 255 * MiB + 256 * KiB;
constexpr size_t WS_RI = 255 * MiB + 512 * KiB, WS_RW = 255 * MiB + 640 * KiB;
constexpr size_t WS_WR = 252 * MiB + 512 * KiB;
constexpr size_t WS_DUMP = 255 * MiB + 768 * KiB;
constexpr size_t WS_END = 256 * MiB;

constexpr int RING_OFF = 0, RING_BYTES = 131072;
constexpr int LDSCTL_OFF = RING_BYTES, MISC_OFF = LDSCTL_OFF + 320;
constexpr int TOKTAB_OFF = LDSCTL_OFF + 1024, TOKTAB_UNITS = 8, MOEOFF_OFF = TOKTAB_OFF + TOKTAB_UNITS * 1024;
constexpr int LDS_BYTES = 147456;
static_assert(MOEOFF_OFF + 512 <= LDS_BYTES, "LDS map");

__device__ __constant__ unsigned char T5_BUCKET[128] = {
    0, 1, 2, 3, 4, 5, 6, 7, 8, 9, 10, 11, 12, 13, 14, 15, 16, 16, 16, 17, 17, 18, 18, 18, 19, 19, 19, 20, 20, 20, 20, 21, 21, 21, 21, 22, 22, 22, 22, 22,
    23, 23, 23, 23, 23, 23, 24, 24, 24, 24, 24, 24, 25, 25, 25, 25, 25, 25, 25, 26, 26, 26, 26, 26, 26, 26, 26, 27, 27, 27, 27, 27, 27, 27, 27, 27, 27,
    28, 28, 28, 28, 28, 28, 28, 28, 28, 28, 29, 29, 29, 29, 29, 29, 29, 29, 29, 29, 29, 29, 30, 30, 30, 30, 30, 30, 30, 30, 30, 30, 30, 30, 30, 30,
    31, 31, 31, 31, 31, 31, 31, 31, 31, 31, 31, 31, 31, 31, 31};

struct Frame {
    LAS unsigned char* lds;
    volatile LAS unsigned* MISC;
    gu32* ctl;
    int tid, lane, wave, vcu, G;
};
__device__ __forceinline__ float wave_sum(float v) {
#pragma unroll
    for (int o = 1; o < 64; o <<= 1) v += __shfl_xor(v, o);
    return v;
}
__device__ __forceinline__ float bf2f(unsigned short h) { return __builtin_bit_cast(float, (unsigned)h << 16); }
__device__ __forceinline__ float bflo(unsigned w) { return __builtin_bit_cast(float, w << 16); }
__device__ __forceinline__ float bfhi(unsigned w) { return __builtin_bit_cast(float, w & 0xffff0000u); }
__device__ __forceinline__ float fsigmoid(float x) { return 1.f / (1.f + __expf(-x)); }
__device__ __forceinline__ float fsilu(float x) { return x * fsigmoid(x); }
__device__ __forceinline__ float fgelu_tanh(float x) { const float z = 0.7978845608028654f * (x + 0.044715f * x * x * x); return x / (1.f + __expf(-2.f * z)); }

__device__ __forceinline__ void p0_transpose_item(const float* W, int N, int k0, int n0, bf16* WT, int ldk, int dst_row0, const float* kgain, LAS float* scr, int lane) {
#pragma unroll 8
    for (int i = 0; i < 32; ++i) { const int kk = 2 * i + (lane >> 5); float v = W[(size_t)(k0 + kk) * N + n0 + (lane & 31)]; if (kgain) v *= kgain[k0 + kk]; scr[kk * 33 + (lane & 31)] = v; }
    LDS_WAIT(); asm volatile("" ::: "memory");
    const int c = lane & 7;
#pragma unroll
    for (int j = 0; j < 4; ++j) { const int n = (lane >> 3) + 8 * j; const LAS float* s = scr + (8 * c) * 33 + n;
        v4u o; o.x = pk2(s[0 * 33], s[1 * 33]); o.y = pk2(s[2 * 33], s[3 * 33]); o.z = pk2(s[4 * 33], s[5 * 33]); o.w = pk2(s[6 * 33], s[7 * 33]);
        *(GAS v4u*)(WT + (size_t)(dst_row0 + n) * ldk + k0 + 8 * c) = o; }
    LDS_WAIT(); asm volatile("" ::: "memory");
}

struct Ptrs {
    const float *x, *c, *w_ada, *b_ada, *w_in, *conv_w, *conv_b, *w_ga, *b_ga, *w_gx, *b_gx, *lam, *rel_bias, *g_l, *g_a, *w_out, *ln1_g, *ln1_b, *w_rg, *b_rg, *w_re, *b_re, *w1, *w3, *w2, *ln2_g, *ln2_b;
    float* out; unsigned char* ws;
};
__device__ __forceinline__ void p0_prologue(Frame& F, const Ptrs& P) {
    float* mod = (float*)(P.ws + WS_MOD);
    if (blockIdx.x < (NMOD * D) / 32) {
        LAS float* sc = (LAS float*)(F.lds + RING_OFF);
        LAS float* part = (LAS float*)(F.lds + RING_OFF + 16384);
        for (int i = F.tid; i < NB * D; i += NTHR) sc[i] = fsilu(P.c[i]);
        __syncthreads();
        const int n0 = 32 * blockIdx.x, col = F.tid & 31, ks = F.tid >> 5, k0 = ks * 64;
        float a0 = 0.f, a1 = 0.f, a2 = 0.f, a3 = 0.f;
#pragma unroll 16
        for (int kk = 0; kk < 64; ++kk) { const float w = P.w_ada[(size_t)(k0 + kk) * (NMOD * D) + n0 + col];
            a0 += sc[k0 + kk] * w; a1 += sc[D + k0 + kk] * w; a2 += sc[2 * D + k0 + kk] * w; a3 += sc[3 * D + k0 + kk] * w; }
        part[(ks * 32 + col) * 4 + 0] = a0; part[(ks * 32 + col) * 4 + 1] = a1; part[(ks * 32 + col) * 4 + 2] = a2; part[(ks * 32 + col) * 4 + 3] = a3;
        __syncthreads();
        if (F.tid < 128) { const int cc = F.tid & 31, b = F.tid >> 5; float s = 0.f;
#pragma unroll
            for (int k = 0; k < 16; ++k) s += part[(k * 32 + cc) * 4 + b];
            mod[b * NMOD * D + n0 + cc] = s + P.b_ada[n0 + cc]; }
        __syncthreads();
    }
    LAS float* scr = (LAS float*)(F.lds + RING_OFF + F.wave * 16384);
    const int gw = F.vcu * NWAVES + F.wave, NGW = F.G * NWAVES;
    constexpr int I_IN = 16 * 80, I_OUT = 16 * 32, NITEMS = I_IN + I_OUT;
    bf16* WinT = (bf16*)(P.ws + WS_WIN); bf16* WoT = (bf16*)(P.ws + WS_WO);
    for (int it = gw; it < NITEMS; it += NGW) {
        int r = it;
        if (r < I_IN) { const int kb = r / 80, nb = r % 80; p0_transpose_item(P.w_in, NPROJ, 64 * kb, 32 * nb, WinT, D, 32 * nb, nullptr, scr, F.lane); continue; } r -= I_IN;
        { const int kb = r / 32, nb = r % 32; p0_transpose_item(P.w_out, D, 64 * kb, 32 * nb, WoT, D, 32 * nb, (64 * kb < DL) ? P.g_l : (P.g_a - DL), scr, F.lane); }
    }
    { float* WR = (float*)(P.ws + WS_WR);
      for (int f = F.vcu * NTHR + F.tid; f < D * 48; f += F.G * NTHR) { const int k = f / 48, col = f % 48; WR[f] = col < NG ? P.w_rg[k * NG + col] : (col < NG + NE ? P.w_re[k * NE + col - NG] : 0.f); } }
    { bf16* GW = (bf16*)(P.ws + WS_GW);
      for (int f = F.vcu * NTHR + F.tid; f < 8 * 2 * 2 * 4 * 64; f += F.G * NTHR) {
          const int ln = f & 63, s = (f >> 6) & 3, T = (f >> 8) & 1, g = (f >> 9) & 1, n = f >> 10;
          const int rho = ln & 31, h = ln >> 5, hi = (rho >> 2) & 1, reg = (rho & 3) + 4 * (rho >> 3), chan = 16 * (2 * T + (reg >> 3)) + 8 * hi + (reg & 7);
          const float* W = (g ? P.w_gx : P.w_ga) + (size_t)n * 64 * 64 + chan; const int i0 = 16 * s + 8 * h;
          v4u o; o.x = pk2(W[(i0 + 0) * 64], W[(i0 + 1) * 64]); o.y = pk2(W[(i0 + 2) * 64], W[(i0 + 3) * 64]); o.z = pk2(W[(i0 + 4) * 64], W[(i0 + 5) * 64]); o.w = pk2(W[(i0 + 6) * 64], W[(i0 + 7) * 64]);
          *(GAS v4u*)(GW + (size_t)f * 8) = o; } }
}
__device__ __forceinline__ void moe_weight_convert(Frame& F, const Ptrs& P, int rank, int nwg) {
    LAS float* scr = (LAS float*)(F.lds + RING_OFF + F.wave * 16384);
    constexpr int I_W1 = NE * 16 * 8, I_W2 = NE * 4 * 32, NITEMS = 2 * I_W1 + I_W2;
    bf16* W13T = (bf16*)(P.ws + WS_W13); bf16* W2T = (bf16*)(P.ws + WS_W2);
    for (int it = rank * NWAVES + F.wave; it < NITEMS; it += nwg * NWAVES) {
        int r = it;
        if (r < I_W1) { const int e = r / 128, q = r % 128, kb = q / 8, n0 = 32 * (q % 8);
            p0_transpose_item(P.w1 + (size_t)e * D * DE, DE, 64 * kb, n0, W13T + (size_t)e * 512 * D, D, (n0 / 128) * 256 + (n0 % 128), nullptr, scr, F.lane); continue; } r -= I_W1;
        if (r < I_W1) { const int e = r / 128, q = r % 128, kb = q / 8, n0 = 32 * (q % 8);
            p0_transpose_item(P.w3 + (size_t)e * D * DE, DE, 64 * kb, n0, W13T + (size_t)e * 512 * D, D, (n0 / 128) * 256 + 128 + (n0 % 128), nullptr, scr, F.lane); continue; } r -= I_W1;
        { const int e = r / 128, q = r % 128, kb = q / 32, n0 = 32 * (q % 32);
            p0_transpose_item(P.w2 + (size_t)e * DE * D, D, 64 * kb, n0, W2T + (size_t)e * D * DE, DE, n0, nullptr, scr, F.lane); }
    }
}
__device__ __forceinline__ void p1_modulate(Frame& F, const Ptrs& P) {
    const int gw = F.vcu * NWAVES + F.wave, NGW = F.G * NWAVES;
    const float* mod = (const float*)(P.ws + WS_MOD); bf16* U = (bf16*)(P.ws + WS_U);
    for (int m = gw; m < M; m += NGW) {
        const GAS f32x4* xr = (const GAS f32x4*)(P.x + (size_t)m * D) + F.lane;
        f32x4 v[4]; float s = 0.f;
#pragma unroll
        for (int j = 0; j < 4; ++j) { v[j] = xr[64 * j]; s += (v[j].x + v[j].y) + (v[j].z + v[j].w); }
        const float mean = wave_sum(s) * (1.f / D); float s2 = 0.f;
#pragma unroll
        for (int j = 0; j < 4; ++j) { v[j] = v[j] - mean; s2 += (v[j].x * v[j].x + v[j].y * v[j].y) + (v[j].z * v[j].z + v[j].w * v[j].w); }
        const float rstd = 1.f / sqrtf(wave_sum(s2) * (1.f / D) + LN_EPS);
        const f32x4* sh = (const f32x4*)(mod + (size_t)(m / S) * NMOD * D) + F.lane; const f32x4* sc = sh + D / 4;
        GAS unsigned long long* o8 = (GAS unsigned long long*)(U + (size_t)m * D) + F.lane;
#pragma unroll
        for (int j = 0; j < 4; ++j) { const f32x4 a = v[j] * rstd * (sc[64 * j] + 1.f) + sh[64 * j];
            o8[64 * j] = (unsigned long long)pk2(a.x, a.y) | ((unsigned long long)pk2(a.z, a.w) << 32); }
    }
}
__device__ __forceinline__ void lru_unit(Frame& F, const Ptrs& P, int b, int c, int n) {
    typedef float f32x16 __attribute__((ext_vector_type(16)));
    LAS float* cst = (LAS float*)(F.lds + RING_OFF);
    LAS float* tot = cst + 192;
    LAS float* pre = tot + 1024;
    const bf16* XL = (const bf16*)(P.ws + WS_XL); const bf16* GW = (const bf16*)(P.ws + WS_GW);
    bf16* HL = (bf16*)(P.ws + WS_HL); bf16* CA = (bf16*)(P.ws + WS_CA); float* SUMM = (float*)(P.ws + WS_SUMM);
    const int r = F.lane & 31, hi = F.lane >> 5, w = F.wave;
    if (F.tid < 64) { const int ch = 64 * n + F.tid; cst[F.tid] = P.b_ga[ch]; cst[64 + F.tid] = P.b_gx[ch]; cst[128 + F.tid] = 8.0f * log1pf(__expf(-P.lam[ch])); }
    const int srow = c * BLK + 32 * w + r; const size_t grow = (size_t)b * S + srow;
    float xc[4][8]; bf16x8 bfr[4];
#pragma unroll
    for (int s = 0; s < 4; ++s) { const int cb = 64 * n + 16 * s + 8 * hi;
        { const f32x4 b0 = *(const f32x4*)(P.conv_b + cb), b1 = *(const f32x4*)(P.conv_b + cb + 4);
          xc[s][0] = b0[0]; xc[s][1] = b0[1]; xc[s][2] = b0[2]; xc[s][3] = b0[3]; xc[s][4] = b1[0]; xc[s][5] = b1[1]; xc[s][6] = b1[2]; xc[s][7] = b1[3]; }
#pragma unroll
        for (int k = 0; k < 4; ++k) { const bool inb = srow - 3 + k >= 0;
            v4u xv = *(const GAS v4u*)(XL + (inb ? grow - 3 + k : grow) * DL + cb); if (!inb) xv = (v4u){0u, 0u, 0u, 0u};
            const f32x4 w0 = *(const f32x4*)(P.conv_w + k * DL + cb), w1 = *(const f32x4*)(P.conv_w + k * DL + cb + 4);
            xc[s][0] += w0[0] * bflo(xv[0]); xc[s][1] += w0[1] * bfhi(xv[0]); xc[s][2] += w0[2] * bflo(xv[1]); xc[s][3] += w0[3] * bfhi(xv[1]);
            xc[s][4] += w1[0] * bflo(xv[2]); xc[s][5] += w1[1] * bfhi(xv[2]); xc[s][6] += w1[2] * bflo(xv[3]); xc[s][7] += w1[3] * bfhi(xv[3]); }
        v4u pk; pk.x = pk2(xc[s][0], xc[s][1]); pk.y = pk2(xc[s][2], xc[s][3]); pk.z = pk2(xc[s][4], xc[s][5]); pk.w = pk2(xc[s][6], xc[s][7]);
        bfr[s] = __builtin_bit_cast(bf16x8, pk); }
    f32x16 acc[2][2];
#pragma unroll
    for (int g = 0; g < 2; ++g)
#pragma unroll
        for (int T = 0; T < 2; ++T) { acc[g][T] = (f32x16){0.f, 0.f, 0.f, 0.f, 0.f, 0.f, 0.f, 0.f, 0.f, 0.f, 0.f, 0.f, 0.f, 0.f, 0.f, 0.f};
#pragma unroll
            for (int s = 0; s < 4; ++s) { const bf16x8 af = __builtin_bit_cast(bf16x8, *(const GAS v4u*)(GW + ((size_t)((((n * 2 + g) * 2 + T) * 4 + s) * 64 + F.lane)) * 8));
                acc[g][T] = __builtin_amdgcn_mfma_f32_32x32x16_bf16(af, bfr[s], acc[g][T], 0, 0, 0); } }
    __syncthreads();
    float av[32], hv[32];
#pragma unroll
    for (int T = 0; T < 2; ++T)
#pragma unroll
        for (int rg = 0; rg < 16; ++rg) { const int i = 16 * T + rg, chl = 16 * (i >> 3) + 8 * hi + (i & 7);
            const float ra = acc[0][T][rg] + cst[chl], rx = acc[1][T][rg] + cst[64 + chl];
            const float rr = __builtin_amdgcn_rcpf(1.f + __expf(-ra)), ig = __builtin_amdgcn_rcpf(1.f + __expf(-rx));
            const float a = __expf(-rr * cst[128 + chl]), mult = __builtin_amdgcn_sqrtf(fmaxf(1.f - a * a, 0.f));
            av[i] = a; hv[i] = mult * ig * xc[i >> 3][i & 7]; }
    __builtin_amdgcn_sched_barrier(0); asm volatile("s_nop 1" ::: "memory");
#define LRU_STEP(CTRL) do { _Pragma("unroll") for (int i = 0; i < 32; ++i) \
        asm volatile("v_fmac_f32_dpp %0, %0, %1 " CTRL " bank_mask:0xf\n\tv_mul_f32_dpp %1, %1, %1 " CTRL " bank_mask:0xf" : "+v"(hv[i]), "+v"(av[i])); } while (0)
    LRU_STEP("row_shr:1 row_mask:0xf"); LRU_STEP("row_shr:2 row_mask:0xf"); LRU_STEP("row_shr:4 row_mask:0xf"); LRU_STEP("row_shr:8 row_mask:0xf"); LRU_STEP("row_bcast:15 row_mask:0xa");
#undef LRU_STEP
    asm volatile("s_nop 1" ::: "memory");
    if (r == 31) {
#pragma unroll
        for (int i = 0; i < 32; ++i) { const int chl = 16 * (i >> 3) + 8 * hi + (i & 7); tot[(w * 64 + chl) * 2] = av[i]; tot[(w * 64 + chl) * 2 + 1] = hv[i]; } }
    __syncthreads();
    if (F.tid < 64) { float cin = 1.f, hin = 0.f;
#pragma unroll
        for (int ww = 0; ww < 8; ++ww) { pre[(ww * 64 + F.tid) * 2] = cin; pre[(ww * 64 + F.tid) * 2 + 1] = hin; const float pa = tot[(ww * 64 + F.tid) * 2], hh = tot[(ww * 64 + F.tid) * 2 + 1]; hin = pa * hin + hh; cin *= pa; }
        float* sp = SUMM + ((size_t)(b * NBLK + c) * DL + 64 * n + F.tid) * 2; sp[0] = cin; sp[1] = hin; }
    __syncthreads();
#pragma unroll
    for (int s = 0; s < 4; ++s) { float hl[8], ca[8];
#pragma unroll
        for (int jj = 0; jj < 8; ++jj) { const int i = 8 * s + jj, chl = 16 * s + 8 * hi + jj; const float cin = pre[(w * 64 + chl) * 2], hin = pre[(w * 64 + chl) * 2 + 1];
            hl[jj] = hv[i] + av[i] * hin; ca[jj] = av[i] * cin; }
        v4u oh, oc; oh.x = pk2(hl[0], hl[1]); oh.y = pk2(hl[2], hl[3]); oh.z = pk2(hl[4], hl[5]); oh.w = pk2(hl[6], hl[7]);
        oc.x = pk2(ca[0], ca[1]); oc.y = pk2(ca[2], ca[3]); oc.z = pk2(ca[4], ca[5]); oc.w = pk2(ca[6], ca[7]);
        *(GAS v4u*)(HL + grow * DL + 64 * n + 16 * s + 8 * hi) = oh; *(GAS v4u*)(CA + grow * DL + 64 * n + 16 * s + 8 * hi) = oc; }
    __syncthreads();
}
__device__ __forceinline__ void p3_lru(Frame& F, const Ptrs& P) {
    for (int u = F.vcu; u < NB * NBLK * 8; u += F.G) lru_unit(F, P, u >> 7, (u >> 3) & 15, u & 7);
}
__device__ __forceinline__ void p4_merge(Frame& F, const Ptrs& P) {
    const bf16* HL = (const bf16*)(P.ws + WS_HL); const bf16* CA = (const bf16*)(P.ws + WS_CA); const bf16* YL = (const bf16*)(P.ws + WS_YL); const bf16* AO = (const bf16*)(P.ws + WS_AO);
    const float* SUMM = (const float*)(P.ws + WS_SUMM); bf16* MG = (bf16*)(P.ws + WS_U);
    LAS float* hin = (LAS float*)(F.lds + RING_OFF);
    for (int u = F.vcu; u < M / 64; u += F.G) {
        const int r0 = 64 * u, b = r0 / S, ck = (r0 % S) / BLK;
        { float h = 0.f; const float* sp = SUMM + ((size_t)b * NBLK * DL + F.tid) * 2;
            for (int c = 0; c < ck; ++c) { const float pa = sp[(size_t)c * DL * 2], hh = sp[(size_t)c * DL * 2 + 1]; h = pa * h + hh; }
            hin[F.tid] = h; }
        __syncthreads();
        float hn[8]; { const f32x4 hi0 = *(const LAS f32x4*)(hin + 8 * F.lane), hi1 = *(const LAS f32x4*)(hin + 8 * F.lane + 4);
            hn[0] = hi0[0]; hn[1] = hi0[1]; hn[2] = hi0[2]; hn[3] = hi0[3]; hn[4] = hi1[0]; hn[5] = hi1[1]; hn[6] = hi1[2]; hn[7] = hi1[3]; }
        for (int rr = 0; rr < 8; ++rr) { const size_t row = (size_t)r0 + F.wave * 8 + rr;
            const v4u hl = *(const GAS v4u*)(HL + row * DL + 8 * F.lane), ca = *(const GAS v4u*)(CA + row * DL + 8 * F.lane), yl = *(const GAS v4u*)(YL + row * DL + 8 * F.lane), ao = *(const GAS v4u*)(AO + row * DA + 8 * F.lane);
            float l[8], a[8]; float sl = 0.f, sa = 0.f;
#pragma unroll
            for (int i = 0; i < 4; ++i) { const float hlo = bflo(hl[i]) + bflo(ca[i]) * hn[2 * i], hhi = bfhi(hl[i]) + bfhi(ca[i]) * hn[2 * i + 1];
                l[2 * i] = hlo * fgelu_tanh(bflo(yl[i])); l[2 * i + 1] = hhi * fgelu_tanh(bfhi(yl[i])); a[2 * i] = bflo(ao[i]); a[2 * i + 1] = bfhi(ao[i]);
                sl += l[2 * i] * l[2 * i] + l[2 * i + 1] * l[2 * i + 1]; sa += a[2 * i] * a[2 * i] + a[2 * i + 1] * a[2 * i + 1]; }
            const float rl = 1.f / sqrtf(wave_sum(sl) * (1.f / DL) + LN_EPS), ra = 1.f / sqrtf(wave_sum(sa) * (1.f / DA) + LN_EPS);
            v4u ol, oa;
#pragma unroll
            for (int i = 0; i < 4; ++i) { ol[i] = pk2(l[2 * i] * rl, l[2 * i + 1] * rl); oa[i] = pk2(a[2 * i] * ra, a[2 * i + 1] * ra); }
            *(GAS v4u*)(MG + row * D + 8 * F.lane) = ol; *(GAS v4u*)(MG + row * D + DL + 8 * F.lane) = oa; }
        __syncthreads();
    }
}
__device__ __forceinline__ void p6_post(Frame& F, const Ptrs& P, bool publish) {
    typedef float f32x4v __attribute__((ext_vector_type(4)));
    constexpr int TS = 1026;
    LAS float* T = (LAS float*)(F.lds + RING_OFF);
    LAS float* Pt = T + 16 * TS;
    LAS float* LG = Pt + 8 * 16 * 48;
    const float* mod = (const float*)(P.ws + WS_MOD); const bf16* MIX = (const bf16*)(P.ws + WS_MIX); float* X1 = (float*)(P.ws + WS_X1); bf16* U2 = (bf16*)(P.ws + WS_U);
    const float* WR = (const float*)(P.ws + WS_WR);
    int* RI = (int*)(P.ws + WS_RI); float* RW = (float*)(P.ws + WS_RW); unsigned* ecnt = (unsigned*)(P.ws + WS_ECNT); unsigned* list = (unsigned*)(P.ws + WS_LIST);
    for (int u = F.vcu; u < M / 16; u += F.G) {
#pragma unroll 1
        for (int rr = 0; rr < 2; ++rr) { const int lr = 2 * F.wave + rr, m = 16 * u + lr;
            const f32x4* md = (const f32x4*)(mod + (size_t)(m / S) * NMOD * D) + F.lane;
            const GAS f32x4* xr = (const GAS f32x4*)(P.x + (size_t)m * D) + F.lane; const GAS unsigned long long* mr = (const GAS unsigned long long*)(MIX + (size_t)m * D) + F.lane;
            f32x4 v[4]; float s = 0.f;
#pragma unroll
            for (int j = 0; j < 4; ++j) { const unsigned long long mw = mr[64 * j]; const f32x4 mv = (f32x4){bflo((unsigned)mw), bfhi((unsigned)mw), bflo((unsigned)(mw >> 32)), bfhi((unsigned)(mw >> 32))};
                v[j] = xr[64 * j] * ALPHA + md[2 * (D / 4) + 64 * j] * mv; s += (v[j].x + v[j].y) + (v[j].z + v[j].w); }
            float mean = wave_sum(s) * (1.f / D), s2 = 0.f;
#pragma unroll
            for (int j = 0; j < 4; ++j) { v[j] = v[j] - mean; s2 += (v[j].x * v[j].x + v[j].y * v[j].y) + (v[j].z * v[j].z + v[j].w * v[j].w); }
            float rstd = 1.f / sqrtf(wave_sum(s2) * (1.f / D) + LN_EPS); s = 0.f;
            GAS f32x4* x1r = (GAS f32x4*)(X1 + (size_t)m * D) + F.lane;
#pragma unroll
            for (int j = 0; j < 4; ++j) { v[j] = v[j] * rstd * ((const f32x4*)P.ln1_g)[F.lane + 64 * j] + ((const f32x4*)P.ln1_b)[F.lane + 64 * j]; x1r[64 * j] = v[j]; s += (v[j].x + v[j].y) + (v[j].z + v[j].w); }
            mean = wave_sum(s) * (1.f / D); s2 = 0.f;
#pragma unroll
            for (int j = 0; j < 4; ++j) { v[j] = v[j] - mean; s2 += (v[j].x * v[j].x + v[j].y * v[j].y) + (v[j].z * v[j].z + v[j].w * v[j].w); }
            rstd = 1.f / sqrtf(wave_sum(s2) * (1.f / D) + LN_EPS);
            GAS unsigned long long* o8 = (GAS unsigned long long*)(U2 + (size_t)m * D) + F.lane;
#pragma unroll
            for (int j = 0; j < 4; ++j) { v[j] = v[j] * rstd * (md[4 * (D / 4) + 64 * j] + 1.f) + md[3 * (D / 4) + 64 * j];
                o8[64 * j] = (unsigned long long)pk2(v[j].x, v[j].y) | ((unsigned long long)pk2(v[j].z, v[j].w) << 32);
                LAS float* tp = T + lr * TS + 4 * F.lane + 256 * j; tp[0] = v[j].x; tp[1] = v[j].y; tp[2] = v[j].z; tp[3] = v[j].w; } }
        __syncthreads();
        { f32x4v acc[3]; acc[0] = (f32x4v){0.f, 0.f, 0.f, 0.f}; acc[1] = acc[0]; acc[2] = acc[0];
            const int ar = F.lane & 15, ak = F.lane >> 4; const LAS float* ta = T + ar * TS + 128 * F.wave + ak; const float* wb = WR + (size_t)(128 * F.wave + ak) * 48 + ar;
#pragma unroll 8
            for (int ks = 0; ks < 32; ++ks) { const float a = ta[4 * ks];
#pragma unroll
                for (int ct = 0; ct < 3; ++ct) acc[ct] = __builtin_amdgcn_mfma_f32_16x16x4f32(a, wb[(size_t)ks * 4 * 48 + 16 * ct], acc[ct], 0, 0, 0); }
#pragma unroll
            for (int ct = 0; ct < 3; ++ct)
#pragma unroll
                for (int rg = 0; rg < 4; ++rg) Pt[(F.wave * 16 + ak * 4 + rg) * 48 + 16 * ct + ar] = acc[ct][rg]; }
        __syncthreads();
        for (int o = F.tid; o < 16 * 36; o += NTHR) { const int row = o / 36, col = o % 36; float sm = 0.f;
#pragma unroll
            for (int w = 0; w < 8; ++w) sm += Pt[(w * 16 + row) * 48 + col];
            LG[row * 36 + col] = sm + (col < NG ? P.b_rg[col] : P.b_re[col - NG]); }
        __syncthreads();
        if (F.tid < 16) { const int m = 16 * u + F.tid; const LAS float* lg = LG + F.tid * 36;
            int gi = 0; float gmax = lg[0];
#pragma unroll
            for (int g = 1; g < NG; ++g) if (lg[g] > gmax) { gi = g; gmax = lg[g]; }
            float gs = 0.f;
#pragma unroll
            for (int g = 0; g < NG; ++g) gs += __expf(lg[g] - gmax);
            const float gtop = 1.f / gs; const LAS float* ev = lg + NG + gi * EPG;
            int e0 = 0; float v0 = ev[0];
#pragma unroll
            for (int e = 1; e < EPG; ++e) { const float t = ev[e]; if (t > v0) { e0 = e; v0 = t; } }
            int e1 = -1; float v1 = 0.f;
#pragma unroll
            for (int e = 0; e < EPG; ++e) { const float t = ev[e]; if (e != e0 && (e1 < 0 || t > v1)) { e1 = e; v1 = t; } }
            const float p1 = __expf(v1 - v0), w0 = 1.f / (1.f + p1), w1 = p1 / (1.f + p1);
            const int ge0 = gi * EPG + e0, ge1 = gi * EPG + e1;
            RI[m * 2 + 0] = ge0; RI[m * 2 + 1] = ge1; RW[m * 2 + 0] = gtop * w0; RW[m * 2 + 1] = gtop * w1;
            if (publish) { const unsigned p0 = atomicAdd(ecnt + 64 * ge0, 1u), p1i = atomicAdd(ecnt + 64 * ge1, 1u);
                list[(size_t)ge0 * M + p0] = (unsigned)m * 2u; list[(size_t)ge1 * M + p1i] = (unsigned)m * 2u + 1u; } }
        __syncthreads();
    }
}
__device__ __forceinline__ void moe_setup(Frame& F, const Ptrs& P, int nct) {
    LAS unsigned* toff = (LAS unsigned*)(F.lds + MOEOFF_OFF); LAS unsigned* cnts = toff + 40; LAS unsigned* toktab = (LAS unsigned*)(F.lds + TOKTAB_OFF);
    const unsigned* ecnt = (const unsigned*)(P.ws + WS_ECNT); const unsigned* list = (const unsigned*)(P.ws + WS_LIST);
    if (F.tid < NE) cnts[F.tid] = ecnt[64 * F.tid];
    __syncthreads();
    if (F.tid == 0) { unsigned a = 0; for (int e = 0; e < NE; ++e) { toff[e] = a; a += (cnts[e] + 255u) >> 8; } toff[NE] = a; }
    __syncthreads();
    const int total = (int)toff[NE] * nct;
    for (int i = 0; i < TOKTAB_UNITS; ++i) { const int L = i * F.G + F.vcu; if (L >= total) break;
        const int rt = L / nct; int e = 0; while ((int)toff[e + 1] <= rt) ++e;
        if (F.tid < 256) { const unsigned pos = 256u * (unsigned)(rt - (int)toff[e]) + (unsigned)F.tid; toktab[i * 256 + F.tid] = pos < cnts[e] ? list[(size_t)e * M + pos] : pg8::TOK_NONE; } }
    __syncthreads();
}
__device__ __forceinline__ void p9_final(Frame& F, const Ptrs& P) {
    const int gw = F.vcu * NWAVES + F.wave, NGW = F.G * NWAVES;
    const float* mod = (const float*)(P.ws + WS_MOD); const float* X1 = (const float*)(P.ws + WS_X1); const bf16* YS = (const bf16*)(P.ws + WS_YS);
    for (int m = gw; m < M; m += NGW) {
        const f32x4* md = (const f32x4*)(mod + (size_t)(m / S) * NMOD * D) + F.lane;
        const GAS f32x4* xr = (const GAS f32x4*)(X1 + (size_t)m * D) + F.lane;
        const GAS unsigned long long* y0 = (const GAS unsigned long long*)(YS + (size_t)m * 2 * D) + F.lane; const GAS unsigned long long* y1 = y0 + D / 4;
        f32x4 v[4]; float s = 0.f;
#pragma unroll
        for (int j = 0; j < 4; ++j) { const unsigned long long a = y0[64 * j], b = y1[64 * j];
            const f32x4 f = (f32x4){bflo((unsigned)a) + bflo((unsigned)b), bfhi((unsigned)a) + bfhi((unsigned)b), bflo((unsigned)(a >> 32)) + bflo((unsigned)(b >> 32)), bfhi((unsigned)(a >> 32)) + bfhi((unsigned)(b >> 32))};
            v[j] = xr[64 * j] * ALPHA + md[5 * (D / 4) + 64 * j] * f; s += (v[j].x + v[j].y) + (v[j].z + v[j].w); }
        const float mean = wave_sum(s) * (1.f / D); float s2 = 0.f;
#pragma unroll
        for (int j = 0; j < 4; ++j) { v[j] = v[j] - mean; s2 += (v[j].x * v[j].x + v[j].y * v[j].y) + (v[j].z * v[j].z + v[j].w * v[j].w); }
        const float rstd = 1.f / sqrtf(wave_sum(s2) * (1.f / D) + LN_EPS);
        GAS f32x4* orow = (GAS f32x4*)(P.out + (size_t)m * D) + F.lane;
#pragma unroll
        for (int j = 0; j < 4; ++j) orow[64 * j] = v[j] * rstd * ((const f32x4*)P.ln2_g)[F.lane + 64 * j] + ((const f32x4*)P.ln2_b)[F.lane + 64 * j];
    }
}

constexpr int N_PHASES = 10;
#ifndef PROBE_MASK
#define PROBE_MASK 0
#endif
#define NREP(k) (((PROBE_MASK) >> (k)) & 1 ? 2 : 1)
struct Args { Ptrs p; int ph_lo, ph_hi, li, pad; };
__global__ void __launch_bounds__(NTHR, 2) mk_fwd(Args args) {
    extern __shared__ __attribute__((aligned(16))) unsigned char lds[];
    Frame F;
    F.lds = (LAS unsigned char*)lds;
    F.MISC = (volatile LAS unsigned*)(F.lds + MISC_OFF);
    F.tid = threadIdx.x; F.lane = F.tid & 63; F.wave = __builtin_amdgcn_readfirstlane(F.tid >> 6);
    F.G = gridDim.x; { const int bx = blockIdx.x; F.vcu = (F.G % 8 == 0) ? (bx % 8) * (F.G / 8) + bx / 8 : bx; }
    const Ptrs& P = args.p;
    F.ctl = (gu32*)(P.ws + WS_CTL);
    for (int u = F.tid; u < (LDS_BYTES - LDSCTL_OFF) / 4; u += NTHR) ((LAS unsigned*)(F.lds + LDSCTL_OFF))[u] = 0u;
    __syncthreads();
    const int lo = args.ph_lo, hi = args.ph_hi;
    XcdBarrier bar; bar.bar = (unsigned*)(F.ctl + CW_BAR) + args.li * XCD_BAR_WORDS; bar.x = 0; bar.st = nullptr;
    if (hi - lo > 1) bar = xcd_barrier_post((unsigned*)(F.ctl + CW_BAR) + args.li * XCD_BAR_WORDS, F.MISC + 8);
#define IN(k) (lo <= (k) && (k) < hi)
#define BOTH(k) (IN(k) && IN((k) + 1))
#define SEAM(k) do { if (BOTH(k)) { xcd_barrier(bar); if (NREP(12) > 1) xcd_barrier(bar); } } while (0)
#define TWICE(k, ...) do { if (NREP(k) > 1) { __VA_ARGS__ } __VA_ARGS__ } while (0)
    if (IN(0)) { TWICE(0, { p0_prologue(F, P); __syncthreads(); }); SEAM(0); }
    if (IN(1)) { TWICE(1, { p1_modulate(F, P); }); SEAM(1); }
    if (IN(2)) {
        TWICE(2, {
        pg8::Gemm g{(const pg8::bf16_t*)(P.ws + WS_U), (const pg8::bf16_t*)(P.ws + WS_WIN), M, NPROJ, D}; pg8::StaticOrder So; So.init(M, NPROJ, F.G, (int)blockIdx.x);
        pg8::EpiProj E{(pg8::bf16_t*)(P.ws + WS_XL), (size_t)(WS_YL - WS_XL) / 2, (float*)(P.ws + WS_KMSUM), QSCALE};
        pg8::gemm_phase<pg8::EpiProj, pg8::StaticOrder, PG8_ALIGN, PG8_SP2>(F.lds + RING_OFF, g, So, E); });
        { const int nun = (M / 256) * (NPROJ / 256), full = nun / F.G, rem = nun % F.G;
          if (rem == 0) moe_weight_convert(F, P, (int)blockIdx.x, F.G); else if ((int)blockIdx.x >= rem) moe_weight_convert(F, P, (int)blockIdx.x - rem, F.G - rem); (void)full; }
        SEAM(2);
    }
    if (IN(3)) {
        static_assert(attn_body::LDS_BYTES <= RING_BYTES && attn_body::DM == DA, "attention body geometry vs frame");
        TWICE(10, { p3_lru(F, P); });
        TWICE(11, {
        const attn_body::AttnTensors AT{(const attn_body::bf16*)(P.ws + WS_Q), (const attn_body::bf16*)(P.ws + WS_K), (const attn_body::bf16*)(P.ws + WS_V), (attn_body::bf16*)(P.ws + WS_AO),
                                        (const float*)(P.ws + WS_KMSUM), P.rel_bias, T5_BUCKET};
        const attn_body::StaticOrder So((int)F.G, F.vcu);
        attn_body::attn_phase<attn_body::StaticOrder>((char*)lds + RING_OFF, AT, So); });
        SEAM(3);
    }
    if (IN(4)) { TWICE(4, { p4_merge(F, P); }); SEAM(4); }
    if (IN(5)) {
        TWICE(5, {
        pg8::Gemm g{(const pg8::bf16_t*)(P.ws + WS_U), (const pg8::bf16_t*)(P.ws + WS_WO), M, D, D}; pg8::StaticOrder So; So.init(M, D, F.G, (int)blockIdx.x);
        pg8::EpiBf16Plain E{(pg8::bf16_t*)(P.ws + WS_MIX), D};
        pg8::gemm_phase<pg8::EpiBf16Plain, pg8::StaticOrder, PG8_ALIGN, PG8_SP2>(F.lds + RING_OFF, g, So, E); });
        SEAM(5);
    }
    if (IN(6)) { if (NREP(6) > 1) p6_post(F, P, false); p6_post(F, P, true); SEAM(6); }
    if (IN(7)) {
        TWICE(7, {
        moe_setup(F, P, 2);
        const LAS unsigned* toktab = (const LAS unsigned*)(F.lds + TOKTAB_OFF);
        pg8::Gemm g{(const pg8::bf16_t*)(P.ws + WS_U), (const pg8::bf16_t*)(P.ws + WS_W13), 0, 0, D}; const pg8::MoeOrder So{(const LAS unsigned*)(F.lds + MOEOFF_OFF), 2, F.G, F.vcu};
        pg8::EpiMoeUp E{(pg8::bf16_t*)(P.ws + WS_HDN), (const float*)(P.ws + WS_RW), toktab};
        pg8::gemm_phase_g<pg8::EpiMoeUp, pg8::MoeOrder, true>(F.lds + RING_OFF, g, So, E, toktab); });
        SEAM(7);
    }
    if (IN(8)) {
        TWICE(8, {
        moe_setup(F, P, 4);
        const LAS unsigned* toktab = (const LAS unsigned*)(F.lds + TOKTAB_OFF);
        pg8::Gemm g{(const pg8::bf16_t*)(P.ws + WS_HDN), (const pg8::bf16_t*)(P.ws + WS_W2), 0, 0, DE}; const pg8::MoeOrder So{(const LAS unsigned*)(F.lds + MOEOFF_OFF), 4, F.G, F.vcu};
        pg8::EpiMoeDown E{(pg8::bf16_t*)(P.ws + WS_YS), (pg8::bf16_t*)(P.ws + WS_DUMP), toktab};
        pg8::gemm_phase_g<pg8::EpiMoeDown, pg8::MoeOrder, false>(F.lds + RING_OFF, g, So, E, toktab); });
        SEAM(8);
    }
    if (IN(9)) { TWICE(9, { p9_final(F, P); }); }
#undef TWICE
#undef IN
#undef BOTH
#undef SEAM
}

extern "C" void kernel_launch(void* const* d_in, const int* in_sizes, int n_in, void* d_out, int out_size, void* d_ws, size_t ws_size, hipStream_t stream) {
    static int grid = 0;
    if (grid == 0) {
        if (n_in != 27 || in_sizes[0] != M * D || out_size != M * D || ws_size < WS_END) { fprintf(stderr, "kernel_launch: unexpected shapes / workspace (n_in %d, ws %zu)\n", n_in, ws_size); grid = -1; return; }
        int dev = 0, cus = 0, per_cu = 0;
        if (hipGetDevice(&dev) != hipSuccess || hipDeviceGetAttribute(&cus, hipDeviceAttributeMultiprocessorCount, dev) != hipSuccess) { grid = -1; return; }
        if (hipFuncSetAttribute((const void*)mk_fwd, hipFuncAttributeMaxDynamicSharedMemorySize, LDS_BYTES) != hipSuccess) { fprintf(stderr, "kernel_launch: hipFuncSetAttribute failed\n"); grid = -1; return; }
        if (hipOccupancyMaxActiveBlocksPerMultiprocessor(&per_cu, (const void*)mk_fwd, NTHR, LDS_BYTES) != hipSuccess || per_cu < 1) fprintf(stderr, "kernel_launch: occupancy query reports %d\n", per_cu);
        (void)hipGetLastError();
        grid = cus;
    }
    if (grid < 0) return;
    unsigned char* ws = (unsigned char*)d_ws;
    (void)hipMemsetAsync(ws + WS_CTL, 0, CTL_ZERO_BYTES, stream);
    Args a{};
    const float** pp = (const float**)&a.p;
    for (int i = 0; i < 27; ++i) pp[i] = (const float*)d_in[i];
    a.p.out = (float*)d_out; a.p.ws = ws;
    auto run = [&](int lo, int hi, int li) { a.ph_lo = lo; a.ph_hi = hi; a.li = li; hipLaunchKernelGGL(mk_fwd, dim3(grid), dim3(NTHR), LDS_BYTES, stream, a); };
    run(0, N_PHASES, 0);
}
```
